# Optimizing an MI355X kernel written in HIP

```python
import math
import jax
import jax.numpy as jnp
from jax import lax
import numpy as np

D_MODEL = 1024
BATCH = 4
SEQ = 8192
DEPTH = 1

ATT_HEAD_DIM = 128
ATT_HEADS = 8
ATT_WIDTH = ATT_HEADS * ATT_HEAD_DIM
MOBA_BLOCK = 256
MOBA_TOPK = 3
MOBA_QCHUNK = 64
REL_BUCKETS = 32
REL_MAX_DIST = 2048
MLSTM_HEADS = 4
MLSTM_WIDTH = D_MODEL
MLSTM_HEAD_DIM = MLSTM_WIDTH // MLSTM_HEADS
MLSTM_CHUNK = 64
QKV_BLOCK = 4
CONV_WIDTH = 4
MIX_WIDTH = ATT_WIDTH + MLSTM_WIDTH
IN_COLS = 4 * ATT_WIDTH + 2 * MLSTM_WIDTH
RMS_EPS = 1e-6
LN_EPS = 1e-5

kernel_name = "hymba_moba_mlstm_sandwich"


def rmsnorm(x, g):
    xf = x.astype(jnp.float32)
    y = xf * lax.rsqrt(jnp.mean(xf * xf, axis=-1, keepdims=True) + RMS_EPS)
    return (y * g.astype(jnp.float32)).astype(x.dtype)


def split_heads(a, n_heads):
    b, s, _ = a.shape
    return a.reshape(b, s, n_heads, -1).transpose(0, 2, 1, 3)


def t5_bucket(dist):
    n = jnp.maximum(dist, 0)
    max_exact = REL_BUCKETS // 2
    nf = jnp.maximum(n, 1).astype(jnp.float32)
    large = max_exact + (jnp.log(nf / max_exact) / math.log(REL_MAX_DIST / max_exact)
                         * (REL_BUCKETS - max_exact)).astype(jnp.int32)
    large = jnp.minimum(large, REL_BUCKETS - 1)
    return jnp.where(n < max_exact, n, large)


def moba_attention(q, k, v, rel_bias):
    B, H, S, Dh = q.shape
    nb = -(-S // MOBA_BLOCK)
    pad = nb * MOBA_BLOCK - S
    kb = jnp.pad(k, ((0, 0), (0, 0), (0, pad), (0, 0))).reshape(B, H, nb, MOBA_BLOCK, Dh)
    vb = jnp.pad(v, ((0, 0), (0, 0), (0, pad), (0, 0))).reshape(B, H, nb, MOBA_BLOCK, Dh)
    kmean = jnp.mean(kb.astype(jnp.float32), axis=3)
    ksel = min(MOBA_TOPK, nb)
    scale = Dh ** -0.5
    bias_h = rel_bias.T.astype(jnp.float32)
    b_idx = jnp.arange(B)[:, None, None, None]
    h_idx = jnp.arange(H)[None, :, None, None]
    h_idx5 = h_idx[..., None]
    blk_off = jnp.arange(MOBA_BLOCK)
    nq = S // MOBA_QCHUNK
    qc = jnp.moveaxis(q.reshape(B, H, nq, MOBA_QCHUNK, Dh), 2, 0)

    def one_chunk(args):
        ci, qblk = args
        q_pos = ci * MOBA_QCHUNK + jnp.arange(MOBA_QCHUNK)
        own = (ci * MOBA_QCHUNK) // MOBA_BLOCK
        qf = qblk.astype(jnp.float32) * scale
        gate = jnp.einsum('bhqd,bhnd->bhqn', qf, kmean)
        gate = jnp.where(jnp.arange(nb) < own, gate, -jnp.inf)
        _, gidx = lax.top_k(gate, ksel)
        sel_valid = gidx < own
        k_sel = kb[b_idx, h_idx, gidx].astype(jnp.float32)
        v_sel = vb[b_idx, h_idx, gidx].astype(jnp.float32)
        s_sel = jnp.einsum('bhqd,bhqnkd->bhqnk', qf, k_sel)
        k_pos_sel = gidx[..., None] * MOBA_BLOCK + blk_off
        bucket_sel = t5_bucket(q_pos[None, None, :, None, None] - k_pos_sel)
        s_sel = s_sel + bias_h[h_idx5, bucket_sel]
        s_sel = jnp.where(sel_valid[..., None], s_sel, -jnp.inf)
        k_own = lax.dynamic_index_in_dim(kb, own, axis=2, keepdims=False).astype(jnp.float32)
        v_own = lax.dynamic_index_in_dim(vb, own, axis=2, keepdims=False).astype(jnp.float32)
        s_own = jnp.einsum('bhqd,bhkd->bhqk', qf, k_own)
        dist = q_pos[:, None] - (own * MOBA_BLOCK + blk_off)[None, :]
        s_own = s_own + bias_h[:, t5_bucket(dist)][None]
        s_own = jnp.where(dist >= 0, s_own, -jnp.inf)
        logits = jnp.concatenate(
            [s_sel.reshape(B, H, MOBA_QCHUNK, ksel * MOBA_BLOCK), s_own], axis=-1)
        p = jax.nn.softmax(logits, axis=-1)
        p_sel = p[..., :ksel * MOBA_BLOCK].reshape(B, H, MOBA_QCHUNK, ksel, MOBA_BLOCK)
        p_own = p[..., ksel * MOBA_BLOCK:]
        out = (jnp.einsum('bhqnk,bhqnkd->bhqd', p_sel, v_sel)
               + jnp.einsum('bhqk,bhkd->bhqd', p_own, v_own))
        return out.astype(q.dtype)

    out = lax.map(one_chunk, (jnp.arange(nq), qc))
    return jnp.moveaxis(out, 0, 2).reshape(B, H, S, Dh)


def causal_depthwise_conv(x, w, b):
    c = x.shape[-1]
    y = lax.conv_general_dilated(
        x, w[:, None, :], window_strides=(1,), padding=[(CONV_WIDTH - 1, 0)],
        dimension_numbers=('NWC', 'WIO', 'NWC'), feature_group_count=c)
    return y + b


def blockdiag_proj(x, w):
    b, s, width = x.shape
    xb = x.reshape(b, s, width // QKV_BLOCK, QKV_BLOCK)
    return jnp.einsum('bsni,nio->bsno', xb, w).reshape(b, s, width)


def mlstm_chunkwise(q, k, v, i_pre, f_pre):
    B, H, S, Dh = q.shape
    L = MLSTM_CHUNK
    nc = S // L
    qf = q.astype(jnp.float32)
    kf = k.astype(jnp.float32) * (Dh ** -0.5)
    vf = v.astype(jnp.float32)
    log_i = i_pre.astype(jnp.float32)
    log_f = jax.nn.log_sigmoid(f_pre.astype(jnp.float32))

    def to_chunks(a):
        return jnp.moveaxis(a.reshape((B, H, nc, L) + a.shape[3:]), 2, 0)

    causal = jnp.tril(jnp.ones((L, L), dtype=bool))

    def step(carry, inp):
        C, n, m = carry
        qc, kc, vc, li, lf = inp
        b = jnp.cumsum(lf, axis=-1)
        log_d = b[..., :, None] - b[..., None, :] + li[..., None, :]
        log_d = jnp.where(causal, log_d, -jnp.inf)
        inter = b + m[..., None]
        m_t = jnp.maximum(inter, jnp.max(log_d, axis=-1))
        d = jnp.exp(log_d - m_t[..., None])
        s = jnp.einsum('bhtd,bhsd->bhts', qc, kc) * d
        dec = jnp.exp(inter - m_t)
        num = (jnp.einsum('bhts,bhsd->bhtd', s, vc)
               + dec[..., None] * jnp.einsum('bhtd,bhde->bhte', qc, C))
        den = jnp.sum(s, axis=-1) + dec * jnp.einsum('bhtd,bhd->bht', qc, n)
        h = num / jnp.maximum(jnp.abs(den), jnp.exp(-m_t))[..., None]
        b_last = b[..., -1]
        log_w = b_last[..., None] - b + li
        m_new = jnp.maximum(b_last + m, jnp.max(log_w, axis=-1))
        w = jnp.exp(log_w - m_new[..., None])
        carry_dec = jnp.exp(b_last + m - m_new)
        C_new = carry_dec[..., None, None] * C + jnp.einsum('bhs,bhsd,bhse->bhde', w, kc, vc)
        n_new = carry_dec[..., None] * n + jnp.einsum('bhs,bhsd->bhd', w, kc)
        return (C_new, n_new, m_new), h

    init = (jnp.zeros((B, H, Dh, Dh), jnp.float32),
            jnp.zeros((B, H, Dh), jnp.float32),
            jnp.zeros((B, H), jnp.float32))
    _, hs = lax.scan(step, init, (to_chunks(qf), to_chunks(kf), to_chunks(vf),
                                  to_chunks(log_i), to_chunks(log_f)))
    return jnp.moveaxis(hs, 0, 2).reshape(B, H, S, Dh)


def headwise_layernorm(h, w):
    mu = jnp.mean(h, axis=-1, keepdims=True)
    var = jnp.mean(jnp.square(h - mu), axis=-1, keepdims=True)
    y = (h - mu) * lax.rsqrt(var + LN_EPS)
    b, s = h.shape[:2]
    return y.reshape(b, s, -1) * w.astype(jnp.float32)


def hybrid_layer(x, rel_bias, g_pre, g_post, w_in, conv_w, conv_b, wq_m, wk_m, wv_m,
                 w_if, b_if, mh_norm, skip, w_out):
    B, S, _ = x.shape
    h = rmsnorm(x, g_pre)
    proj = h @ w_in
    aw, mw = ATT_WIDTH, MLSTM_WIDTH
    q_a = proj[..., 0:aw]
    k_a = proj[..., aw:2 * aw]
    v_a = proj[..., 2 * aw:3 * aw]
    g_a = proj[..., 3 * aw:4 * aw]
    x_m = proj[..., 4 * aw:4 * aw + mw]
    z_m = proj[..., 4 * aw + mw:]
    o_a = moba_attention(split_heads(q_a, ATT_HEADS), split_heads(k_a, ATT_HEADS),
                         split_heads(v_a, ATT_HEADS), rel_bias)
    o_a = o_a.transpose(0, 2, 1, 3).reshape(B, S, aw)
    y_a = o_a * jax.nn.silu(g_a)
    x_c = jax.nn.silu(causal_depthwise_conv(x_m, conv_w, conv_b))
    q_m = blockdiag_proj(x_c, wq_m)
    k_m = blockdiag_proj(x_c, wk_m)
    v_m = blockdiag_proj(x_m, wv_m)
    gates = jnp.concatenate([q_m, k_m, v_m], axis=-1) @ w_if + b_if
    i_pre = gates[..., :MLSTM_HEADS].transpose(0, 2, 1)
    f_pre = gates[..., MLSTM_HEADS:].transpose(0, 2, 1)
    h_m = mlstm_chunkwise(split_heads(q_m, MLSTM_HEADS), split_heads(k_m, MLSTM_HEADS),
                          split_heads(v_m, MLSTM_HEADS), i_pre, f_pre)
    h_m = headwise_layernorm(h_m.transpose(0, 2, 1, 3), mh_norm)
    y_m = ((h_m + skip.astype(jnp.float32) * x_c.astype(jnp.float32))
           * jax.nn.silu(z_m.astype(jnp.float32))).astype(x.dtype)
    y = jnp.concatenate([y_a, y_m], axis=-1) @ w_out
    return x + rmsnorm(y, g_post)


def setup_inputs(seed: int = 0) -> dict:
    key = jax.random.key(seed)
    ks = jax.random.split(key, 16)
    f32 = jnp.float32
    nblk = MLSTM_WIDTH // QKV_BLOCK
    x = jax.random.normal(ks[0], (BATCH, SEQ, D_MODEL), f32)
    rel_bias = 0.5 * jax.random.normal(ks[1], (REL_BUCKETS, ATT_HEADS), f32)
    g_pre = 1.0 + 0.02 * jax.random.normal(ks[2], (DEPTH, D_MODEL), f32)
    g_post = 1.0 + 0.02 * jax.random.normal(ks[3], (DEPTH, D_MODEL), f32)
    w_in = jax.random.normal(ks[4], (DEPTH, D_MODEL, IN_COLS), f32) * D_MODEL ** -0.5
    conv_w = jax.random.normal(ks[5], (DEPTH, CONV_WIDTH, MLSTM_WIDTH), f32) * CONV_WIDTH ** -0.5
    conv_b = 0.02 * jax.random.normal(ks[6], (DEPTH, MLSTM_WIDTH), f32)
    wq_m = jax.random.normal(ks[7], (DEPTH, nblk, QKV_BLOCK, QKV_BLOCK), f32) * QKV_BLOCK ** -0.5
    wk_m = jax.random.normal(ks[8], (DEPTH, nblk, QKV_BLOCK, QKV_BLOCK), f32) * QKV_BLOCK ** -0.5
    wv_m = jax.random.normal(ks[9], (DEPTH, nblk, QKV_BLOCK, QKV_BLOCK), f32) * QKV_BLOCK ** -0.5
    w_if = jax.random.normal(ks[10], (DEPTH, 3 * MLSTM_WIDTH, 2 * MLSTM_HEADS), f32) * (3 * MLSTM_WIDTH) ** -0.5
    b_i = 0.1 * jax.random.normal(ks[11], (DEPTH, MLSTM_HEADS), f32)
    b_f = (jnp.linspace(3.0, 6.0, MLSTM_HEADS, dtype=f32)[None, :]
           + 0.1 * jax.random.normal(ks[12], (DEPTH, MLSTM_HEADS), f32))
    b_if = jnp.concatenate([b_i, b_f], axis=-1)
    mh_norm = 1.0 + 0.02 * jax.random.normal(ks[13], (DEPTH, MLSTM_WIDTH), f32)
    skip = 1.0 + 0.02 * jax.random.normal(ks[14], (DEPTH, MLSTM_WIDTH), f32)
    w_out = jax.random.normal(ks[15], (DEPTH, MIX_WIDTH, D_MODEL), f32) * MIX_WIDTH ** -0.5
    return {"x": x, "rel_bias": rel_bias, "g_pre": g_pre, "g_post": g_post, "w_in": w_in,
            "conv_w": conv_w, "conv_b": conv_b, "wq_m": wq_m, "wk_m": wk_m, "wv_m": wv_m,
            "w_if": w_if, "b_if": b_if, "mh_norm": mh_norm, "skip": skip, "w_out": w_out}


def reference(x, rel_bias, g_pre, g_post, w_in, conv_w, conv_b, wq_m, wk_m, wv_m,
              w_if, b_if, mh_norm, skip, w_out):
    for l in range(DEPTH):
        x = hybrid_layer(x, rel_bias, g_pre[l], g_post[l], w_in[l], conv_w[l], conv_b[l],
                         wq_m[l], wk_m[l], wv_m[l], w_if[l], b_if[l], mh_norm[l], skip[l],
                         w_out[l])
    return x
```

```cpp
#include <hip/hip_runtime.h>
#include <hip/hip_cooperative_groups.h>
#include <cstdio>
#include <cstdint>
namespace cg = cooperative_groups;
namespace pg8 {
#define PG8_LAS __attribute__((address_space(3)))
typedef unsigned short bf16_t;
typedef short bf16x8 __attribute__((ext_vector_type(8)));
typedef float f32x4 __attribute__((ext_vector_type(4)));
typedef unsigned u32x4 __attribute__((ext_vector_type(4)));
constexpr int BM = 256, BK = 64, HALF = 128, HTB = HALF * BK * 2  , STAGE_BYTES = 8 * HTB, NXCD = 8, WGM = 8;

__host__ __device__ __forceinline__ int lds_byte(int r, int c) { const int st = (r >> 4) * 2 + (c >> 5), rr = r & 15, cc = c & 31, ob = rr * 64 + cc * 2; return st * 1024 + (ob ^ (((ob >> 9) & 1) << 5)); }
__host__ __device__ __forceinline__ void stage_rc(int b, int& R, int& C) { const int st = b / 1024, sb = b % 1024, swz = sb ^ (((sb >> 9) & 1) << 5); R = (st >> 1) * 16 + swz / 64; C = (st & 1) * 32 + (swz % 64) / 2; }
__host__ __device__ __forceinline__ int perm32(int rho) { const int n = rho >> 4, i = rho & 15; return 8 * (i >> 2) + 4 * n + (i & 3); }

struct Unit { int pm, pn; };
struct Gemm { const bf16_t* A; const bf16_t* Bt; int M, N, K; };

struct StaticOrder {
    int nM, nN, nwg, G, c;
    __host__ __device__ void init(int M, int N, int G_, int c_) { nM = M / BM; nN = N / BM; nwg = nM * nN; G = G_; c = c_; }
    __host__ __device__ bool next(int i, Unit& u) const {
        const long L = (long)i * G + c; if (L >= nwg) return false;
        int wgid = (int)L; { const int q = nwg / NXCD, r = nwg % NXCD, xcd = wgid % NXCD, off = wgid / NXCD; wgid = (xcd < r ? xcd * (q + 1) : r * (q + 1) + (xcd - r) * q) + off; }
        const int nig = WGM * nN, gid = wgid / nig, fm = gid * WGM, gsz = (nM - fm) < WGM ? (nM - fm) : WGM;
        u.pm = fm + ((wgid % nig) % gsz); u.pn = (wgid % nig) / gsz; return true;
    }
    __device__ __forceinline__ void a_ready(const Unit&) const {}
    __device__ __forceinline__ void done(const Unit&) const {}
};

__device__ __forceinline__ unsigned cvt_pk_bf16(float lo, float hi) { unsigned r; asm volatile("v_cvt_pk_bf16_f32 %0, %1, %2" : "=v"(r) : "v"(lo), "v"(hi)); return r; }
typedef float f32x2 __attribute__((ext_vector_type(2)));
struct EpiProj {
    static constexpr bool PERM = true, AFTER_DRAIN = false;
    bf16_t* QK; bf16_t* V; bf16_t* G; bf16_t* XM; bf16_t* ZM; float qscale;
    __device__ __forceinline__ void operator()(const f32x4 (&acc)[2][2][4][2], const Unit& u, int wr, int wc, int fr, int fq) const {
        const int row0 = u.pm * BM + wr * 64 + fr; const int colt = u.pn * BM; const int t = colt >> 10; const int cgp = colt & 1023;
        bf16_t* base; int ldc; float sc = 1.f;
        if (t == 0) { base = QK; ldc = 2048; sc = qscale; } else if (t == 1) { base = QK + 1024; ldc = 2048; } else if (t == 2) { base = V; ldc = 1024; }
        else if (t == 3) { base = G; ldc = 1024; } else if (t == 4) { base = XM; ldc = 1024; } else { base = ZM; ldc = 1024; }
        const int col0 = cgp + wc * 32 + 8 * fq;
#pragma unroll
        for (int ai = 0; ai < 2; ++ai)
#pragma unroll
            for (int m = 0; m < 4; ++m) { bf16_t* rowp = base + (size_t)(row0 + ai * HALF + m * 16) * ldc + col0;
#pragma unroll
                for (int bj = 0; bj < 2; ++bj) { f32x4 v0 = acc[ai][bj][m][0] * sc, v1 = acc[ai][bj][m][1] * sc;
                    u32x4 w; w.x = cvt_pk_bf16(v0[0], v0[1]); w.y = cvt_pk_bf16(v0[2], v0[3]); w.z = cvt_pk_bf16(v1[0], v1[1]); w.w = cvt_pk_bf16(v1[2], v1[3]);
                    *(u32x4*)(rowp + bj * HALF) = w; } }
    }
};
struct EpiF32 {
    static constexpr bool PERM = false, AFTER_DRAIN = false;
    float* O; int ldc;
    __device__ __forceinline__ void operator()(const f32x4 (&acc)[2][2][4][2], const Unit& u, int wr, int wc, int fr, int fq) const {
        const int col0 = u.pn * BM + wc * 32 + 4 * fq;
#pragma unroll
        for (int ai = 0; ai < 2; ++ai)
#pragma unroll
            for (int m = 0; m < 4; ++m) { const int r = ai * HALF + wr * 64 + m * 16 + fr; const size_t off = (size_t)(u.pm * BM + r) * ldc + col0;
#pragma unroll
                for (int bj = 0; bj < 2; ++bj)
#pragma unroll
                    for (int n = 0; n < 2; ++n) *(f32x4*)(O + off + bj * HALF + n * 16) = acc[ai][bj][m][n]; }
    }
};
template <class Epi, class Sched, bool ALIGN_EPI = false, bool SP2 = false>
__device__ __forceinline__ void gemm_phase(PG8_LAS unsigned char* lds, const Gemm g, const Sched& S, const Epi& E) {
    const int tid = threadIdx.x, wid = __builtin_amdgcn_readfirstlane(tid >> 6), lane = tid & 63, wr = wid >> 2, wc = wid & 3, fr = lane & 15, fq = lane >> 4;
    const int K = g.K, nt = K / BK;
    unsigned voffA[2], voffB[2];
#pragma unroll
    for (int i = 0; i < 2; ++i) { int R, C; stage_rc(tid * 16 + i * 8192, R, C); const int Rb = Epi::PERM ? ((R & ~31) + perm32(R & 31)) : R;
        voffA[i] = (unsigned)(R * K + C) * 2u; voffB[i] = (unsigned)(Rb * K + C) * 2u; }
    const size_t kstep = (size_t)(BK * 2);
    const size_t hstep = (size_t)HALF * K * 2;
    const size_t tstep = 2 * hstep;
    const unsigned ldsw = (unsigned)wid * 1024u;
    const int aoff = lds_byte(wr * 64 + fr, fq * 8), boff = lds_byte(wc * 32 + fr, fq * 8);
#define PG8_SA(b, h) (((b) * 2 + (h)) * HTB)
#define PG8_SB(b, h) ((4 + (b) * 2 + (h)) * HTB)
#define PG8_STAGE(bufoff, gbase, voff) do { _Pragma("unroll") for (int _i = 0; _i < 2; ++_i) \
        __builtin_amdgcn_global_load_lds((const unsigned*)((const char*)(gbase) + (voff)[_i]), (PG8_LAS unsigned*)(lds + (bufoff) + ldsw + _i * 8192), 16, 0, 0); } while (0)
#define PG8_LDA(dst, b, h) do { _Pragma("unroll") for (int m = 0; m < 4; ++m) _Pragma("unroll") for (int k = 0; k < 2; ++k) dst[m][k] = *(const PG8_LAS bf16x8*)(lds + PG8_SA(b, h) + aoff + m * 2048 + k * 1024); } while (0)
#define PG8_LDB(dst, b, h) do { _Pragma("unroll") for (int n = 0; n < 2; ++n) _Pragma("unroll") for (int k = 0; k < 2; ++k) dst[n][k] = *(const PG8_LAS bf16x8*)(lds + PG8_SB(b, h) + boff + n * 2048 + k * 1024); } while (0)
#define PG8_MMA(ai, bj, At, Bt) do { __builtin_amdgcn_s_setprio(1); _Pragma("unroll") for (int m = 0; m < 4; ++m) _Pragma("unroll") for (int n = 0; n < 2; ++n) _Pragma("unroll") for (int k = 0; k < 2; ++k) \
        acc[ai][bj][m][n] = __builtin_amdgcn_mfma_f32_16x16x32_bf16(Bt[n][k], At[m][k], acc[ai][bj][m][n], 0, 0, 0); __builtin_amdgcn_s_setprio(0); } while (0)
#define PG8_WAIT_V(n) asm volatile("s_waitcnt vmcnt(" #n ")" ::: "memory")
#define PG8_WAIT_L(n) asm volatile("s_waitcnt lgkmcnt(" #n ")" ::: "memory")
#define PG8_BAR __builtin_amdgcn_s_barrier()
#define PG8_SCHED __builtin_amdgcn_sched_barrier(0)
    Unit cur, nxt; int ui = 0;
    if (!S.next(0, cur)) return;
    f32x4 acc[2][2][4][2];
#pragma unroll
    for (int a = 0; a < 2; ++a)
#pragma unroll
        for (int b = 0; b < 2; ++b)
#pragma unroll
            for (int m = 0; m < 4; ++m)
#pragma unroll
                for (int n = 0; n < 2; ++n) acc[a][b][m][n] = (f32x4){0.f, 0.f, 0.f, 0.f};
    bf16x8 At[4][2], B0[2][2], B1[2][2];
    const char* cA = (const char*)g.A + (size_t)cur.pm * tstep; const char* cB = (const char*)g.Bt + (size_t)cur.pn * tstep;
    S.a_ready(cur);
    if constexpr (SP2) {
        PG8_STAGE(PG8_SB(0, 0), cB, voffB); PG8_STAGE(PG8_SB(0, 1), cB + hstep, voffB); PG8_STAGE(PG8_SA(0, 0), cA, voffA); PG8_STAGE(PG8_SA(0, 1), cA + hstep, voffA);
        if (wr == 1) PG8_BAR;
        PG8_WAIT_V(2); PG8_BAR;
        PG8_STAGE(PG8_SB(1, 0), cB + kstep, voffB); PG8_STAGE(PG8_SA(1, 0), cA + kstep, voffA); PG8_STAGE(PG8_SB(1, 1), cB + hstep + kstep, voffB);
        PG8_WAIT_V(6); PG8_BAR;
    } else {
        PG8_STAGE(PG8_SB(0, 0), cB, voffB); PG8_STAGE(PG8_SA(0, 0), cA, voffA); PG8_STAGE(PG8_SB(0, 1), cB + hstep, voffB); PG8_STAGE(PG8_SA(0, 1), cA + hstep, voffA);
        if (wr == 1) PG8_BAR;
        PG8_WAIT_V(4); PG8_BAR;
        PG8_STAGE(PG8_SB(1, 0), cB + kstep, voffB); PG8_STAGE(PG8_SA(1, 0), cA + kstep, voffA); PG8_STAGE(PG8_SB(1, 1), cB + hstep + kstep, voffB);
        PG8_WAIT_V(6); PG8_BAR;
    }
    for (;;) {
        const bool has_next = S.next(ui + 1, nxt);
        const char* nA = has_next ? (const char*)g.A + (size_t)nxt.pm * tstep : cA; const char* nB = has_next ? (const char*)g.Bt + (size_t)nxt.pn * tstep : cB;
        for (int t = 0; t < nt; t += 2) {
            const bool last = (t == nt - 2);
            const char* a1 = cA + (size_t)(t + 1) * kstep;
            const char* a2 = last ? nA : cA + (size_t)(t + 2) * kstep; const char* b2 = last ? nB : cB + (size_t)(t + 2) * kstep;
            const char* a3 = a2 + kstep; const char* b3 = b2 + kstep;
            if (last && has_next) S.a_ready(nxt);
            if constexpr (SP2) {
            PG8_LDB(B0, 0, 0); PG8_LDB(B1, 0, 1); PG8_SCHED; PG8_LDA(At, 0, 0); PG8_STAGE(PG8_SA(1, 1), a1 + hstep, voffA);
            PG8_WAIT_V(8); PG8_WAIT_L(0); PG8_BAR; PG8_MMA(0, 0, At, B0); PG8_MMA(0, 1, At, B1); PG8_BAR; PG8_SCHED;
            PG8_LDA(At, 0, 1); PG8_STAGE(PG8_SB(0, 0), b2, voffB); PG8_STAGE(PG8_SB(0, 1), b2 + hstep, voffB); PG8_STAGE(PG8_SA(0, 0), a2, voffA);
            PG8_WAIT_V(8); PG8_WAIT_L(0); PG8_BAR; PG8_MMA(1, 0, At, B0); PG8_MMA(1, 1, At, B1); PG8_BAR; PG8_SCHED;
            PG8_LDB(B0, 1, 0); PG8_LDB(B1, 1, 1); PG8_SCHED; PG8_LDA(At, 1, 0); PG8_STAGE(PG8_SA(0, 1), a2 + hstep, voffA);
            PG8_WAIT_V(8); PG8_WAIT_L(0); PG8_BAR; PG8_MMA(0, 0, At, B0); PG8_MMA(0, 1, At, B1); PG8_BAR; PG8_SCHED;
            PG8_LDA(At, 1, 1); PG8_STAGE(PG8_SB(1, 0), b3, voffB); PG8_STAGE(PG8_SB(1, 1), b3 + hstep, voffB); PG8_STAGE(PG8_SA(1, 0), a3, voffA);
            PG8_WAIT_V(8); PG8_WAIT_L(0); PG8_BAR; PG8_MMA(1, 0, At, B0); PG8_MMA(1, 1, At, B1); PG8_BAR; PG8_SCHED;
            } else {
            PG8_LDB(B0, 0, 0); PG8_SCHED; PG8_LDA(At, 0, 0); PG8_STAGE(PG8_SA(1, 1), a1 + hstep, voffA);
            PG8_WAIT_L(8); PG8_BAR; PG8_WAIT_L(0); PG8_MMA(0, 0, At, B0); PG8_BAR; PG8_SCHED;
            PG8_LDB(B1, 0, 1); PG8_STAGE(PG8_SB(0, 0), b2, voffB);
            PG8_BAR; PG8_WAIT_L(0); PG8_MMA(0, 1, At, B1); PG8_BAR;
            PG8_LDA(At, 0, 1); PG8_STAGE(PG8_SA(0, 0), a2, voffA);
            PG8_BAR; PG8_WAIT_L(0); PG8_MMA(1, 0, At, B0); PG8_BAR; PG8_SCHED;
            PG8_STAGE(PG8_SB(0, 1), b2 + hstep, voffB);
            PG8_WAIT_V(6); PG8_BAR; PG8_MMA(1, 1, At, B1); PG8_BAR;
            PG8_LDB(B0, 1, 0); PG8_SCHED; PG8_LDA(At, 1, 0); PG8_STAGE(PG8_SA(0, 1), a2 + hstep, voffA);
            PG8_WAIT_L(8); PG8_BAR; PG8_WAIT_L(0); PG8_MMA(0, 0, At, B0); PG8_BAR; PG8_SCHED;
            PG8_LDB(B1, 1, 1); PG8_STAGE(PG8_SB(1, 0), b3, voffB);
            PG8_BAR; PG8_WAIT_L(0); PG8_MMA(0, 1, At, B1); PG8_BAR;
            PG8_LDA(At, 1, 1); PG8_STAGE(PG8_SA(1, 0), a3, voffA);
            PG8_BAR; PG8_WAIT_L(0); PG8_MMA(1, 0, At, B0); PG8_BAR; PG8_SCHED;
            PG8_STAGE(PG8_SB(1, 1), b3 + hstep, voffB);
            PG8_WAIT_V(6); PG8_BAR; PG8_MMA(1, 1, At, B1); PG8_BAR;
            }
        }
        if constexpr (ALIGN_EPI) { if (wr == 0) PG8_BAR; }
        if constexpr (!Epi::AFTER_DRAIN) { E(acc, cur, wr, wc, fr, fq); S.done(cur); }
        if (!has_next) break;
#pragma unroll
        for (int a = 0; a < 2; ++a)
#pragma unroll
            for (int b = 0; b < 2; ++b)
#pragma unroll
                for (int m = 0; m < 4; ++m)
#pragma unroll
                    for (int n = 0; n < 2; ++n) acc[a][b][m][n] = (f32x4){0.f, 0.f, 0.f, 0.f};
        cur = nxt; cA = nA; cB = nB; ++ui;
        if constexpr (ALIGN_EPI) { if (wr == 1) PG8_BAR; }
    }
    PG8_WAIT_V(0);
    if constexpr (!ALIGN_EPI) { if (wr == 0) PG8_BAR; }
    PG8_BAR;
    if constexpr (Epi::AFTER_DRAIN) { E.fused(acc, cur, wr, wc, fr, fq, lds, wid, lane); S.done(cur); }
#undef PG8_SA
#undef PG8_SB
#undef PG8_STAGE
#undef PG8_LDA
#undef PG8_LDB
#undef PG8_MMA
#undef PG8_WAIT_V
#undef PG8_WAIT_L
#undef PG8_BAR
#undef PG8_SCHED
}
}

constexpr int NWAVES = 8, NTHR = 512;
constexpr int BATCH = 4, SEQ = 8192, DM = 1024, MTOK = BATCH * SEQ, NIN = 6144, MIXW = 2048;
constexpr int NH = 8, DH = 128, NBLK = SEQ / 256;
constexpr int MH = 4, MD = 256, LCH = 64, NCH = SEQ / LCH;
constexpr float LOG2E = 1.4426950408889634f;
constexpr float QSCALE = 0.08838834764831845f * LOG2E;
constexpr float RMS_EPS = 1e-6f, LN_EPS = 1e-5f;
constexpr int LISTSZ = 256 * 496;
__host__ __device__ constexpr int list_off(int j) { return 256 * (31 * j - (j * (j - 1)) / 2); }

constexpr size_t MiB = 1u << 20;
constexpr size_t WS_CTL = 0, CTL_ZERO_BYTES = 64 * 1024;
constexpr size_t WS_BIASD = 1 * MiB;
constexpr size_t WS_WEFF = 1 * MiB + 64 * 1024;
constexpr size_t WS_KMEAN = 1 * MiB + 128 * 1024;
constexpr size_t WS_KMAX = 1 * MiB + 640 * 1024;
constexpr size_t WS_GLI = 2 * MiB, WS_GLF = 2 * MiB + 512 * 1024;
constexpr size_t WS_SEL = 3 * MiB;
constexpr size_t WS_LPART = 7 * MiB;
constexpr size_t WS_WINT = 10 * MiB;
constexpr size_t WS_WOUTT = 22 * MiB;
constexpr size_t WS_LIST = 26 * MiB;
constexpr size_t WS_XN = 64 * MiB;
constexpr size_t WS_QK = 128 * MiB;
constexpr size_t WS_V = 256 * MiB, WS_G = 320 * MiB, WS_XM = 384 * MiB, WS_ZM = 448 * MiB, WS_END = 512 * MiB;
constexpr int CW_CNT = 1024;

constexpr int LDS_BYTES = 163840;
#define GAS __attribute__((address_space(1)))
#define LAS __attribute__((address_space(3)))
#define DI __device__ __forceinline__
typedef unsigned short bf16;
typedef unsigned u32x4 __attribute__((ext_vector_type(4)));
typedef unsigned u32x2 __attribute__((ext_vector_type(2)));
typedef int i32x4 __attribute__((ext_vector_type(4)));
typedef float f32x4 __attribute__((ext_vector_type(4)));
typedef float f32x16 __attribute__((ext_vector_type(16)));
typedef short bf16x8 __attribute__((ext_vector_type(8)));
typedef short s16x4 __attribute__((ext_vector_type(4)));
typedef float f32x2_t __attribute__((ext_vector_type(2)));
typedef __bf16 bf16x2_t __attribute__((ext_vector_type(2)));
#define MFMA32(a, b, c) __builtin_amdgcn_mfma_f32_32x32x16_bf16((a), (b), (c), 0, 0, 0)
#define MFMA16(a, b, c) __builtin_amdgcn_mfma_f32_16x16x32_bf16((a), (b), (c), 0, 0, 0)

DI float bf2f(unsigned u16) { return __uint_as_float(u16 << 16); }
DI float bflo(unsigned w) { return __uint_as_float(w << 16); }
DI float bfhi(unsigned w) { return __uint_as_float(w & 0xffff0000u); }
DI unsigned pk2(float lo, float hi) { f32x2_t v = {lo, hi}; bf16x2_t b = __builtin_convertvector(v, bf16x2_t); return __builtin_bit_cast(unsigned, b); }
DI unsigned f2bf(float f) { return pk2(f, 0.f) & 0xffffu; }
DI int crow(int reg, int h) { return (reg & 3) + 8 * (reg >> 2) + 4 * h; }
DI float wave_sum(float v) {
#pragma unroll
    for (int o = 1; o < 64; o <<= 1) v += __shfl_xor(v, o);
    return v;
}
DI float wave_max(float v) {
#pragma unroll
    for (int o = 1; o < 64; o <<= 1) v = fmaxf(v, __shfl_xor(v, o));
    return v;
}
DI bf16x8 pack_lo(const f32x16& x) { u32x4 p; p.x = pk2(x[0], x[1]); p.y = pk2(x[2], x[3]); p.z = pk2(x[4], x[5]); p.w = pk2(x[6], x[7]); return __builtin_bit_cast(bf16x8, p); }
DI bf16x8 pack_hi(const f32x16& x) { u32x4 p; p.x = pk2(x[8], x[9]); p.y = pk2(x[10], x[11]); p.z = pk2(x[12], x[13]); p.w = pk2(x[14], x[15]); return __builtin_bit_cast(bf16x8, p); }
DI float silu_f(float v) { return v / (1.0f + __expf(-v)); }

struct Args { const float* in[15]; float* out; unsigned char* ws; int ph_lo, ph_hi; };

DI void p0_transpose_item(const float* W, int K, int N, bf16* WT, LAS float* scr, int item, int lane) {
    const int nblk = N / 32, kb = item / nblk, nb = item % nblk, k0 = 64 * kb, n0 = 32 * nb;
#pragma unroll 8
    for (int i = 0; i < 32; ++i) { const int kk = 2 * i + (lane >> 5); scr[kk * 33 + (lane & 31)] = W[(size_t)(k0 + kk) * N + n0 + (lane & 31)]; }
    asm volatile("s_waitcnt lgkmcnt(0)" ::: "memory");
    const int c = lane & 7;
#pragma unroll
    for (int j = 0; j < 4; ++j) { const int n = (lane >> 3) + 8 * j; const LAS float* s = scr + (8 * c) * 33 + n;
        u32x4 o; o.x = pk2(s[0 * 33], s[1 * 33]); o.y = pk2(s[2 * 33], s[3 * 33]); o.z = pk2(s[4 * 33], s[5 * 33]); o.w = pk2(s[6 * 33], s[7 * 33]);
        *(u32x4*)(WT + (size_t)(n0 + n) * K + k0 + 8 * c) = o; }
    asm volatile("s_waitcnt lgkmcnt(0)" ::: "memory");
}
DI int t5_bucket(int n) {
    if (n < 16) return n;
    int b = 16;
    b += (n >= 22); b += (n >= 30); b += (n >= 40); b += (n >= 54); b += (n >= 73); b += (n >= 99); b += (n >= 134); b += (n >= 182);
    b += (n >= 246); b += (n >= 332); b += (n >= 450); b += (n >= 609); b += (n >= 825); b += (n >= 1117); b += (n >= 1513);
    return b;
}
DI void phase_prologue(const Args& a, LAS unsigned char* lds, int tid, int lane, int wave, int bid, int G) {
    const float* x = a.in[0]; const float* rel_bias = a.in[1]; const float* g_pre = a.in[2]; const float* w_in = a.in[4];
    const float* wq = a.in[7]; const float* wk = a.in[8]; const float* wv = a.in[9]; const float* w_if = a.in[10]; const float* w_out = a.in[14];
    unsigned char* ws = a.ws;
    LAS float* scr = (LAS float*)(lds + wave * 16384);
    const int gw = bid * NWAVES + wave, NGW = G * NWAVES;
    constexpr int I_IN = (DM / 64) * (NIN / 32), I_OUT = (MIXW / 64) * (DM / 32);
    for (int it = gw; it < I_IN + I_OUT; it += NGW) {
        if (it < I_IN) p0_transpose_item(w_in, DM, NIN, (bf16*)(ws + WS_WINT), scr, it, lane);
        else p0_transpose_item(w_out, MIXW, DM, (bf16*)(ws + WS_WOUTT), scr, it - I_IN, lane);
    }
    {
        const f32x4* gr = (const f32x4*)g_pre + lane; f32x4 gg[4];
#pragma unroll
        for (int j = 0; j < 4; ++j) gg[j] = gr[64 * j];
        bf16* XN = (bf16*)(ws + WS_XN);
        for (int m = gw; m < MTOK; m += NGW) {
            const f32x4* xr = (const f32x4*)(x + (size_t)m * DM) + lane; f32x4 v[4]; float s = 0.f;
#pragma unroll
            for (int j = 0; j < 4; ++j) { v[j] = xr[64 * j]; s += (v[j].x * v[j].x + v[j].y * v[j].y) + (v[j].z * v[j].z + v[j].w * v[j].w); }
            const float rstd = 1.0f / sqrtf(wave_sum(s) * (1.0f / DM) + RMS_EPS);
            u32x2* o8 = (u32x2*)(XN + (size_t)m * DM) + lane;
#pragma unroll
            for (int j = 0; j < 4; ++j) { u32x2 o; o.x = pk2(v[j].x * rstd * gg[j].x, v[j].y * rstd * gg[j].y); o.y = pk2(v[j].z * rstd * gg[j].z, v[j].w * rstd * gg[j].w); o8[64 * j] = o; }
        }
    }
    const int gt = bid * NTHR + tid, NGT = G * NTHR;
    float* biasd = (float*)(ws + WS_BIASD);
    for (int idx = gt; idx < NH * 2048; idx += NGT) { const int h = idx >> 11, d = idx & 2047; biasd[idx] = rel_bias[t5_bucket(d) * NH + h] * LOG2E; }
    if (gt < NH) { float m = -1e30f; for (int b = 0; b < 32; ++b) m = fmaxf(m, rel_bias[b * NH + gt] * LOG2E); ((float*)(ws + WS_KMAX + 4096))[gt] = m; }
    float* weff = (float*)(ws + WS_WEFF);
    for (int idx = gt; idx < 2 * 1024 * 8; idx += NGT) {
        const int which = idx >> 13, c = (idx >> 3) & 1023, g = idx & 7, n = c >> 2, i = c & 3; float s = 0.f;
        if (which == 0) { for (int o = 0; o < 4; ++o) s += wq[n * 16 + i * 4 + o] * w_if[(4 * n + o) * 8 + g] + wk[n * 16 + i * 4 + o] * w_if[(1024 + 4 * n + o) * 8 + g]; }
        else { for (int o = 0; o < 4; ++o) s += wv[n * 16 + i * 4 + o] * w_if[(2048 + 4 * n + o) * 8 + g]; }
        weff[idx] = s;
    }
}

DI void phase_kstat(const Args& a, LAS unsigned char* lds, int tid, int lane, int wave, int bid, int G) {
    const bf16* QK = (const bf16*)(a.ws + WS_QK); float* KMEAN = (float*)(a.ws + WS_KMEAN); float* KMAX = (float*)(a.ws + WS_KMAX);
    LAS float* red = (LAS float*)lds; LAS float* wmx = (LAS float*)(lds + 32 * 128 * 4);
    for (int u = bid; u < 32 * NBLK; u += G) {
        const int bh = u >> 5, blk = u & 31, b = bh >> 3, h = bh & 7;
        const bf16* Kb = QK + (size_t)(b * SEQ + blk * 256) * 2048 + 1024 + h * DH;
        const int rg = tid >> 4, ch = tid & 15;
        float cs[8]; float mx = 0.f;
#pragma unroll
        for (int e = 0; e < 8; ++e) cs[e] = 0.f;
#pragma unroll
        for (int rr = 0; rr < 8; ++rr) {
            const u32x4 v = *(const u32x4*)(Kb + (size_t)(rg * 8 + rr) * 2048 + ch * 8);
            const float f0 = bflo(v.x), f1 = bfhi(v.x), f2 = bflo(v.y), f3 = bfhi(v.y), f4 = bflo(v.z), f5 = bfhi(v.z), f6 = bflo(v.w), f7 = bfhi(v.w);
            cs[0] += f0; cs[1] += f1; cs[2] += f2; cs[3] += f3; cs[4] += f4; cs[5] += f5; cs[6] += f6; cs[7] += f7;
            float ss = (f0 * f0 + f1 * f1) + (f2 * f2 + f3 * f3) + (f4 * f4 + f5 * f5) + (f6 * f6 + f7 * f7);
            ss += __shfl_xor(ss, 1); ss += __shfl_xor(ss, 2); ss += __shfl_xor(ss, 4); ss += __shfl_xor(ss, 8);
            mx = fmaxf(mx, ss);
        }
#pragma unroll
        for (int e = 0; e < 8; ++e) red[rg * 128 + ch * 8 + e] = cs[e];
        mx = wave_max(mx); if (lane == 0) wmx[wave] = mx;
        __syncthreads();
        if (tid < 128) { float s = 0.f; for (int r = 0; r < 32; ++r) s += red[r * 128 + tid]; KMEAN[(size_t)(bh * 32 + blk) * 128 + tid] = s * (1.0f / 256.0f); }
        if (tid == 0) { float m = wmx[0]; for (int w = 1; w < 8; ++w) m = fmaxf(m, wmx[w]); KMAX[bh * 32 + blk] = m; }
        __syncthreads();
    }
}

DI void phase_sel(const Args& a, LAS unsigned char* lds, int tid, int lane, int wave, int bid, int G) {
    const bf16* QK = (const bf16*)(a.ws + WS_QK); const float* KMEAN = (const float*)(a.ws + WS_KMEAN); const float* KMAX = (const float*)(a.ws + WS_KMAX);
    const float* BMAX = (const float*)(a.ws + WS_KMAX + 4096);
    i32x4* SEL = (i32x4*)(a.ws + WS_SEL); unsigned* cnt = (unsigned*)(a.ws + WS_CTL) + CW_CNT; unsigned* LIST = (unsigned*)(a.ws + WS_LIST);
    LAS float* km = (LAS float*)lds; LAS float* misc = (LAS float*)(lds + 32 * 128 * 4);
    for (int u = bid; u < 32 * NBLK; u += G) {
        const int bh = u >> 5, i = u & 31, b = bh >> 3, h = bh & 7;
        for (int idx = tid; idx < i * 128; idx += NTHR) km[idx] = KMEAN[(size_t)bh * 32 * 128 + idx];
        if (tid < 64) { float v = tid < 32 ? KMAX[bh * 32 + tid] : 0.f; v = wave_max(v); if (tid == 0) misc[0] = sqrtf(v); }
        __syncthreads();
        const float kmaxn = misc[0];
        const int q = tid >> 1, half = tid & 1; const int row = b * SEQ + i * 256 + q;
        const bf16* qp = QK + (size_t)row * 2048 + h * DH + half * 64;
        float qv[64];
#pragma unroll
        for (int c = 0; c < 8; ++c) { const u32x4 v = *(const u32x4*)(qp + c * 8);
            qv[c * 8 + 0] = bflo(v.x); qv[c * 8 + 1] = bfhi(v.x); qv[c * 8 + 2] = bflo(v.y); qv[c * 8 + 3] = bfhi(v.y);
            qv[c * 8 + 4] = bflo(v.z); qv[c * 8 + 5] = bfhi(v.z); qv[c * 8 + 6] = bflo(v.w); qv[c * 8 + 7] = bfhi(v.w); }
        float qn2 = 0.f;
#pragma unroll
        for (int d = 0; d < 64; ++d) qn2 += qv[d] * qv[d];
        qn2 += __shfl_xor(qn2, 1);
        float v0 = -INFINITY, v1 = -INFINITY, v2 = -INFINITY; int i0 = -1, i1 = -1, i2 = -1;
        for (int j = 0; j < i; ++j) {
            const LAS float* kr = km + j * 128 + half * 64; float dot = 0.f;
#pragma unroll
            for (int d = 0; d < 64; d += 4) { const f32x4 kk = *(const LAS f32x4*)(kr + d); dot += qv[d] * kk.x + qv[d + 1] * kk.y + qv[d + 2] * kk.z + qv[d + 3] * kk.w; }
            dot += __shfl_xor(dot, 1);
            if (dot > v0) { v2 = v1; i2 = i1; v1 = v0; i1 = i0; v0 = dot; i0 = j; }
            else if (dot > v1) { v2 = v1; i2 = i1; v1 = dot; i1 = j; }
            else if (dot > v2) { v2 = dot; i2 = j; }
        }
        const float shift = sqrtf(qn2) * kmaxn + BMAX[h];
        if (half == 0) {
            i32x4 s4; s4.x = i0; s4.y = i1; s4.z = i2; s4.w = __float_as_int(shift);
            SEL[(size_t)row * 8 + h] = s4;
            const unsigned qpos = (unsigned)(i * 256 + q);
            if (i0 >= 0) { const unsigned p = atomicAdd(&cnt[bh * 32 + i0], 1u); LIST[(size_t)bh * LISTSZ + list_off(i0) + p] = qpos | (0u << 16); }
            if (i1 >= 0) { const unsigned p = atomicAdd(&cnt[bh * 32 + i1], 1u); LIST[(size_t)bh * LISTSZ + list_off(i1) + p] = qpos | (1u << 16); }
            if (i2 >= 0) { const unsigned p = atomicAdd(&cnt[bh * 32 + i2], 1u); LIST[(size_t)bh * LISTSZ + list_off(i2) + p] = qpos | (2u << 16); }
        }
        __syncthreads();
    }
}

constexpr int ATT_KIMG = 0, ATT_KROW = 272, ATT_VT = 69632, ATT_VROW = 520, ATT_BIASD = 136192, ATT_PREF = 144384, ATT_LST = 148480, ATT_MISC = 149504;
DI void att_fill_kv(LAS unsigned char* lds, const bf16* Kg, const bf16* Vg, int tid, int lane, int wave) {
#pragma unroll
    for (int it = 0; it < 8; ++it) { const int p = it * NTHR + tid, key = p >> 4, ch = p & 15;
        const u32x4 v = *(const u32x4*)(Kg + (size_t)key * 2048 + ch * 8); *(LAS u32x4*)(lds + ATT_KIMG + key * ATT_KROW + ch * 16) = v; }
#pragma unroll
    for (int dcw = 0; dcw < 2; ++dcw) { const int dc = wave + 8 * dcw;
#pragma unroll
        for (int kp = 0; kp < 4; ++kp) { const int key = kp * 64 + lane;
            const u32x4 v = *(const u32x4*)(Vg + (size_t)key * 1024 + dc * 8);
            LAS unsigned short* dst = (LAS unsigned short*)(lds + ATT_VT + (dc * 8) * ATT_VROW + key * 2);
            dst[0 * (ATT_VROW / 2)] = (unsigned short)(v.x & 0xffffu); dst[1 * (ATT_VROW / 2)] = (unsigned short)(v.x >> 16);
            dst[2 * (ATT_VROW / 2)] = (unsigned short)(v.y & 0xffffu); dst[3 * (ATT_VROW / 2)] = (unsigned short)(v.y >> 16);
            dst[4 * (ATT_VROW / 2)] = (unsigned short)(v.z & 0xffffu); dst[5 * (ATT_VROW / 2)] = (unsigned short)(v.z >> 16);
            dst[6 * (ATT_VROW / 2)] = (unsigned short)(v.w & 0xffffu); dst[7 * (ATT_VROW / 2)] = (unsigned short)(v.w >> 16); } }
}
template <bool OWN>
DI void att_tile(LAS unsigned char* lds, const bf16x8 (&qf)[8], int qpos, float shift, int kbase, int kt_end, int wdiag, bool far, float b31,
                 f32x16 (&o)[4], float& lsum, int r, int hf) {
    const LAS float* biasd = (const LAS float*)(lds + ATT_BIASD);
    for (int kt = 0; kt < kt_end; ++kt) {
        f32x16 x;
#pragma unroll
        for (int i = 0; i < 16; ++i) x[i] = 0.f;
#pragma unroll
        for (int ks = 0; ks < 8; ++ks) { const bf16x8 kf = *(const LAS bf16x8*)(lds + ATT_KIMG + (32 * kt + r) * ATT_KROW + ks * 32 + hf * 16); x = MFMA32(kf, qf[ks], x); }
        if (far) {
#pragma unroll
            for (int i = 0; i < 16; ++i) { const float p = __builtin_amdgcn_exp2f(x[i] + (b31 - shift)); lsum += p; x[i] = p; }
        } else {
#pragma unroll
            for (int i = 0; i < 16; ++i) { const int key = 32 * kt + crow(i, hf); int dist = qpos - (kbase + key); dist = dist < 0 ? 0 : (dist > 2047 ? 2047 : dist);
                float p = __builtin_amdgcn_exp2f(x[i] + biasd[dist] - shift);
                if (OWN) { if (kt == wdiag && crow(i, hf) > r) p = 0.f; }
                lsum += p; x[i] = p; }
        }
        const bf16x8 pa0 = pack_lo(x), pa1 = pack_hi(x);
#pragma unroll
        for (int dt = 0; dt < 4; ++dt) {
            const LAS unsigned char* vb = lds + ATT_VT + (32 * dt + r) * ATT_VROW + 2 * (32 * kt + 4 * hf);
            const s16x4 l0 = *(const LAS s16x4*)(vb), h0 = *(const LAS s16x4*)(vb + 16), l1 = *(const LAS s16x4*)(vb + 32), h1 = *(const LAS s16x4*)(vb + 48);
            const bf16x8 vf0 = __builtin_shufflevector(l0, h0, 0, 1, 2, 3, 4, 5, 6, 7), vf1 = __builtin_shufflevector(l1, h1, 0, 1, 2, 3, 4, 5, 6, 7);
            o[dt] = MFMA32(pa0, vf0, o[dt]); o[dt] = MFMA32(pa1, vf1, o[dt]);
        }
    }
}
DI void att_load_biasd(const Args& a, LAS unsigned char* lds, int h, int tid) {
    const float* biasd = (const float*)(a.ws + WS_BIASD) + h * 2048; LAS float* dst = (LAS float*)(lds + ATT_BIASD);
    for (int i = tid; i < 2048; i += NTHR) dst[i] = biasd[i];
}
DI bf16* opart_base(const Args& a, int slot) { return slot == 0 ? (bf16*)a.out : (slot == 1 ? (bf16*)((unsigned char*)a.out + 64 * MiB) : (bf16*)(a.ws + WS_XN)); }

DI void phase_att_gather(const Args& a, LAS unsigned char* lds, int tid, int lane, int wave, int bid, int G) {
    const bf16* QK = (const bf16*)(a.ws + WS_QK); const bf16* Vb = (const bf16*)(a.ws + WS_V);
    const i32x4* SEL = (const i32x4*)(a.ws + WS_SEL); const unsigned* cnt = (const unsigned*)(a.ws + WS_CTL) + CW_CNT; const unsigned* LIST = (const unsigned*)(a.ws + WS_LIST);
    float* LPART = (float*)(a.ws + WS_LPART);
    LAS int* pref = (LAS int*)(lds + ATT_PREF);
    if (tid < 64) {
        int nu[16]; int s = 0;
#pragma unroll
        for (int k = 0; k < 16; ++k) { const int l = tid * 16 + k; int n = 0; if (l < 992) { const int bh = l / 31, j = l % 31; n = (int)((cnt[bh * 32 + j] + 255u) >> 8); } nu[k] = n; s += n; }
        int incl = s;
#pragma unroll
        for (int o = 1; o < 64; o <<= 1) { const int t = __shfl_up(incl, o); if (lane >= o) incl += t; }
        int run = incl - s;
#pragma unroll
        for (int k = 0; k < 16; ++k) { const int l = tid * 16 + k; if (l <= 992) pref[l] = run; run += nu[k]; }
    }
    __syncthreads();
    const int U = pref[992];
    const int r = lane & 31, hf = lane >> 5;
    int cur_h = -1;
    for (int u = bid; u < U; u += G) {
        int lo = 0, hi = 992;
        while (hi - lo > 1) { const int mid = (lo + hi) >> 1; if (pref[mid] <= u) lo = mid; else hi = mid; }
        const int l = lo, bh = l / 31, j = l % 31, chunk = u - pref[l], b = bh >> 3, h = bh & 7;
        const int n = (int)cnt[bh * 32 + j]; const int nrows = min(256, n - chunk * 256);
        if (h != cur_h) { att_load_biasd(a, lds, h, tid); cur_h = h; }
        att_fill_kv(lds, QK + (size_t)(b * SEQ + j * 256) * 2048 + 1024 + h * DH, Vb + (size_t)(b * SEQ + j * 256) * 1024 + h * DH, tid, lane, wave);
        __syncthreads();
        const int nv = min(32, max(0, nrows - 32 * wave));
        const unsigned* lp = LIST + (size_t)bh * LISTSZ + list_off(j) + chunk * 256 + 32 * wave;
        unsigned ent = 0; f32x16 o[4]; float lsum = 0.f;
#pragma unroll
        for (int dt = 0; dt < 4; ++dt)
#pragma unroll
            for (int i = 0; i < 16; ++i) o[dt][i] = 0.f;
        if (nv > 0) {
            ent = lp[r < nv ? r : 0];
            const int qpos = (int)(ent & 0xffffu); const size_t row = (size_t)b * SEQ + qpos;
            const float shift = __int_as_float(SEL[row * 8 + h].w);
            bf16x8 qf[8];
#pragma unroll
            for (int ks = 0; ks < 8; ++ks) qf[ks] = *(const bf16x8*)(QK + row * 2048 + h * DH + ks * 16 + hf * 8);
            const bool far = __all(qpos - (j * 256 + 255) >= 1513);
            const float b31 = *(const LAS float*)(lds + ATT_BIASD + 2047 * 4);
            att_tile<false>(lds, qf, qpos, shift, j * 256, 8, -1, far, b31, o, lsum, r, hf);
            lsum += __shfl_xor(lsum, 32);
        }
        __syncthreads();
        if (nv > 0) {
            LAS unsigned char* stg = lds + wave * 8192;
#pragma unroll
            for (int dt = 0; dt < 4; ++dt)
#pragma unroll
                for (int i = 0; i < 16; ++i) *(LAS unsigned short*)(stg + crow(i, hf) * 256 + (32 * dt + r) * 2) = (unsigned short)f2bf(o[dt][i]);
#pragma unroll
            for (int it = 0; it < 8; ++it) { const int item = it * 64 + lane, rho = item >> 4, ch = item & 15;
                const unsigned e2 = (unsigned)__shfl((int)ent, rho); const int q2 = (int)(e2 & 0xffffu), slot2 = (int)(e2 >> 16);
                const u32x4 v = *(const LAS u32x4*)(stg + rho * 256 + ch * 16);
                if (rho < nv) *(u32x4*)(opart_base(a, slot2) + (((size_t)b * SEQ + q2) * 8 + h) * 128 + ch * 8) = v; }
            if (hf == 0 && r < nv) { const int q1 = (int)(ent & 0xffffu), slot1 = (int)(ent >> 16); LPART[(size_t)slot1 * MTOK * 8 + ((size_t)b * SEQ + q1) * 8 + h] = lsum; }
        }
        __syncthreads();
    }
}

DI void phase_att_own(const Args& a, LAS unsigned char* lds, int tid, int lane, int wave, int bid, int G) {
    bf16* QK = (bf16*)(a.ws + WS_QK); const bf16* Vb = (const bf16*)(a.ws + WS_V); const bf16* Gb = (const bf16*)(a.ws + WS_G);
    const i32x4* SEL = (const i32x4*)(a.ws + WS_SEL); const float* LPART = (const float*)(a.ws + WS_LPART);
    const int r = lane & 31, hf = lane >> 5;
    int cur_h = -1;
    for (int u = bid; u < 32 * NBLK; u += G) {
        const int bh = u >> 5, i = u & 31, b = bh >> 3, h = bh & 7;
        if (h != cur_h) { att_load_biasd(a, lds, h, tid); cur_h = h; }
        att_fill_kv(lds, QK + (size_t)(b * SEQ + i * 256) * 2048 + 1024 + h * DH, Vb + (size_t)(b * SEQ + i * 256) * 1024 + h * DH, tid, lane, wave);
        __syncthreads();
        const int qpos = i * 256 + 32 * wave + r; const size_t row = (size_t)b * SEQ + qpos;
        const float shift = __int_as_float(SEL[row * 8 + h].w);
        bf16x8 qf[8];
#pragma unroll
        for (int ks = 0; ks < 8; ++ks) qf[ks] = *(const bf16x8*)(QK + row * 2048 + h * DH + ks * 16 + hf * 8);
        f32x16 o[4]; float lsum = 0.f;
#pragma unroll
        for (int dt = 0; dt < 4; ++dt)
#pragma unroll
            for (int k = 0; k < 16; ++k) o[dt][k] = 0.f;
        att_tile<true>(lds, qf, qpos, shift, i * 256, wave + 1, wave, false, 0.f, o, lsum, r, hf);
        lsum += __shfl_xor(lsum, 32);
        __syncthreads();
        LAS unsigned char* stg = lds + wave * 16384;
        LAS float* lst = (LAS float*)(lds + ATT_LST) + wave * 32;
#pragma unroll
        for (int dt = 0; dt < 4; ++dt)
#pragma unroll
            for (int k = 0; k < 16; ++k) *(LAS float*)(stg + crow(k, hf) * 512 + (32 * dt + r) * 4) = o[dt][k];
        if (hf == 0) lst[r] = lsum;
#pragma unroll
        for (int it = 0; it < 8; ++it) { const int item = it * 64 + lane, rho = item >> 4, ch = item & 15;
            const size_t row2 = (size_t)b * SEQ + i * 256 + 32 * wave + rho;
            const f32x4 a0 = *(const LAS f32x4*)(stg + rho * 512 + ch * 32), a1 = *(const LAS f32x4*)(stg + rho * 512 + ch * 32 + 16);
            float acc[8] = {a0.x, a0.y, a0.z, a0.w, a1.x, a1.y, a1.z, a1.w};
            float l = lst[rho];
            const i32x4 s4 = SEL[row2 * 8 + h];
#pragma unroll
            for (int k = 0; k < 3; ++k) { const int sk = (k == 0) ? s4.x : (k == 1 ? s4.y : s4.z);
                if (sk >= 0) { const u32x4 pv = *(const u32x4*)(opart_base(a, k) + (row2 * 8 + h) * 128 + ch * 8);
                    acc[0] += bflo(pv.x); acc[1] += bfhi(pv.x); acc[2] += bflo(pv.y); acc[3] += bfhi(pv.y); acc[4] += bflo(pv.z); acc[5] += bfhi(pv.z); acc[6] += bflo(pv.w); acc[7] += bfhi(pv.w);
                    l += LPART[(size_t)k * MTOK * 8 + row2 * 8 + h]; } }
            const u32x4 gv = *(const u32x4*)(Gb + row2 * 1024 + h * DH + ch * 8);
            const float rl = 1.0f / l;
            u32x4 ov; ov.x = pk2(acc[0] * rl * silu_f(bflo(gv.x)), acc[1] * rl * silu_f(bfhi(gv.x))); ov.y = pk2(acc[2] * rl * silu_f(bflo(gv.y)), acc[3] * rl * silu_f(bfhi(gv.y)));
            ov.z = pk2(acc[4] * rl * silu_f(bflo(gv.z)), acc[5] * rl * silu_f(bfhi(gv.z))); ov.w = pk2(acc[6] * rl * silu_f(bflo(gv.w)), acc[7] * rl * silu_f(bfhi(gv.w)));
            *(u32x4*)(QK + row2 * 2048 + h * DH + ch * 8) = ov; }
        __syncthreads();
    }
}

DI void phase_mpre(const Args& a, LAS unsigned char* lds, int tid, int lane, int wave, int bid, int G) {
    const float* conv_w = a.in[5]; const float* conv_b = a.in[6]; const float* wq = a.in[7]; const float* wk = a.in[8]; const float* wv = a.in[9]; const float* b_if = a.in[11];
    const float* weff = (const float*)(a.ws + WS_WEFF);
    const bf16* XM = (const bf16*)(a.ws + WS_XM);
    bf16* QM = (bf16*)a.out; bf16* KM = (bf16*)((unsigned char*)a.out + 64 * MiB); bf16* VM = (bf16*)(a.ws + WS_XN); bf16* XC = (bf16*)(a.ws + WS_G);
    float* GLI = (float*)(a.ws + WS_GLI); float* GLF = (float*)(a.ws + WS_GLF);
    LAS float* red = (LAS float*)lds;
    const int tk = tid >> 8, n = tid & 255;
    float cw[4][4], cb[4], fq[16], fk[16], fv[16], wc[4][8], wm[4][8];
#pragma unroll
    for (int w = 0; w < 4; ++w) { const f32x4 t = *(const f32x4*)(conv_w + w * 1024 + 4 * n); cw[w][0] = t.x; cw[w][1] = t.y; cw[w][2] = t.z; cw[w][3] = t.w; }
    { const f32x4 t = *(const f32x4*)(conv_b + 4 * n); cb[0] = t.x; cb[1] = t.y; cb[2] = t.z; cb[3] = t.w; }
#pragma unroll
    for (int k = 0; k < 16; ++k) { fq[k] = wq[n * 16 + k]; fk[k] = wk[n * 16 + k] * 0.0625f; fv[k] = wv[n * 16 + k]; }
#pragma unroll
    for (int i = 0; i < 4; ++i)
#pragma unroll
        for (int g = 0; g < 8; ++g) { wc[i][g] = weff[(4 * n + i) * 8 + g]; wm[i][g] = weff[8192 + (4 * n + i) * 8 + g]; }
    for (int tp = bid; tp < MTOK / 2; tp += G) {
        const int m = 2 * tp + tk, s = m & (SEQ - 1);
        float xw[4][4];
#pragma unroll
        for (int w = 0; w < 4; ++w) {
            u32x2 v; v.x = 0u; v.y = 0u;
            if (s - 3 + w >= 0) v = *(const u32x2*)(XM + (size_t)(m - 3 + w) * 1024 + 4 * n);
            xw[w][0] = bflo(v.x); xw[w][1] = bfhi(v.x); xw[w][2] = bflo(v.y); xw[w][3] = bfhi(v.y);
        }
        float xc[4];
#pragma unroll
        for (int c = 0; c < 4; ++c) { float y = cb[c];
#pragma unroll
            for (int w = 0; w < 4; ++w) y += xw[w][c] * cw[w][c];
            xc[c] = silu_f(y); }
        float qo[4], ko[4], vo[4];
#pragma unroll
        for (int o = 0; o < 4; ++o) { float sq = 0.f, sk = 0.f, sv = 0.f;
#pragma unroll
            for (int i = 0; i < 4; ++i) { sq += xc[i] * fq[i * 4 + o]; sk += xc[i] * fk[i * 4 + o]; sv += xw[3][i] * fv[i * 4 + o]; }
            qo[o] = sq; ko[o] = sk; vo[o] = sv; }
        float gp[8];
#pragma unroll
        for (int g = 0; g < 8; ++g) { float sg = 0.f;
#pragma unroll
            for (int i = 0; i < 4; ++i) sg += xc[i] * wc[i][g] + xw[3][i] * wm[i][g];
            gp[g] = sg; }
        const size_t off = (size_t)m * 1024 + 4 * n;
        { u32x2 o; o.x = pk2(qo[0], qo[1]); o.y = pk2(qo[2], qo[3]); *(u32x2*)(QM + off) = o; }
        { u32x2 o; o.x = pk2(ko[0], ko[1]); o.y = pk2(ko[2], ko[3]); *(u32x2*)(KM + off) = o; }
        { u32x2 o; o.x = pk2(vo[0], vo[1]); o.y = pk2(vo[2], vo[3]); *(u32x2*)(VM + off) = o; }
        { u32x2 o; o.x = pk2(xc[0], xc[1]); o.y = pk2(xc[2], xc[3]); *(u32x2*)(XC + off) = o; }
#pragma unroll
        for (int g = 0; g < 8; ++g) gp[g] = wave_sum(gp[g]);
        if (lane == 0) {
#pragma unroll
            for (int g = 0; g < 8; ++g) red[(tk * 4 + (wave & 3)) * 8 + g] = gp[g]; }
        __syncthreads();
        if (tid < 16) { const int t2 = tid >> 3, g = tid & 7; const int m2 = 2 * tp + t2, s2 = m2 & (SEQ - 1), b2 = m2 >> 13;
            const float gate = red[(t2 * 4 + 0) * 8 + g] + red[(t2 * 4 + 1) * 8 + g] + red[(t2 * 4 + 2) * 8 + g] + red[(t2 * 4 + 3) * 8 + g] + b_if[g];
            if (g < 4) GLI[(size_t)(b2 * 4 + g) * SEQ + s2] = gate;
            else GLF[(size_t)(b2 * 4 + g - 4) * SEQ + s2] = fminf(gate, 0.f) - log1pf(__expf(-fabsf(gate))); }
        __syncthreads();
    }
}

constexpr int MC_QI = 0, MC_QROW = 528, MC_KI = 33792, MC_KT = 67584, MC_TROW = 144, MC_VT = 104448, MC_P = 141312, MC_SC = 150528, MC_NV = 153600, MC_MISC = 154624;
constexpr int MC_STROW = 1040;
DI LAS float* mc_sc(LAS unsigned char* lds, int k) { return (LAS float*)(lds + MC_SC + k * 256); }
DI void phase_mscan(const Args& a, LAS unsigned char* lds, int tid, int lane0, int wave, int bid, int G) {
    const bf16* QM = (const bf16*)a.out; const bf16* KM = (const bf16*)((unsigned char*)a.out + 64 * MiB); const bf16* VM = (const bf16*)(a.ws + WS_XN); const bf16* XC = (const bf16*)(a.ws + WS_G);
    const bf16* ZM = (const bf16*)(a.ws + WS_ZM); bf16* QK = (bf16*)(a.ws + WS_QK);
    const float* GLI = (const float*)(a.ws + WS_GLI); const float* GLF = (const float*)(a.ws + WS_GLF);
    const float* mh_norm = a.in[12]; const float* skip = a.in[13];
    LAS float* nvec = (LAS float*)(lds + MC_NV); LAS float* misc = (LAS float*)(lds + MC_MISC);
#define OPQ(name) int name = tid; asm volatile("" : "+v"(name))
    for (int u = bid; u < BATCH * MH; u += G) {
        const int bh = u, b = bh >> 2, hd = bh & 3;
        f32x16 C[8];
#pragma unroll
        for (int dt = 0; dt < 8; ++dt)
#pragma unroll
            for (int i = 0; i < 16; ++i) C[dt][i] = 0.f;
        if (tid < 256) nvec[tid] = 0.f;
        float mrun = 0.f;
        for (int c = 0; c < NCH; ++c) {
            const size_t rowbase = (size_t)b * SEQ + (size_t)c * LCH;
            { OPQ(tA); const int laneA = tA & 63;
#pragma unroll
            for (int it = 0; it < 4; ++it) { const int p = it * NTHR + tA, t = p >> 5, ch = p & 31;
                const u32x4 vq = *(const u32x4*)(QM + (rowbase + t) * 1024 + hd * MD + ch * 8); const u32x4 vk = *(const u32x4*)(KM + (rowbase + t) * 1024 + hd * MD + ch * 8);
                *(LAS u32x4*)(lds + MC_QI + t * MC_QROW + ch * 16) = vq; *(LAS u32x4*)(lds + MC_KI + t * MC_QROW + ch * 16) = vk; }
#pragma unroll
            for (int cc = 0; cc < 4; ++cc) { const int c8 = wave + 8 * cc;
                const u32x4 vk = *(const u32x4*)(KM + (rowbase + laneA) * 1024 + hd * MD + c8 * 8); const u32x4 vv = *(const u32x4*)(VM + (rowbase + laneA) * 1024 + hd * MD + c8 * 8);
                LAS unsigned short* dk = (LAS unsigned short*)(lds + MC_KT + (c8 * 8) * MC_TROW + laneA * 2); LAS unsigned short* dv = (LAS unsigned short*)(lds + MC_VT + (c8 * 8) * MC_TROW + laneA * 2);
                dk[0 * 72] = (unsigned short)(vk.x & 0xffffu); dk[1 * 72] = (unsigned short)(vk.x >> 16); dk[2 * 72] = (unsigned short)(vk.y & 0xffffu); dk[3 * 72] = (unsigned short)(vk.y >> 16);
                dk[4 * 72] = (unsigned short)(vk.z & 0xffffu); dk[5 * 72] = (unsigned short)(vk.z >> 16); dk[6 * 72] = (unsigned short)(vk.w & 0xffffu); dk[7 * 72] = (unsigned short)(vk.w >> 16);
                dv[0 * 72] = (unsigned short)(vv.x & 0xffffu); dv[1 * 72] = (unsigned short)(vv.x >> 16); dv[2 * 72] = (unsigned short)(vv.y & 0xffffu); dv[3 * 72] = (unsigned short)(vv.y >> 16);
                dv[4 * 72] = (unsigned short)(vv.z & 0xffffu); dv[5 * 72] = (unsigned short)(vv.z >> 16); dv[6 * 72] = (unsigned short)(vv.w & 0xffffu); dv[7 * 72] = (unsigned short)(vv.w >> 16); }
            if (wave == 0) {
                const float lf = GLF[(size_t)bh * SEQ + c * LCH + laneA], li = GLI[(size_t)bh * SEQ + c * LCH + laneA];
                float bc = lf;
#pragma unroll
                for (int o = 1; o < 64; o <<= 1) { const float t = __shfl_up(bc, o); if (laneA >= o) bc += t; }
                const float av = li - bc; float cm = av;
#pragma unroll
                for (int o = 1; o < 64; o <<= 1) { const float t = __shfl_up(cm, o); if (laneA >= o) cm = fmaxf(cm, t); }
                const float gv = fmaxf(mrun, cm); const float Gc = __shfl(gv, 63), bL = __shfl(bc, 63);
                mc_sc(lds, 0)[laneA] = av; mc_sc(lds, 1)[laneA] = gv; mc_sc(lds, 2)[laneA] = __expf(mrun - gv); mc_sc(lds, 3)[laneA] = __expf(av - Gc); mc_sc(lds, 4)[laneA] = __expf(-(bc + gv));
                if (laneA == 0) misc[0] = __expf(mrun - Gc);
                mrun = bL + Gc;
            } }
            __syncthreads();
            { OPQ(tB); const int laneB = tB & 63, l15 = laneB & 15, l4 = laneB >> 4;
                const int tt = wave >> 1;
#pragma unroll
                for (int sti = 0; sti < 2; ++sti) { const int st = 2 * (wave & 1) + sti;
                    f32x4 acc4 = {0.f, 0.f, 0.f, 0.f};
                    if (st <= tt) {
#pragma unroll
                        for (int ks = 0; ks < 8; ++ks) { const bf16x8 A = *(const LAS bf16x8*)(lds + MC_QI + (16 * tt + l15) * MC_QROW + ks * 64 + l4 * 16);
                            const bf16x8 B = *(const LAS bf16x8*)(lds + MC_KI + (16 * st + l15) * MC_QROW + ks * 64 + l4 * 16); acc4 = MFMA16(A, B, acc4); }
                    }
                    const int sidx = 16 * st + l15; const float as_ = mc_sc(lds, 0)[sidx];
#pragma unroll
                    for (int rg = 0; rg < 4; ++rg) { const int t = 16 * tt + 4 * l4 + rg; float p = 0.f;
                        if (st <= tt && sidx <= t) p = acc4[rg] * __expf(as_ - mc_sc(lds, 1)[t]);
                        *(LAS unsigned short*)(lds + MC_P + t * MC_TROW + sidx * 2) = (unsigned short)f2bf(p);
                        float sum = p; sum += __shfl_xor(sum, 1); sum += __shfl_xor(sum, 2); sum += __shfl_xor(sum, 4); sum += __shfl_xor(sum, 8);
                        if (l15 == 0) mc_sc(lds, 7 + st)[t] = sum; }
                }
              const int t = tB >> 3, seg = tB & 7; float sacc = 0.f;
#pragma unroll
                for (int k = 0; k < 4; ++k) { const u32x4 qv = *(const LAS u32x4*)(lds + MC_QI + t * MC_QROW + (seg * 32 + k * 8) * 2);
                    const f32x4 n0 = *(const LAS f32x4*)(nvec + seg * 32 + k * 8), n1 = *(const LAS f32x4*)(nvec + seg * 32 + k * 8 + 4);
                    sacc += bflo(qv.x) * n0.x + bfhi(qv.x) * n0.y + bflo(qv.y) * n0.z + bfhi(qv.y) * n0.w + bflo(qv.z) * n1.x + bfhi(qv.z) * n1.y + bflo(qv.w) * n1.z + bfhi(qv.w) * n1.w; }
                sacc += __shfl_xor(sacc, 1); sacc += __shfl_xor(sacc, 2); sacc += __shfl_xor(sacc, 4);
                if (seg == 0) mc_sc(lds, 5)[t] = sacc; }
            __syncthreads();
            const float cd = misc[0];
            f32x16 acc[2];
            { OPQ(tC); const int laneC = tC & 63, r = laneC & 31, hf = laneC >> 5;
            if (tC < 64) { const int t = tC; const float den = mc_sc(lds, 7)[t] + mc_sc(lds, 8)[t] + mc_sc(lds, 9)[t] + mc_sc(lds, 10)[t];
                const float dn = den + mc_sc(lds, 2)[t] * mc_sc(lds, 5)[t]; mc_sc(lds, 6)[t] = 1.0f / fmaxf(fabsf(dn), mc_sc(lds, 4)[t]); }
#pragma unroll
            for (int t2 = 0; t2 < 2; ++t2)
#pragma unroll
                for (int i = 0; i < 16; ++i) acc[t2][i] = 0.f;
            const LAS unsigned char* qbase = lds + MC_QI + r * MC_QROW + hf * 8;
#pragma unroll
            for (int dt = 0; dt < 8; ++dt) { const bf16x8 cl = pack_lo(C[dt]), chh = pack_hi(C[dt]);
#pragma unroll
                for (int t2 = 0; t2 < 2; ++t2) { const LAS unsigned char* qb = qbase + t2 * 32 * MC_QROW + dt * 64;
                    const s16x4 a0l = *(const LAS s16x4*)(qb), a0h = *(const LAS s16x4*)(qb + 16), a1l = *(const LAS s16x4*)(qb + 32), a1h = *(const LAS s16x4*)(qb + 48);
                    acc[t2] = MFMA32(__builtin_shufflevector(a0l, a0h, 0, 1, 2, 3, 4, 5, 6, 7), cl, acc[t2]);
                    acc[t2] = MFMA32(__builtin_shufflevector(a1l, a1h, 0, 1, 2, 3, 4, 5, 6, 7), chh, acc[t2]); } }
#pragma unroll
            for (int t2 = 0; t2 < 2; ++t2)
#pragma unroll
                for (int i = 0; i < 16; ++i) acc[t2][i] *= mc_sc(lds, 2)[32 * t2 + crow(i, hf)];
            bf16x8 vt[4];
            const LAS unsigned char* vbase = lds + MC_VT + (32 * wave + r) * MC_TROW + hf * 16;
#pragma unroll
            for (int ks = 0; ks < 4; ++ks) vt[ks] = *(const LAS bf16x8*)(vbase + ks * 32);
            const LAS unsigned char* pbase = lds + MC_P + r * MC_TROW + hf * 16;
#pragma unroll
            for (int t2 = 0; t2 < 2; ++t2)
#pragma unroll
                for (int ks = 0; ks < 4; ++ks) { const bf16x8 pA = *(const LAS bf16x8*)(pbase + t2 * 32 * MC_TROW + ks * 32); acc[t2] = MFMA32(pA, vt[ks], acc[t2]); }
            asm volatile("" : "+v"(acc[0]), "+v"(acc[1]));
#pragma unroll
            for (int ks = 0; ks < 4; ++ks) {
                const f32x4 w0 = *(const LAS f32x4*)(mc_sc(lds, 3) + 16 * ks + 8 * hf), w1 = *(const LAS f32x4*)(mc_sc(lds, 3) + 16 * ks + 8 * hf + 4);
                const u32x4 vv = __builtin_bit_cast(u32x4, vt[ks]); u32x4 o;
                o.x = pk2(bflo(vv.x) * w0.x, bfhi(vv.x) * w0.y); o.y = pk2(bflo(vv.y) * w0.z, bfhi(vv.y) * w0.w); o.z = pk2(bflo(vv.z) * w1.x, bfhi(vv.z) * w1.y); o.w = pk2(bflo(vv.w) * w1.z, bfhi(vv.w) * w1.w);
                vt[ks] = __builtin_bit_cast(bf16x8, o); }
            const LAS unsigned char* kbase = lds + MC_KT + r * MC_TROW + hf * 16;
#pragma unroll
            for (int dt = 0; dt < 8; ++dt) {
#pragma unroll
                for (int i = 0; i < 16; ++i) C[dt][i] *= cd;
#pragma unroll
                for (int ks = 0; ks < 4; ++ks) { const bf16x8 kA = *(const LAS bf16x8*)(kbase + dt * 32 * MC_TROW + ks * 32); C[dt] = MFMA32(kA, vt[ks], C[dt]); } }
            if (tC < 256) { float sacc = cd * nvec[tC];
#pragma unroll
                for (int k = 0; k < 8; ++k) { const u32x4 kv = *(const LAS u32x4*)(lds + MC_KT + tC * MC_TROW + k * 16);
                    const f32x4 w0 = *(const LAS f32x4*)(mc_sc(lds, 3) + k * 8), w1 = *(const LAS f32x4*)(mc_sc(lds, 3) + k * 8 + 4);
                    sacc += bflo(kv.x) * w0.x + bfhi(kv.x) * w0.y + bflo(kv.y) * w0.z + bfhi(kv.y) * w0.w + bflo(kv.z) * w1.x + bfhi(kv.z) * w1.y + bflo(kv.w) * w1.z + bfhi(kv.w) * w1.w; }
                nvec[tC] = sacc; }
            }
            __syncthreads();
            { OPQ(tD); const int laneD = tD & 63, r = laneD & 31, hf = laneD >> 5;
#pragma unroll
            for (int t2 = 0; t2 < 2; ++t2)
#pragma unroll
                for (int i = 0; i < 16; ++i) *(LAS float*)(lds + MC_QI + (32 * t2 + crow(i, hf)) * MC_STROW + (32 * wave + r) * 4) = acc[t2][i];
            }
            __syncthreads();
            { OPQ(tE); const int t = tE >> 3, seg = tE & 7; const float rden = mc_sc(lds, 6)[t]; float s1 = 0.f, s2 = 0.f;
                const LAS unsigned char* sp = lds + MC_QI + t * MC_STROW + (seg * 32) * 4;
#pragma unroll
                for (int k = 0; k < 8; ++k) { const f32x4 v = *(const LAS f32x4*)(sp + k * 16) * rden;
                    s1 += (v.x + v.y) + (v.z + v.w); s2 += (v.x * v.x + v.y * v.y) + (v.z * v.z + v.w * v.w); }
                s1 += __shfl_xor(s1, 1); s1 += __shfl_xor(s1, 2); s1 += __shfl_xor(s1, 4); s2 += __shfl_xor(s2, 1); s2 += __shfl_xor(s2, 2); s2 += __shfl_xor(s2, 4);
                const float mean = s1 * (1.0f / MD); const float var = fmaxf(s2 * (1.0f / MD) - mean * mean, 0.f); const float rstd = 1.0f / sqrtf(var + LN_EPS);
                const float sc = rden * rstd, sh = -mean * rstd;
                const size_t row = rowbase + t; const int col = hd * MD + seg * 32;
#pragma unroll 1
                for (int k = 0; k < 4; ++k) { const u32x4 xv = *(const u32x4*)(XC + row * 1024 + col + k * 8); const u32x4 zv = *(const u32x4*)(ZM + row * 1024 + col + k * 8);
                    const f32x4 g0 = *(const f32x4*)(mh_norm + col + k * 8), g1 = *(const f32x4*)(mh_norm + col + k * 8 + 4), k0 = *(const f32x4*)(skip + col + k * 8), k1 = *(const f32x4*)(skip + col + k * 8 + 4);
                    const f32x4 h0 = *(const LAS f32x4*)(sp + k * 32) * sc + sh, h1 = *(const LAS f32x4*)(sp + k * 32 + 16) * sc + sh;
                    float y[8];
                    y[0] = (h0.x * g0.x + k0.x * bflo(xv.x)) * silu_f(bflo(zv.x)); y[1] = (h0.y * g0.y + k0.y * bfhi(xv.x)) * silu_f(bfhi(zv.x));
                    y[2] = (h0.z * g0.z + k0.z * bflo(xv.y)) * silu_f(bflo(zv.y)); y[3] = (h0.w * g0.w + k0.w * bfhi(xv.y)) * silu_f(bfhi(zv.y));
                    y[4] = (h1.x * g1.x + k1.x * bflo(xv.z)) * silu_f(bflo(zv.z)); y[5] = (h1.y * g1.y + k1.y * bfhi(xv.z)) * silu_f(bfhi(zv.z));
                    y[6] = (h1.z * g1.z + k1.z * bflo(xv.w)) * silu_f(bflo(zv.w)); y[7] = (h1.w * g1.w + k1.w * bfhi(xv.w)) * silu_f(bfhi(zv.w));
                    u32x4 o; o.x = pk2(y[0], y[1]); o.y = pk2(y[2], y[3]); o.z = pk2(y[4], y[5]); o.w = pk2(y[6], y[7]);
                    *(u32x4*)(QK + row * 2048 + 1024 + col + k * 8) = o; } }
            __syncthreads();
        }
    }
#undef OPQ
}

DI void phase_final(const Args& a, int lane, int wave, int bid, int G) {
    const float* x = a.in[0]; const float* g_post = a.in[3]; float* out = a.out;
    const int gw = bid * NWAVES + wave, NGW = G * NWAVES;
    const f32x4* gr = (const f32x4*)g_post + lane; f32x4 gg[4];
#pragma unroll
    for (int j = 0; j < 4; ++j) gg[j] = gr[64 * j];
    for (int m = gw; m < MTOK; m += NGW) {
        f32x4* yr = (f32x4*)(out + (size_t)m * DM) + lane; const f32x4* xr = (const f32x4*)(x + (size_t)m * DM) + lane; f32x4 v[4], xv[4]; float s = 0.f;
#pragma unroll
        for (int j = 0; j < 4; ++j) { v[j] = yr[64 * j]; xv[j] = xr[64 * j]; s += (v[j].x * v[j].x + v[j].y * v[j].y) + (v[j].z * v[j].z + v[j].w * v[j].w); }
        const float rstd = 1.0f / sqrtf(wave_sum(s) * (1.0f / DM) + RMS_EPS);
#pragma unroll
        for (int j = 0; j < 4; ++j) { f32x4 o; o.x = xv[j].x + v[j].x * rstd * gg[j].x; o.y = xv[j].y + v[j].y * rstd * gg[j].y; o.z = xv[j].z + v[j].z * rstd * gg[j].z; o.w = xv[j].w + v[j].w * rstd * gg[j].w; yr[64 * j] = o; }
    }
}

constexpr int NPHASE = 10;
#ifndef MK_MULTI
#define MK_MULTI 0
#endif
__global__ void __launch_bounds__(NTHR, 2) hymba_fwd(Args args) {
    extern __shared__ __attribute__((aligned(16))) unsigned char lds_raw[];
    LAS unsigned char* lds = (LAS unsigned char*)lds_raw;
    cg::grid_group grid = cg::this_grid();
    const int tid = threadIdx.x, lane = tid & 63, wave = __builtin_amdgcn_readfirstlane(tid >> 6), bid = blockIdx.x, G = gridDim.x;
    const int lo = args.ph_lo, hi = args.ph_hi;
#ifdef ONLY_PHASE
#define IN(k) ((k) == ONLY_PHASE && lo <= (k) && (k) < hi)
#else
#define IN(k) (lo <= (k) && (k) < hi)
#endif
#define SEAM(k) do { if (IN(k) && IN((k) + 1)) grid.sync(); } while (0)
    unsigned char* ws = args.ws;
    if (IN(0)) { phase_prologue(args, lds, tid, lane, wave, bid, G); } SEAM(0);
    if (IN(1)) {
        pg8::Gemm g{(const pg8::bf16_t*)(ws + WS_XN), (const pg8::bf16_t*)(ws + WS_WINT), MTOK, NIN, DM}; pg8::StaticOrder S; S.init(MTOK, NIN, G, bid);
        pg8::EpiProj E{(pg8::bf16_t*)(ws + WS_QK), (pg8::bf16_t*)(ws + WS_V), (pg8::bf16_t*)(ws + WS_G), (pg8::bf16_t*)(ws + WS_XM), (pg8::bf16_t*)(ws + WS_ZM), QSCALE};
        pg8::gemm_phase<pg8::EpiProj, pg8::StaticOrder, true, true>(lds, g, S, E);
    } SEAM(1);
    if (IN(2)) { phase_kstat(args, lds, tid, lane, wave, bid, G); } SEAM(2);
    if (IN(3)) { phase_sel(args, lds, tid, lane, wave, bid, G); } SEAM(3);
    if (IN(4)) { phase_att_gather(args, lds, tid, lane, wave, bid, G); } SEAM(4);
    if (IN(5)) { phase_att_own(args, lds, tid, lane, wave, bid, G); } SEAM(5);
    if (IN(6)) { phase_mpre(args, lds, tid, lane, wave, bid, G); } SEAM(6);
    if (IN(7)) { phase_mscan(args, lds, tid, lane, wave, bid, G); } SEAM(7);
    if (IN(8)) {
        pg8::Gemm g{(const pg8::bf16_t*)(ws + WS_QK), (const pg8::bf16_t*)(ws + WS_WOUTT), MTOK, DM, MIXW}; pg8::StaticOrder S; S.init(MTOK, DM, G, bid);
        pg8::EpiF32 E{args.out, DM};
        pg8::gemm_phase<pg8::EpiF32, pg8::StaticOrder, true, true>(lds, g, S, E);
    } SEAM(8);
    if (IN(9)) { phase_final(args, lane, wave, bid, G); }
#undef IN
#undef SEAM
}

extern "C" void kernel_launch(void* const* d_in, const int* in_sizes, int n_in, void* d_out, int out_size, void* d_ws, size_t ws_size, hipStream_t stream) {
    static int grid = 0;
    if (grid == 0) {
        if (n_in != 15 || out_size != MTOK * DM || ws_size < WS_END) { fprintf(stderr, "kernel_launch: unexpected shapes (n_in %d out %d ws %zu)\n", n_in, out_size, ws_size); grid = -1; return; }
        int dev = 0, cus = 0, per_cu = 0;
        if (hipGetDevice(&dev) != hipSuccess || hipDeviceGetAttribute(&cus, hipDeviceAttributeMultiprocessorCount, dev) != hipSuccess) { grid = -1; return; }
        if (hipFuncSetAttribute((const void*)hymba_fwd, hipFuncAttributeMaxDynamicSharedMemorySize, LDS_BYTES) != hipSuccess) { fprintf(stderr, "kernel_launch: hipFuncSetAttribute failed\n"); grid = -1; return; }
        if (hipOccupancyMaxActiveBlocksPerMultiprocessor(&per_cu, (const void*)hymba_fwd, NTHR, LDS_BYTES) != hipSuccess || per_cu < 1) { fprintf(stderr, "kernel_launch: occupancy query says %d\n", per_cu); per_cu = 1; }
        (void)hipGetLastError();
        grid = cus * 1;
        fprintf(stderr, "kernel_launch: grid %d (cus %d, query per_cu %d)\n", grid, cus, per_cu);
    }
    if (grid < 0) return;
    (void)hipMemsetAsync((char*)d_ws + WS_CTL, 0, CTL_ZERO_BYTES, stream);
    Args a{};
    for (int i = 0; i < 15; ++i) a.in[i] = (const float*)d_in[i];
    a.out = (float*)d_out; a.ws = (unsigned char*)d_ws;
#if MK_MULTI
    for (int p = 0; p < NPHASE; ++p) { a.ph_lo = p; a.ph_hi = p + 1; hipLaunchKernelGGL(hymba_fwd, dim3(grid), dim3(NTHR), LDS_BYTES, stream, a); }
#else
    a.ph_lo = 0; a.ph_hi = NPHASE;
    void* kargs[] = {&a};
    hipError_t e = hipLaunchCooperativeKernel((const void*)hymba_fwd, dim3(grid), dim3(NTHR), kargs, LDS_BYTES, stream);
    if (e != hipSuccess) fprintf(stderr, "kernel_launch: cooperative launch failed: %s (grid %d)\n", hipGetErrorString(e), grid);
#endif
}
```

```cpp
#include <hip/hip_runtime.h>
#include <hip/hip_cooperative_groups.h>
#include <cstdio>
#include <cstdint>
namespace cg = cooperative_groups;
namespace pg8 {
#define PG8_LAS __attribute__((address_space(3)))
typedef unsigned short bf16_t;
typedef short bf16x8 __attribute__((ext_vector_type(8)));
typedef float f32x4 __attribute__((ext_vector_type(4)));
typedef unsigned u32x4 __attribute__((ext_vector_type(4)));
constexpr int BM = 256, BK = 64, HALF = 128, HTB = HALF * BK * 2  , STAGE_BYTES = 8 * HTB, NXCD = 8, WGM = 8;

__host__ __device__ __forceinline__ int lds_byte(int r, int c) { const int st = (r >> 4) * 2 + (c >> 5), rr = r & 15, cc = c & 31, ob = rr * 64 + cc * 2; return st * 1024 + (ob ^ (((ob >> 9) & 1) << 5)); }
__host__ __device__ __forceinline__ void stage_rc(int b, int& R, int& C) { const int st = b / 1024, sb = b % 1024, swz = sb ^ (((sb >> 9) & 1) << 5); R = (st >> 1) * 16 + swz / 64; C = (st & 1) * 32 + (swz % 64) / 2; }
__host__ __device__ __forceinline__ int perm32(int rho) { const int n = rho >> 4, i = rho & 15; return 8 * (i >> 2) + 4 * n + (i & 3); }

struct Unit { int pm, pn; };
struct Gemm { const bf16_t* A; const bf16_t* Bt; int M, N, K; };

struct StaticOrder {
    int nM, nN, nwg, G, c;
    __host__ __device__ void init(int M, int N, int G_, int c_) { nM = M / BM; nN = N / BM; nwg = nM * nN; G = G_; c = c_; }
    __host__ __device__ bool next(int i, Unit& u) const {
        const long L = (long)i * G + c; if (L >= nwg) return false;
        int wgid = (int)L; { const int q = nwg / NXCD, r = nwg % NXCD, xcd = wgid % NXCD, off = wgid / NXCD; wgid = (xcd < r ? xcd * (q + 1) : r * (q + 1) + (xcd - r) * q) + off; }
        const int nig = WGM * nN, gid = wgid / nig, fm = gid * WGM, gsz = (nM - fm) < WGM ? (nM - fm) : WGM;
        u.pm = fm + ((wgid % nig) % gsz); u.pn = (wgid % nig) / gsz; return true;
    }
    __device__ __forceinline__ void a_ready(const Unit&) const {}
    __device__ __forceinline__ void done(const Unit&) const {}
};

__device__ __forceinline__ unsigned cvt_pk_bf16(float lo, float hi) { unsigned r; asm volatile("v_cvt_pk_bf16_f32 %0, %1, %2" : "=v"(r) : "v"(lo), "v"(hi)); return r; }
typedef float f32x2 __attribute__((ext_vector_type(2)));
struct EpiProj {
    static constexpr bool PERM = true, AFTER_DRAIN = false;
    bf16_t* QK; bf16_t* V; bf16_t* G; bf16_t* XM; bf16_t* ZM; float qscale;
    __device__ __forceinline__ void operator()(const f32x4 (&acc)[2][2][4][2], const Unit& u, int wr, int wc, int fr, int fq) const {
        const int row0 = u.pm * BM + wr * 64 + fr; const int colt = u.pn * BM; const int t = colt >> 10; const int cgp = colt & 1023;
        bf16_t* base; int ldc; float sc = 1.f;
        if (t == 0) { base = QK; ldc = 2048; sc = qscale; } else if (t == 1) { base = QK + 1024; ldc = 2048; } else if (t == 2) { base = V; ldc = 1024; }
        else if (t == 3) { base = G; ldc = 1024; } else if (t == 4) { base = XM; ldc = 1024; } else { base = ZM; ldc = 1024; }
        const int col0 = cgp + wc * 32 + 8 * fq;
#pragma unroll
        for (int ai = 0; ai < 2; ++ai)
#pragma unroll
            for (int m = 0; m < 4; ++m) { bf16_t* rowp = base + (size_t)(row0 + ai * HALF + m * 16) * ldc + col0;
#pragma unroll
                for (int bj = 0; bj < 2; ++bj) { f32x4 v0 = acc[ai][bj][m][0] * sc, v1 = acc[ai][bj][m][1] * sc;
                    u32x4 w; w.x = cvt_pk_bf16(v0[0], v0[1]); w.y = cvt_pk_bf16(v0[2], v0[3]); w.z = cvt_pk_bf16(v1[0], v1[1]); w.w = cvt_pk_bf16(v1[2], v1[3]);
                    *(u32x4*)(rowp + bj * HALF) = w; } }
    }
};
struct EpiF32 {
    static constexpr bool PERM = false, AFTER_DRAIN = false;
    float* O; int ldc;
    __device__ __forceinline__ void operator()(const f32x4 (&acc)[2][2][4][2], const Unit& u, int wr, int wc, int fr, int fq) const {
        const int col0 = u.pn * BM + wc * 32 + 4 * fq;
#pragma unroll
        for (int ai = 0; ai < 2; ++ai)
#pragma unroll
            for (int m = 0; m < 4; ++m) { const int r = ai * HALF + wr * 64 + m * 16 + fr; const size_t off = (size_t)(u.pm * BM + r) * ldc + col0;
#pragma unroll
                for (int bj = 0; bj < 2; ++bj)
#pragma unroll
                    for (int n = 0; n < 2; ++n) *(f32x4*)(O + off + bj * HALF + n * 16) = acc[ai][bj][m][n]; }
    }
};
template <class Epi, class Sched, bool ALIGN_EPI = false, bool SP2 = false>
__device__ __forceinline__ void gemm_phase(PG8_LAS unsigned char* lds, const Gemm g, const Sched& S, const Epi& E) {
    const int tid = threadIdx.x, wid = __builtin_amdgcn_readfirstlane(tid >> 6), lane = tid & 63, wr = wid >> 2, wc = wid & 3, fr = lane & 15, fq = lane >> 4;
    const int K = g.K, nt = K / BK;
    unsigned voffA[2], voffB[2];
#pragma unroll
    for (int i = 0; i < 2; ++i) { int R, C; stage_rc(tid * 16 + i * 8192, R, C); const int Rb = Epi::PERM ? ((R & ~31) + perm32(R & 31)) : R;
        voffA[i] = (unsigned)(R * K + C) * 2u; voffB[i] = (unsigned)(Rb * K + C) * 2u; }
    const size_t kstep = (size_t)(BK * 2);
    const size_t hstep = (size_t)HALF * K * 2;
    const size_t tstep = 2 * hstep;
    const unsigned ldsw = (unsigned)wid * 1024u;
    const int aoff = lds_byte(wr * 64 + fr, fq * 8), boff = lds_byte(wc * 32 + fr, fq * 8);
#define PG8_SA(b, h) (((b) * 2 + (h)) * HTB)
#define PG8_SB(b, h) ((4 + (b) * 2 + (h)) * HTB)
#define PG8_STAGE(bufoff, gbase, voff) do { _Pragma("unroll") for (int _i = 0; _i < 2; ++_i) \
        __builtin_amdgcn_global_load_lds((const unsigned*)((const char*)(gbase) + (voff)[_i]), (PG8_LAS unsigned*)(lds + (bufoff) + ldsw + _i * 8192), 16, 0, 0); } while (0)
#define PG8_LDA(dst, b, h) do { _Pragma("unroll") for (int m = 0; m < 4; ++m) _Pragma("unroll") for (int k = 0; k < 2; ++k) dst[m][k] = *(const PG8_LAS bf16x8*)(lds + PG8_SA(b, h) + aoff + m * 2048 + k * 1024); } while (0)
#define PG8_LDB(dst, b, h) do { _Pragma("unroll") for (int n = 0; n < 2; ++n) _Pragma("unroll") for (int k = 0; k < 2; ++k) dst[n][k] = *(const PG8_LAS bf16x8*)(lds + PG8_SB(b, h) + boff + n * 2048 + k * 1024); } while (0)
#define PG8_MMA(ai, bj, At, Bt) do { __builtin_amdgcn_s_setprio(1); _Pragma("unroll") for (int m = 0; m < 4; ++m) _Pragma("unroll") for (int n = 0; n < 2; ++n) _Pragma("unroll") for (int k = 0; k < 2; ++k) \
        acc[ai][bj][m][n] = __builtin_amdgcn_mfma_f32_16x16x32_bf16(Bt[n][k], At[m][k], acc[ai][bj][m][n], 0, 0, 0); __builtin_amdgcn_s_setprio(0); } while (0)
#define PG8_WAIT_V(n) asm volatile("s_waitcnt vmcnt(" #n ")" ::: "memory")
#define PG8_WAIT_L(n) asm volatile("s_waitcnt lgkmcnt(" #n ")" ::: "memory")
#define PG8_BAR __builtin_amdgcn_s_barrier()
#define PG8_SCHED __builtin_amdgcn_sched_barrier(0)
    Unit cur, nxt; int ui = 0;
    if (!S.next(0, cur)) return;
    f32x4 acc[2][2][4][2];
#pragma unroll
    for (int a = 0; a < 2; ++a)
#pragma unroll
        for (int b = 0; b < 2; ++b)
#pragma unroll
            for (int m = 0; m < 4; ++m)
#pragma unroll
                for (int n = 0; n < 2; ++n) acc[a][b][m][n] = (f32x4){0.f, 0.f, 0.f, 0.f};
    bf16x8 At[4][2], B0[2][2], B1[2][2];
    const char* cA = (const char*)g.A + (size_t)cur.pm * tstep; const char* cB = (const char*)g.Bt + (size_t)cur.pn * tstep;
    S.a_ready(cur);
    if constexpr (SP2) {
        PG8_STAGE(PG8_SB(0, 0), cB, voffB); PG8_STAGE(PG8_SB(0, 1), cB + hstep, voffB); PG8_STAGE(PG8_SA(0, 0), cA, voffA); PG8_STAGE(PG8_SA(0, 1), cA + hstep, voffA);
        if (wr == 1) PG8_BAR;
        PG8_WAIT_V(2); PG8_BAR;
        PG8_STAGE(PG8_SB(1, 0), cB + kstep, voffB); PG8_STAGE(PG8_SA(1, 0), cA + kstep, voffA); PG8_STAGE(PG8_SB(1, 1), cB + hstep + kstep, voffB);
        PG8_WAIT_V(6); PG8_BAR;
    } else {
        PG8_STAGE(PG8_SB(0, 0), cB, voffB); PG8_STAGE(PG8_SA(0, 0), cA, voffA); PG8_STAGE(PG8_SB(0, 1), cB + hstep, voffB); PG8_STAGE(PG8_SA(0, 1), cA + hstep, voffA);
        if (wr == 1) PG8_BAR;
        PG8_WAIT_V(4); PG8_BAR;
        PG8_STAGE(PG8_SB(1, 0), cB + kstep, voffB); PG8_STAGE(PG8_SA(1, 0), cA + kstep, voffA); PG8_STAGE(PG8_SB(1, 1), cB + hstep + kstep, voffB);
        PG8_WAIT_V(6); PG8_BAR;
    }
    for (;;) {
        const bool has_next = S.next(ui + 1, nxt);
        const char* nA = has_next ? (const char*)g.A + (size_t)nxt.pm * tstep : cA; const char* nB = has_next ? (const char*)g.Bt + (size_t)nxt.pn * tstep : cB;
        for (int t = 0; t < nt; t += 2) {
            const bool last = (t == nt - 2);
            const char* a1 = cA + (size_t)(t + 1) * kstep;
            const char* a2 = last ? nA : cA + (size_t)(t + 2) * kstep; const char* b2 = last ? nB : cB + (size_t)(t + 2) * kstep;
            const char* a3 = a2 + kstep; const char* b3 = b2 + kstep;
            if (last && has_next) S.a_ready(nxt);
            if constexpr (SP2) {
            PG8_LDB(B0, 0, 0); PG8_LDB(B1, 0, 1); PG8_SCHED; PG8_LDA(At, 0, 0); PG8_STAGE(PG8_SA(1, 1), a1 + hstep, voffA);
            PG8_WAIT_V(8); PG8_WAIT_L(0); PG8_BAR; PG8_MMA(0, 0, At, B0); PG8_MMA(0, 1, At, B1); PG8_BAR; PG8_SCHED;
            PG8_LDA(At, 0, 1); PG8_STAGE(PG8_SB(0, 0), b2, voffB); PG8_STAGE(PG8_SB(0, 1), b2 + hstep, voffB); PG8_STAGE(PG8_SA(0, 0), a2, voffA);
            PG8_WAIT_V(8); PG8_WAIT_L(0); PG8_BAR; PG8_MMA(1, 0, At, B0); PG8_MMA(1, 1, At, B1); PG8_BAR; PG8_SCHED;
            PG8_LDB(B0, 1, 0); PG8_LDB(B1, 1, 1); PG8_SCHED; PG8_LDA(At, 1, 0); PG8_STAGE(PG8_SA(0, 1), a2 + hstep, voffA);
            PG8_WAIT_V(8); PG8_WAIT_L(0); PG8_BAR; PG8_MMA(0, 0, At, B0); PG8_MMA(0, 1, At, B1); PG8_BAR; PG8_SCHED;
            PG8_LDA(At, 1, 1); PG8_STAGE(PG8_SB(1, 0), b3, voffB); PG8_STAGE(PG8_SB(1, 1), b3 + hstep, voffB); PG8_STAGE(PG8_SA(1, 0), a3, voffA);
            PG8_WAIT_V(8); PG8_WAIT_L(0); PG8_BAR; PG8_MMA(1, 0, At, B0); PG8_MMA(1, 1, At, B1); PG8_BAR; PG8_SCHED;
            } else {
            PG8_LDB(B0, 0, 0); PG8_SCHED; PG8_LDA(At, 0, 0); PG8_STAGE(PG8_SA(1, 1), a1 + hstep, voffA);
            PG8_WAIT_L(8); PG8_BAR; PG8_WAIT_L(0); PG8_MMA(0, 0, At, B0); PG8_BAR; PG8_SCHED;
            PG8_LDB(B1, 0, 1); PG8_STAGE(PG8_SB(0, 0), b2, voffB);
            PG8_BAR; PG8_WAIT_L(0); PG8_MMA(0, 1, At, B1); PG8_BAR;
            PG8_LDA(At, 0, 1); PG8_STAGE(PG8_SA(0, 0), a2, voffA);
            PG8_BAR; PG8_WAIT_L(0); PG8_MMA(1, 0, At, B0); PG8_BAR; PG8_SCHED;
            PG8_STAGE(PG8_SB(0, 1), b2 + hstep, voffB);
            PG8_WAIT_V(6); PG8_BAR; PG8_MMA(1, 1, At, B1); PG8_BAR;
            PG8_LDB(B0, 1, 0); PG8_SCHED; PG8_LDA(At, 1, 0); PG8_STAGE(PG8_SA(0, 1), a2 + hstep, voffA);
            PG8_WAIT_L(8); PG8_BAR; PG8_WAIT_L(0); PG8_MMA(0, 0, At, B0); PG8_BAR; PG8_SCHED;
            PG8_LDB(B1, 1, 1); PG8_STAGE(PG8_SB(1, 0), b3, voffB);
            PG8_BAR; PG8_WAIT_L(0); PG8_MMA(0, 1, At, B1); PG8_BAR;
            PG8_LDA(At, 1, 1); PG8_STAGE(PG8_SA(1, 0), a3, voffA);
            PG8_BAR; PG8_WAIT_L(0); PG8_MMA(1, 0, At, B0); PG8_BAR; PG8_SCHED;
            PG8_STAGE(PG8_SB(1, 1), b3 + hstep, voffB);
            PG8_WAIT_V(6); PG8_BAR; PG8_MMA(1, 1, At, B1); PG8_BAR;
            }
        }
        if constexpr (ALIGN_EPI) { if (wr == 0) PG8_BAR; }
        if constexpr (!Epi::AFTER_DRAIN) { E(acc, cur, wr, wc, fr, fq); S.done(cur); }
        if (!has_next) break;
#pragma unroll
        for (int a = 0; a < 2; ++a)
#pragma unroll
            for (int b = 0; b < 2; ++b)
#pragma unroll
                for (int m = 0; m < 4; ++m)
#pragma unroll
                    for (int n = 0; n < 2; ++n) acc[a][b][m][n] = (f32x4){0.f, 0.f, 0.f, 0.f};
        cur = nxt; cA = nA; cB = nB; ++ui;
        if constexpr (ALIGN_EPI) { if (wr == 1) PG8_BAR; }
    }
    PG8_WAIT_V(0);
    if constexpr (!ALIGN_EPI) { if (wr == 0) PG8_BAR; }
    PG8_BAR;
    if constexpr (Epi::AFTER_DRAIN) { E.fused(acc, cur, wr, wc, fr, fq, lds, wid, lane); S.done(cur); }
#undef PG8_SA
#undef PG8_SB
#undef PG8_STAGE
#undef PG8_LDA
#undef PG8_LDB
#undef PG8_MMA
#undef PG8_WAIT_V
#undef PG8_WAIT_L
#undef PG8_BAR
#undef PG8_SCHED
}
}

constexpr int NWAVES = 8, NTHR = 512;
constexpr int BATCH = 4, SEQ = 8192, DM = 1024, MTOK = BATCH * SEQ, NIN = 6144, MIXW = 2048;
constexpr int NH = 8, DH = 128, NBLK = SEQ / 256;
constexpr int MH = 4, MD = 256, LCH = 64, NCH = SEQ / LCH;
constexpr float LOG2E = 1.4426950408889634f;
constexpr float QSCALE = 0.08838834764831845f * LOG2E;
constexpr float RMS_EPS = 1e-6f, LN_EPS = 1e-5f;
constexpr int LISTSZ = 256 * 496;
__host__ __device__ constexpr int list_off(int j) { return 256 * (31 * j - (j * (j - 1)) / 2); }

constexpr size_t MiB = 1u << 20;
constexpr size_t WS_CTL = 0, CTL_ZERO_BYTES = 64 * 1024;
constexpr size_t WS_BIASD = 1 * MiB;
constexpr size_t WS_WEFF = 1 * MiB + 64 * 1024;
constexpr size_t WS_KMEAN = 1 * MiB + 128 * 1024;
constexpr size_t WS_KMAX = 1 * MiB + 640 * 1024;
constexpr size_t WS_GLI = 2 * MiB, WS_GLF = 2 * MiB + 512 * 1024;
constexpr size_t WS_SEL = 3 * MiB;
constexpr size_t WS_LPART = 7 * MiB;
constexpr size_t WS_WINT = 10 * MiB;
constexpr size_t WS_WOUTT = 22 * MiB;
constexpr size_t WS_LIST = 26 * MiB;
constexpr size_t WS_XN = 64 * MiB;
constexpr size_t WS_QK = 128 * MiB;
constexpr size_t WS_V = 256 * MiB, WS_G = 320 * MiB, WS_XM = 384 * MiB, WS_ZM = 448 * MiB, WS_END = 512 * MiB;
constexpr size_t WS_NST = 42 * MiB;
constexpr size_t WS_PST = 42 * MiB + 512 * 1024, WS_MIN = 42 * MiB + 516 * 1024;
constexpr size_t WS_CST = WS_V;
constexpr int NSC = 16, SCCH = NCH / NSC;
constexpr int CW_CNT = 1024;

constexpr int LDS_BYTES = 163840;
#define GAS __attribute__((address_space(1)))
#define LAS __attribute__((address_space(3)))
#define DI __device__ __forceinline__
typedef unsigned short bf16;
typedef unsigned u32x4 __attribute__((ext_vector_type(4)));
typedef unsigned u32x2 __attribute__((ext_vector_type(2)));
typedef int i32x4 __attribute__((ext_vector_type(4)));
typedef float f32x4 __attribute__((ext_vector_type(4)));
typedef float f32x16 __attribute__((ext_vector_type(16)));
typedef short bf16x8 __attribute__((ext_vector_type(8)));
typedef short s16x4 __attribute__((ext_vector_type(4)));
typedef float f32x2_t __attribute__((ext_vector_type(2)));
typedef __bf16 bf16x2_t __attribute__((ext_vector_type(2)));
#define MFMA32(a, b, c) __builtin_amdgcn_mfma_f32_32x32x16_bf16((a), (b), (c), 0, 0, 0)
#define MFMA16(a, b, c) __builtin_amdgcn_mfma_f32_16x16x32_bf16((a), (b), (c), 0, 0, 0)

DI float bf2f(unsigned u16) { return __uint_as_float(u16 << 16); }
DI float bflo(unsigned w) { return __uint_as_float(w << 16); }
DI float bfhi(unsigned w) { return __uint_as_float(w & 0xffff0000u); }
DI unsigned pk2(float lo, float hi) { f32x2_t v = {lo, hi}; bf16x2_t b = __builtin_convertvector(v, bf16x2_t); return __builtin_bit_cast(unsigned, b); }
DI unsigned f2bf(float f) { return pk2(f, 0.f) & 0xffffu; }
DI int crow(int reg, int h) { return (reg & 3) + 8 * (reg >> 2) + 4 * h; }
DI float wave_sum(float v) {
#pragma unroll
    for (int o = 1; o < 64; o <<= 1) v += __shfl_xor(v, o);
    return v;
}
DI float wave_max(float v) {
#pragma unroll
    for (int o = 1; o < 64; o <<= 1) v = fmaxf(v, __shfl_xor(v, o));
    return v;
}
DI bf16x8 pack_lo(const f32x16& x) { u32x4 p; p.x = pk2(x[0], x[1]); p.y = pk2(x[2], x[3]); p.z = pk2(x[4], x[5]); p.w = pk2(x[6], x[7]); return __builtin_bit_cast(bf16x8, p); }
DI bf16x8 pack_hi(const f32x16& x) { u32x4 p; p.x = pk2(x[8], x[9]); p.y = pk2(x[10], x[11]); p.z = pk2(x[12], x[13]); p.w = pk2(x[14], x[15]); return __builtin_bit_cast(bf16x8, p); }
DI float silu_f(float v) { return v / (1.0f + __expf(-v)); }

struct Args { const float* in[15]; float* out; unsigned char* ws; int ph_lo, ph_hi; };

DI void p0_transpose_item(const float* W, int K, int N, bf16* WT, LAS float* scr, int item, int lane) {
    const int nblk = N / 32, kb = item / nblk, nb = item % nblk, k0 = 64 * kb, n0 = 32 * nb;
#pragma unroll 8
    for (int i = 0; i < 32; ++i) { const int kk = 2 * i + (lane >> 5); scr[kk * 33 + (lane & 31)] = W[(size_t)(k0 + kk) * N + n0 + (lane & 31)]; }
    asm volatile("s_waitcnt lgkmcnt(0)" ::: "memory");
    const int c = lane & 7;
#pragma unroll
    for (int j = 0; j < 4; ++j) { const int n = (lane >> 3) + 8 * j; const LAS float* s = scr + (8 * c) * 33 + n;
        u32x4 o; o.x = pk2(s[0 * 33], s[1 * 33]); o.y = pk2(s[2 * 33], s[3 * 33]); o.z = pk2(s[4 * 33], s[5 * 33]); o.w = pk2(s[6 * 33], s[7 * 33]);
        *(u32x4*)(WT + (size_t)(n0 + n) * K + k0 + 8 * c) = o; }
    asm volatile("s_waitcnt lgkmcnt(0)" ::: "memory");
}
DI int t5_bucket(int n) {
    if (n < 16) return n;
    int b = 16;
    b += (n >= 22); b += (n >= 30); b += (n >= 40); b += (n >= 54); b += (n >= 73); b += (n >= 99); b += (n >= 134); b += (n >= 182);
    b += (n >= 246); b += (n >= 332); b += (n >= 450); b += (n >= 609); b += (n >= 825); b += (n >= 1117); b += (n >= 1513);
    return b;
}
DI void phase_prologue(const Args& a, LAS unsigned char* lds, int tid, int lane, int wave, int bid, int G) {
    const float* x = a.in[0]; const float* rel_bias = a.in[1]; const float* g_pre = a.in[2]; const float* w_in = a.in[4];
    const float* wq = a.in[7]; const float* wk = a.in[8]; const float* wv = a.in[9]; const float* w_if = a.in[10]; const float* w_out = a.in[14];
    unsigned char* ws = a.ws;
    LAS float* scr = (LAS float*)(lds + wave * 16384);
    const int gw = bid * NWAVES + wave, NGW = G * NWAVES;
    constexpr int I_IN = (DM / 64) * (NIN / 32), I_OUT = (MIXW / 64) * (DM / 32);
    for (int it = gw; it < I_IN + I_OUT; it += NGW) {
        if (it < I_IN) p0_transpose_item(w_in, DM, NIN, (bf16*)(ws + WS_WINT), scr, it, lane);
        else p0_transpose_item(w_out, MIXW, DM, (bf16*)(ws + WS_WOUTT), scr, it - I_IN, lane);
    }
    {
        const f32x4* gr = (const f32x4*)g_pre + lane; f32x4 gg[4];
#pragma unroll
        for (int j = 0; j < 4; ++j) gg[j] = gr[64 * j];
        bf16* XN = (bf16*)(ws + WS_XN);
        for (int m = gw; m < MTOK; m += NGW) {
            const f32x4* xr = (const f32x4*)(x + (size_t)m * DM) + lane; f32x4 v[4]; float s = 0.f;
#pragma unroll
            for (int j = 0; j < 4; ++j) { v[j] = xr[64 * j]; s += (v[j].x * v[j].x + v[j].y * v[j].y) + (v[j].z * v[j].z + v[j].w * v[j].w); }
            const float rstd = 1.0f / sqrtf(wave_sum(s) * (1.0f / DM) + RMS_EPS);
            u32x2* o8 = (u32x2*)(XN + (size_t)m * DM) + lane;
#pragma unroll
            for (int j = 0; j < 4; ++j) { u32x2 o; o.x = pk2(v[j].x * rstd * gg[j].x, v[j].y * rstd * gg[j].y); o.y = pk2(v[j].z * rstd * gg[j].z, v[j].w * rstd * gg[j].w); o8[64 * j] = o; }
        }
    }
    const int gt = bid * NTHR + tid, NGT = G * NTHR;
    float* biasd = (float*)(ws + WS_BIASD);
    for (int idx = gt; idx < NH * 2048; idx += NGT) { const int h = idx >> 11, d = idx & 2047; biasd[idx] = rel_bias[t5_bucket(d) * NH + h] * LOG2E; }
    if (gt < NH) { float m = -1e30f; for (int b = 0; b < 32; ++b) m = fmaxf(m, rel_bias[b * NH + gt] * LOG2E); ((float*)(ws + WS_KMAX + 4096))[gt] = m; }
    float* weff = (float*)(ws + WS_WEFF);
    for (int idx = gt; idx < 2 * 1024 * 8; idx += NGT) {
        const int which = idx >> 13, c = (idx >> 3) & 1023, g = idx & 7, n = c >> 2, i = c & 3; float s = 0.f;
        if (which == 0) { for (int o = 0; o < 4; ++o) s += wq[n * 16 + i * 4 + o] * w_if[(4 * n + o) * 8 + g] + wk[n * 16 + i * 4 + o] * w_if[(1024 + 4 * n + o) * 8 + g]; }
        else { for (int o = 0; o < 4; ++o) s += wv[n * 16 + i * 4 + o] * w_if[(2048 + 4 * n + o) * 8 + g]; }
        weff[idx] = s;
    }
}

DI void phase_kstat(const Args& a, LAS unsigned char* lds, int tid, int lane, int wave, int bid, int G) {
    const bf16* QK = (const bf16*)(a.ws + WS_QK); float* KMEAN = (float*)(a.ws + WS_KMEAN); float* KMAX = (float*)(a.ws + WS_KMAX);
    LAS float* red = (LAS float*)lds; LAS float* wmx = (LAS float*)(lds + 32 * 128 * 4);
    for (int u = bid; u < 32 * NBLK; u += G) {
        const int bh = u >> 5, blk = u & 31, b = bh >> 3, h = bh & 7;
        const bf16* Kb = QK + (size_t)(b * SEQ + blk * 256) * 2048 + 1024 + h * DH;
        const int rg = tid >> 4, ch = tid & 15;
        float cs[8]; float mx = 0.f;
#pragma unroll
        for (int e = 0; e < 8; ++e) cs[e] = 0.f;
#pragma unroll
        for (int rr = 0; rr < 8; ++rr) {
            const u32x4 v = *(const u32x4*)(Kb + (size_t)(rg * 8 + rr) * 2048 + ch * 8);
            const float f0 = bflo(v.x), f1 = bfhi(v.x), f2 = bflo(v.y), f3 = bfhi(v.y), f4 = bflo(v.z), f5 = bfhi(v.z), f6 = bflo(v.w), f7 = bfhi(v.w);
            cs[0] += f0; cs[1] += f1; cs[2] += f2; cs[3] += f3; cs[4] += f4; cs[5] += f5; cs[6] += f6; cs[7] += f7;
            float ss = (f0 * f0 + f1 * f1) + (f2 * f2 + f3 * f3) + (f4 * f4 + f5 * f5) + (f6 * f6 + f7 * f7);
            ss += __shfl_xor(ss, 1); ss += __shfl_xor(ss, 2); ss += __shfl_xor(ss, 4); ss += __shfl_xor(ss, 8);
            mx = fmaxf(mx, ss);
        }
#pragma unroll
        for (int e = 0; e < 8; ++e) red[rg * 128 + ch * 8 + e] = cs[e];
        mx = wave_max(mx); if (lane == 0) wmx[wave] = mx;
        __syncthreads();
        if (tid < 128) { float s = 0.f; for (int r = 0; r < 32; ++r) s += red[r * 128 + tid]; KMEAN[(size_t)(bh * 32 + blk) * 128 + tid] = s * (1.0f / 256.0f); }
        if (tid == 0) { float m = wmx[0]; for (int w = 1; w < 8; ++w) m = fmaxf(m, wmx[w]); KMAX[bh * 32 + blk] = m; }
        __syncthreads();
    }
}

DI void phase_sel(const Args& a, LAS unsigned char* lds, int tid, int lane, int wave, int bid, int G) {
    const bf16* QK = (const bf16*)(a.ws + WS_QK); const float* KMEAN = (const float*)(a.ws + WS_KMEAN); const float* KMAX = (const float*)(a.ws + WS_KMAX);
    const float* BMAX = (const float*)(a.ws + WS_KMAX + 4096);
    i32x4* SEL = (i32x4*)(a.ws + WS_SEL); unsigned* cnt = (unsigned*)(a.ws + WS_CTL) + CW_CNT; unsigned* LIST = (unsigned*)(a.ws + WS_LIST);
    LAS float* km = (LAS float*)lds; LAS float* misc = (LAS float*)(lds + 32 * 128 * 4);
    for (int u = bid; u < 32 * NBLK; u += G) {
        const int bh = u >> 5, i = u & 31, b = bh >> 3, h = bh & 7;
        for (int idx = tid; idx < i * 128; idx += NTHR) km[idx] = KMEAN[(size_t)bh * 32 * 128 + idx];
        if (tid < 64) { float v = tid < 32 ? KMAX[bh * 32 + tid] : 0.f; v = wave_max(v); if (tid == 0) misc[0] = sqrtf(v); }
        __syncthreads();
        const float kmaxn = misc[0];
        const int q = tid >> 1, half = tid & 1; const int row = b * SEQ + i * 256 + q;
        const bf16* qp = QK + (size_t)row * 2048 + h * DH + half * 64;
        float qv[64];
#pragma unroll
        for (int c = 0; c < 8; ++c) { const u32x4 v = *(const u32x4*)(qp + c * 8);
            qv[c * 8 + 0] = bflo(v.x); qv[c * 8 + 1] = bfhi(v.x); qv[c * 8 + 2] = bflo(v.y); qv[c * 8 + 3] = bfhi(v.y);
            qv[c * 8 + 4] = bflo(v.z); qv[c * 8 + 5] = bfhi(v.z); qv[c * 8 + 6] = bflo(v.w); qv[c * 8 + 7] = bfhi(v.w); }
        float qn2 = 0.f;
#pragma unroll
        for (int d = 0; d < 64; ++d) qn2 += qv[d] * qv[d];
        qn2 += __shfl_xor(qn2, 1);
        float v0 = -INFINITY, v1 = -INFINITY, v2 = -INFINITY; int i0 = -1, i1 = -1, i2 = -1;
        for (int j = 0; j < i; ++j) {
            const LAS float* kr = km + j * 128 + half * 64; float dot = 0.f;
#pragma unroll
            for (int d = 0; d < 64; d += 4) { const f32x4 kk = *(const LAS f32x4*)(kr + d); dot += qv[d] * kk.x + qv[d + 1] * kk.y + qv[d + 2] * kk.z + qv[d + 3] * kk.w; }
            dot += __shfl_xor(dot, 1);
            if (dot > v0) { v2 = v1; i2 = i1; v1 = v0; i1 = i0; v0 = dot; i0 = j; }
            else if (dot > v1) { v2 = v1; i2 = i1; v1 = dot; i1 = j; }
            else if (dot > v2) { v2 = dot; i2 = j; }
        }
        const float shift = sqrtf(qn2) * kmaxn + BMAX[h];
        if (half == 0) {
            i32x4 s4; s4.x = i0; s4.y = i1; s4.z = i2; s4.w = __float_as_int(shift);
            SEL[(size_t)row * 8 + h] = s4;
            const unsigned qpos = (unsigned)(i * 256 + q);
            if (i0 >= 0) { const unsigned p = atomicAdd(&cnt[bh * 32 + i0], 1u); LIST[(size_t)bh * LISTSZ + list_off(i0) + p] = qpos | (0u << 16); }
            if (i1 >= 0) { const unsigned p = atomicAdd(&cnt[bh * 32 + i1], 1u); LIST[(size_t)bh * LISTSZ + list_off(i1) + p] = qpos | (1u << 16); }
            if (i2 >= 0) { const unsigned p = atomicAdd(&cnt[bh * 32 + i2], 1u); LIST[(size_t)bh * LISTSZ + list_off(i2) + p] = qpos | (2u << 16); }
        }
        __syncthreads();
    }
}

constexpr int ATT_KIMG = 0, ATT_KROW = 272, ATT_VT = 69632, ATT_VROW = 520, ATT_BIASD = 136192, ATT_PREF = 144384, ATT_LST = 148480, ATT_MISC = 149504;
DI void att_fill_kv(LAS unsigned char* lds, const bf16* Kg, const bf16* Vg, int tid, int lane, int wave) {
#pragma unroll
    for (int it = 0; it < 8; ++it) { const int p = it * NTHR + tid, key = p >> 4, ch = p & 15;
        const u32x4 v = *(const u32x4*)(Kg + (size_t)key * 2048 + ch * 8); *(LAS u32x4*)(lds + ATT_KIMG + key * ATT_KROW + ch * 16) = v; }
#pragma unroll
    for (int dcw = 0; dcw < 2; ++dcw) { const int dc = wave + 8 * dcw;
#pragma unroll
        for (int kp = 0; kp < 4; ++kp) { const int key = kp * 64 + lane;
            const u32x4 v = *(const u32x4*)(Vg + (size_t)key * 1024 + dc * 8);
            LAS unsigned short* dst = (LAS unsigned short*)(lds + ATT_VT + (dc * 8) * ATT_VROW + key * 2);
            dst[0 * (ATT_VROW / 2)] = (unsigned short)(v.x & 0xffffu); dst[1 * (ATT_VROW / 2)] = (unsigned short)(v.x >> 16);
            dst[2 * (ATT_VROW / 2)] = (unsigned short)(v.y & 0xffffu); dst[3 * (ATT_VROW / 2)] = (unsigned short)(v.y >> 16);
            dst[4 * (ATT_VROW / 2)] = (unsigned short)(v.z & 0xffffu); dst[5 * (ATT_VROW / 2)] = (unsigned short)(v.z >> 16);
            dst[6 * (ATT_VROW / 2)] = (unsigned short)(v.w & 0xffffu); dst[7 * (ATT_VROW / 2)] = (unsigned short)(v.w >> 16); } }
}
template <bool OWN>
DI void att_tile(LAS unsigned char* lds, const bf16x8 (&qf)[8], int qpos, float shift, int kbase, int kt_end, int wdiag, bool far, float b31,
                 f32x16 (&o)[4], float& lsum, int r, int hf) {
    const LAS float* biasd = (const LAS float*)(lds + ATT_BIASD);
    for (int kt = 0; kt < kt_end; ++kt) {
        f32x16 x;
#pragma unroll
        for (int i = 0; i < 16; ++i) x[i] = 0.f;
#pragma unroll
        for (int ks = 0; ks < 8; ++ks) { const bf16x8 kf = *(const LAS bf16x8*)(lds + ATT_KIMG + (32 * kt + r) * ATT_KROW + ks * 32 + hf * 16); x = MFMA32(kf, qf[ks], x); }
        if (far) {
#pragma unroll
            for (int i = 0; i < 16; ++i) { const float p = __builtin_amdgcn_exp2f(x[i] + (b31 - shift)); lsum += p; x[i] = p; }
        } else {
#pragma unroll
            for (int i = 0; i < 16; ++i) { const int key = 32 * kt + crow(i, hf); int dist = qpos - (kbase + key); dist = dist < 0 ? 0 : (dist > 2047 ? 2047 : dist);
                float p = __builtin_amdgcn_exp2f(x[i] + biasd[dist] - shift);
                if (OWN) { if (kt == wdiag && crow(i, hf) > r) p = 0.f; }
                lsum += p; x[i] = p; }
        }
        const bf16x8 pa0 = pack_lo(x), pa1 = pack_hi(x);
#pragma unroll
        for (int dt = 0; dt < 4; ++dt) {
            const LAS unsigned char* vb = lds + ATT_VT + (32 * dt + r) * ATT_VROW + 2 * (32 * kt + 4 * hf);
            const s16x4 l0 = *(const LAS s16x4*)(vb), h0 = *(const LAS s16x4*)(vb + 16), l1 = *(const LAS s16x4*)(vb + 32), h1 = *(const LAS s16x4*)(vb + 48);
            const bf16x8 vf0 = __builtin_shufflevector(l0, h0, 0, 1, 2, 3, 4, 5, 6, 7), vf1 = __builtin_shufflevector(l1, h1, 0, 1, 2, 3, 4, 5, 6, 7);
            o[dt] = MFMA32(pa0, vf0, o[dt]); o[dt] = MFMA32(pa1, vf1, o[dt]);
        }
    }
}
DI void att_load_biasd(const Args& a, LAS unsigned char* lds, int h, int tid) {
    const float* biasd = (const float*)(a.ws + WS_BIASD) + h * 2048; LAS float* dst = (LAS float*)(lds + ATT_BIASD);
    for (int i = tid; i < 2048; i += NTHR) dst[i] = biasd[i];
}
DI bf16* opart_base(const Args& a, int slot) { return slot == 0 ? (bf16*)a.out : (slot == 1 ? (bf16*)((unsigned char*)a.out + 64 * MiB) : (bf16*)(a.ws + WS_XN)); }

DI void phase_att_gather(const Args& a, LAS unsigned char* lds, int tid, int lane, int wave, int bid, int G) {
    const bf16* QK = (const bf16*)(a.ws + WS_QK); const bf16* Vb = (const bf16*)(a.ws + WS_V);
    const i32x4* SEL = (const i32x4*)(a.ws + WS_SEL); const unsigned* cnt = (const unsigned*)(a.ws + WS_CTL) + CW_CNT; const unsigned* LIST = (const unsigned*)(a.ws + WS_LIST);
    float* LPART = (float*)(a.ws + WS_LPART);
    LAS int* pref = (LAS int*)(lds + ATT_PREF);
    if (tid < 64) {
        int nu[16]; int s = 0;
#pragma unroll
        for (int k = 0; k < 16; ++k) { const int l = tid * 16 + k; int n = 0; if (l < 992) { const int bh = l / 31, j = l % 31; n = (int)((cnt[bh * 32 + j] + 255u) >> 8); } nu[k] = n; s += n; }
        int incl = s;
#pragma unroll
        for (int o = 1; o < 64; o <<= 1) { const int t = __shfl_up(incl, o); if (lane >= o) incl += t; }
        int run = incl - s;
#pragma unroll
        for (int k = 0; k < 16; ++k) { const int l = tid * 16 + k; if (l <= 992) pref[l] = run; run += nu[k]; }
    }
    __syncthreads();
    const int U = pref[992];
    const int r = lane & 31, hf = lane >> 5;
    int cur_h = -1;
    for (int u = bid; u < U; u += G) {
        int lo = 0, hi = 992;
        while (hi - lo > 1) { const int mid = (lo + hi) >> 1; if (pref[mid] <= u) lo = mid; else hi = mid; }
        const int l = lo, bh = l / 31, j = l % 31, chunk = u - pref[l], b = bh >> 3, h = bh & 7;
        const int n = (int)cnt[bh * 32 + j]; const int nrows = min(256, n - chunk * 256);
        if (h != cur_h) { att_load_biasd(a, lds, h, tid); cur_h = h; }
        att_fill_kv(lds, QK + (size_t)(b * SEQ + j * 256) * 2048 + 1024 + h * DH, Vb + (size_t)(b * SEQ + j * 256) * 1024 + h * DH, tid, lane, wave);
        __syncthreads();
        const int nv = min(32, max(0, nrows - 32 * wave));
        const unsigned* lp = LIST + (size_t)bh * LISTSZ + list_off(j) + chunk * 256 + 32 * wave;
        unsigned ent = 0; f32x16 o[4]; float lsum = 0.f;
#pragma unroll
        for (int dt = 0; dt < 4; ++dt)
#pragma unroll
            for (int i = 0; i < 16; ++i) o[dt][i] = 0.f;
        if (nv > 0) {
            ent = lp[r < nv ? r : 0];
            const int qpos = (int)(ent & 0xffffu); const size_t row = (size_t)b * SEQ + qpos;
            const float shift = __int_as_float(SEL[row * 8 + h].w);
            bf16x8 qf[8];
#pragma unroll
            for (int ks = 0; ks < 8; ++ks) qf[ks] = *(const bf16x8*)(QK + row * 2048 + h * DH + ks * 16 + hf * 8);
            const bool far = __all(qpos - (j * 256 + 255) >= 1513);
            const float b31 = *(const LAS float*)(lds + ATT_BIASD + 2047 * 4);
            att_tile<false>(lds, qf, qpos, shift, j * 256, 8, -1, far, b31, o, lsum, r, hf);
            lsum += __shfl_xor(lsum, 32);
        }
        __syncthreads();
        if (nv > 0) {
            LAS unsigned char* stg = lds + wave * 8192;
#pragma unroll
            for (int dt = 0; dt < 4; ++dt)
#pragma unroll
                for (int i = 0; i < 16; ++i) *(LAS unsigned short*)(stg + crow(i, hf) * 256 + (32 * dt + r) * 2) = (unsigned short)f2bf(o[dt][i]);
#pragma unroll
            for (int it = 0; it < 8; ++it) { const int item = it * 64 + lane, rho = item >> 4, ch = item & 15;
                const unsigned e2 = (unsigned)__shfl((int)ent, rho); const int q2 = (int)(e2 & 0xffffu), slot2 = (int)(e2 >> 16);
                const u32x4 v = *(const LAS u32x4*)(stg + rho * 256 + ch * 16);
                if (rho < nv) *(u32x4*)(opart_base(a, slot2) + (((size_t)b * SEQ + q2) * 8 + h) * 128 + ch * 8) = v; }
            if (hf == 0 && r < nv) { const int q1 = (int)(ent & 0xffffu), slot1 = (int)(ent >> 16); LPART[(size_t)slot1 * MTOK * 8 + ((size_t)b * SEQ + q1) * 8 + h] = lsum; }
        }
        __syncthreads();
    }
}

DI void phase_att_own(const Args& a, LAS unsigned char* lds, int tid, int lane, int wave, int bid, int G) {
    bf16* QK = (bf16*)(a.ws + WS_QK); const bf16* Vb = (const bf16*)(a.ws + WS_V); const bf16* Gb = (const bf16*)(a.ws + WS_G);
    const i32x4* SEL = (const i32x4*)(a.ws + WS_SEL); const float* LPART = (const float*)(a.ws + WS_LPART);
    const int r = lane & 31, hf = lane >> 5;
    int cur_h = -1;
    for (int u = bid; u < 32 * NBLK; u += G) {
        const int bh = u >> 5, i = u & 31, b = bh >> 3, h = bh & 7;
        if (h != cur_h) { att_load_biasd(a, lds, h, tid); cur_h = h; }
        att_fill_kv(lds, QK + (size_t)(b * SEQ + i * 256) * 2048 + 1024 + h * DH, Vb + (size_t)(b * SEQ + i * 256) * 1024 + h * DH, tid, lane, wave);
        __syncthreads();
        const int qpos = i * 256 + 32 * wave + r; const size_t row = (size_t)b * SEQ + qpos;
        const float shift = __int_as_float(SEL[row * 8 + h].w);
        bf16x8 qf[8];
#pragma unroll
        for (int ks = 0; ks < 8; ++ks) qf[ks] = *(const bf16x8*)(QK + row * 2048 + h * DH + ks * 16 + hf * 8);
        f32x16 o[4]; float lsum = 0.f;
#pragma unroll
        for (int dt = 0; dt < 4; ++dt)
#pragma unroll
            for (int k = 0; k < 16; ++k) o[dt][k] = 0.f;
        att_tile<true>(lds, qf, qpos, shift, i * 256, wave + 1, wave, false, 0.f, o, lsum, r, hf);
        lsum += __shfl_xor(lsum, 32);
        __syncthreads();
        LAS unsigned char* stg = lds + wave * 16384;
        LAS float* lst = (LAS float*)(lds + ATT_LST) + wave * 32;
#pragma unroll
        for (int dt = 0; dt < 4; ++dt)
#pragma unroll
            for (int k = 0; k < 16; ++k) *(LAS float*)(stg + crow(k, hf) * 512 + (32 * dt + r) * 4) = o[dt][k];
        if (hf == 0) lst[r] = lsum;
#pragma unroll
        for (int it = 0; it < 8; ++it) { const int item = it * 64 + lane, rho = item >> 4, ch = item & 15;
            const size_t row2 = (size_t)b * SEQ + i * 256 + 32 * wave + rho;
            const f32x4 a0 = *(const LAS f32x4*)(stg + rho * 512 + ch * 32), a1 = *(const LAS f32x4*)(stg + rho * 512 + ch * 32 + 16);
            float acc[8] = {a0.x, a0.y, a0.z, a0.w, a1.x, a1.y, a1.z, a1.w};
            float l = lst[rho];
            const i32x4 s4 = SEL[row2 * 8 + h];
#pragma unroll
            for (int k = 0; k < 3; ++k) { const int sk = (k == 0) ? s4.x : (k == 1 ? s4.y : s4.z);
                if (sk >= 0) { const u32x4 pv = *(const u32x4*)(opart_base(a, k) + (row2 * 8 + h) * 128 + ch * 8);
                    acc[0] += bflo(pv.x); acc[1] += bfhi(pv.x); acc[2] += bflo(pv.y); acc[3] += bfhi(pv.y); acc[4] += bflo(pv.z); acc[5] += bfhi(pv.z); acc[6] += bflo(pv.w); acc[7] += bfhi(pv.w);
                    l += LPART[(size_t)k * MTOK * 8 + row2 * 8 + h]; } }
            const u32x4 gv = *(const u32x4*)(Gb + row2 * 1024 + h * DH + ch * 8);
            const float rl = 1.0f / l;
            u32x4 ov; ov.x = pk2(acc[0] * rl * silu_f(bflo(gv.x)), acc[1] * rl * silu_f(bfhi(gv.x))); ov.y = pk2(acc[2] * rl * silu_f(bflo(gv.y)), acc[3] * rl * silu_f(bfhi(gv.y)));
            ov.z = pk2(acc[4] * rl * silu_f(bflo(gv.z)), acc[5] * rl * silu_f(bfhi(gv.z))); ov.w = pk2(acc[6] * rl * silu_f(bflo(gv.w)), acc[7] * rl * silu_f(bfhi(gv.w)));
            *(u32x4*)(QK + row2 * 2048 + h * DH + ch * 8) = ov; }
        __syncthreads();
    }
}

DI void phase_mpre(const Args& a, LAS unsigned char* lds, int tid, int lane, int wave, int bid, int G) {
    const float* conv_w = a.in[5]; const float* conv_b = a.in[6]; const float* wq = a.in[7]; const float* wk = a.in[8]; const float* wv = a.in[9]; const float* b_if = a.in[11];
    const float* weff = (const float*)(a.ws + WS_WEFF);
    const bf16* XM = (const bf16*)(a.ws + WS_XM);
    bf16* QM = (bf16*)a.out; bf16* KM = (bf16*)((unsigned char*)a.out + 64 * MiB); bf16* VM = (bf16*)(a.ws + WS_XN); bf16* XC = (bf16*)(a.ws + WS_G);
    float* GLI = (float*)(a.ws + WS_GLI); float* GLF = (float*)(a.ws + WS_GLF);
    LAS float* red = (LAS float*)lds;
    const int tk = tid >> 8, n = tid & 255;
    float cw[4][4], cb[4], fq[16], fk[16], fv[16], wc[4][8], wm[4][8];
#pragma unroll
    for (int w = 0; w < 4; ++w) { const f32x4 t = *(const f32x4*)(conv_w + w * 1024 + 4 * n); cw[w][0] = t.x; cw[w][1] = t.y; cw[w][2] = t.z; cw[w][3] = t.w; }
    { const f32x4 t = *(const f32x4*)(conv_b + 4 * n); cb[0] = t.x; cb[1] = t.y; cb[2] = t.z; cb[3] = t.w; }
#pragma unroll
    for (int k = 0; k < 16; ++k) { fq[k] = wq[n * 16 + k]; fk[k] = wk[n * 16 + k] * 0.0625f; fv[k] = wv[n * 16 + k]; }
#pragma unroll
    for (int i = 0; i < 4; ++i)
#pragma unroll
        for (int g = 0; g < 8; ++g) { wc[i][g] = weff[(4 * n + i) * 8 + g]; wm[i][g] = weff[8192 + (4 * n + i) * 8 + g]; }
    for (int tp = bid; tp < MTOK / 2; tp += G) {
        const int m = 2 * tp + tk, s = m & (SEQ - 1);
        float xw[4][4];
#pragma unroll
        for (int w = 0; w < 4; ++w) {
            u32x2 v; v.x = 0u; v.y = 0u;
            if (s - 3 + w >= 0) v = *(const u32x2*)(XM + (size_t)(m - 3 + w) * 1024 + 4 * n);
            xw[w][0] = bflo(v.x); xw[w][1] = bfhi(v.x); xw[w][2] = bflo(v.y); xw[w][3] = bfhi(v.y);
        }
        float xc[4];
#pragma unroll
        for (int c = 0; c < 4; ++c) { float y = cb[c];
#pragma unroll
            for (int w = 0; w < 4; ++w) y += xw[w][c] * cw[w][c];
            xc[c] = silu_f(y); }
        float qo[4], ko[4], vo[4];
#pragma unroll
        for (int o = 0; o < 4; ++o) { float sq = 0.f, sk = 0.f, sv = 0.f;
#pragma unroll
            for (int i = 0; i < 4; ++i) { sq += xc[i] * fq[i * 4 + o]; sk += xc[i] * fk[i * 4 + o]; sv += xw[3][i] * fv[i * 4 + o]; }
            qo[o] = sq; ko[o] = sk; vo[o] = sv; }
        float gp[8];
#pragma unroll
        for (int g = 0; g < 8; ++g) { float sg = 0.f;
#pragma unroll
            for (int i = 0; i < 4; ++i) sg += xc[i] * wc[i][g] + xw[3][i] * wm[i][g];
            gp[g] = sg; }
        const size_t off = (size_t)m * 1024 + 4 * n;
        { u32x2 o; o.x = pk2(qo[0], qo[1]); o.y = pk2(qo[2], qo[3]); *(u32x2*)(QM + off) = o; }
        { u32x2 o; o.x = pk2(ko[0], ko[1]); o.y = pk2(ko[2], ko[3]); *(u32x2*)(KM + off) = o; }
        { u32x2 o; o.x = pk2(vo[0], vo[1]); o.y = pk2(vo[2], vo[3]); *(u32x2*)(VM + off) = o; }
        { u32x2 o; o.x = pk2(xc[0], xc[1]); o.y = pk2(xc[2], xc[3]); *(u32x2*)(XC + off) = o; }
#pragma unroll
        for (int g = 0; g < 8; ++g) gp[g] = wave_sum(gp[g]);
        if (lane == 0) {
#pragma unroll
            for (int g = 0; g < 8; ++g) red[(tk * 4 + (wave & 3)) * 8 + g] = gp[g]; }
        __syncthreads();
        if (tid < 16) { const int t2 = tid >> 3, g = tid & 7; const int m2 = 2 * tp + t2, s2 = m2 & (SEQ - 1), b2 = m2 >> 13;
            const float gate = red[(t2 * 4 + 0) * 8 + g] + red[(t2 * 4 + 1) * 8 + g] + red[(t2 * 4 + 2) * 8 + g] + red[(t2 * 4 + 3) * 8 + g] + b_if[g];
            if (g < 4) GLI[(size_t)(b2 * 4 + g) * SEQ + s2] = gate;
            else GLF[(size_t)(b2 * 4 + g - 4) * SEQ + s2] = fminf(gate, 0.f) - log1pf(__expf(-fabsf(gate))); }
        __syncthreads();
    }
}

constexpr int MC_QI = 0, MC_QROW = 528, MC_KI = 33792, MC_KT = 67584, MC_TROW = 144, MC_VT = 104448, MC_P = 141312, MC_SC = 150528, MC_NV = 153600, MC_MISC = 154624;
constexpr int MC_STROW = 1040;
DI LAS float* mc_sc(LAS unsigned char* lds, int k) { return (LAS float*)(lds + MC_SC + k * 256); }

DI void phase_mstate(const Args& a, LAS unsigned char* lds, int tid, int lane0, int wave, int bid, int G) {
    const bf16* KM = (const bf16*)((unsigned char*)a.out + 64 * MiB); const bf16* VM = (const bf16*)(a.ws + WS_XN);
    const float* GLI = (const float*)(a.ws + WS_GLI); const float* GLF = (const float*)(a.ws + WS_GLF);
    float* CST = (float*)(a.ws + WS_CST); float* NST = (float*)(a.ws + WS_NST); float* PST = (float*)(a.ws + WS_PST); float* MIN = (float*)(a.ws + WS_MIN);
    LAS float* nvec = (LAS float*)(lds + MC_NV); LAS float* misc = (LAS float*)(lds + MC_MISC);
    LAS float* aggb = (LAS float*)(lds + MC_QI); LAS float* agga = aggb + 128; LAS float* marr = aggb + 256;
#define OPQ(name) int name = tid; asm volatile("" : "+v"(name))
    for (int u = bid; u < BATCH * MH * NSC; u += G) {
        const int bh = u >> 4, sc = u & 15, b = bh >> 2, hd = bh & 3; const int c0 = sc * SCCH, c1 = c0 + SCCH;
        { OPQ(tA); const int laneA = tA & 63;
            for (int c = wave; c < c1; c += NWAVES) {
                const float lf = GLF[(size_t)bh * SEQ + c * LCH + laneA], li = GLI[(size_t)bh * SEQ + c * LCH + laneA];
                float bc = lf;
#pragma unroll
                for (int o = 1; o < 64; o <<= 1) { const float t = __shfl_up(bc, o); if (laneA >= o) bc += t; }
                const float am = wave_max(li - bc); const float bL = __shfl(bc, 63);
                if (laneA == 0) { aggb[c] = bL; agga[c] = am; }
            }
        }
        __syncthreads();
        if (tid == 0) { float m = 0.f; for (int c = 0; c < c1; ++c) { marr[c] = m; m = aggb[c] + fmaxf(m, agga[c]); } }
        __syncthreads();
        if (tid < SCCH) MIN[bh * NCH + c0 + tid] = marr[c0 + tid];
        f32x16 C[8];
#pragma unroll
        for (int dt = 0; dt < 8; ++dt)
#pragma unroll
            for (int i = 0; i < 16; ++i) C[dt][i] = 0.f;
        if (tid < 256) nvec[tid] = 0.f;
        float pprod = 1.f;
        for (int c = c0; c < c1; ++c) {
            const size_t rowbase = (size_t)b * SEQ + (size_t)c * LCH;
            { OPQ(tB); const int laneB = tB & 63;
#pragma unroll
            for (int cc = 0; cc < 4; ++cc) { const int c8 = wave + 8 * cc;
                const u32x4 vk = *(const u32x4*)(KM + (rowbase + laneB) * 1024 + hd * MD + c8 * 8); const u32x4 vv = *(const u32x4*)(VM + (rowbase + laneB) * 1024 + hd * MD + c8 * 8);
                LAS unsigned short* dk = (LAS unsigned short*)(lds + MC_KT + (c8 * 8) * MC_TROW + laneB * 2); LAS unsigned short* dv = (LAS unsigned short*)(lds + MC_VT + (c8 * 8) * MC_TROW + laneB * 2);
                dk[0 * 72] = (unsigned short)(vk.x & 0xffffu); dk[1 * 72] = (unsigned short)(vk.x >> 16); dk[2 * 72] = (unsigned short)(vk.y & 0xffffu); dk[3 * 72] = (unsigned short)(vk.y >> 16);
                dk[4 * 72] = (unsigned short)(vk.z & 0xffffu); dk[5 * 72] = (unsigned short)(vk.z >> 16); dk[6 * 72] = (unsigned short)(vk.w & 0xffffu); dk[7 * 72] = (unsigned short)(vk.w >> 16);
                dv[0 * 72] = (unsigned short)(vv.x & 0xffffu); dv[1 * 72] = (unsigned short)(vv.x >> 16); dv[2 * 72] = (unsigned short)(vv.y & 0xffffu); dv[3 * 72] = (unsigned short)(vv.y >> 16);
                dv[4 * 72] = (unsigned short)(vv.z & 0xffffu); dv[5 * 72] = (unsigned short)(vv.z >> 16); dv[6 * 72] = (unsigned short)(vv.w & 0xffffu); dv[7 * 72] = (unsigned short)(vv.w >> 16); }
            if (wave == 0) {
                const float lf = GLF[(size_t)bh * SEQ + c * LCH + laneB], li = GLI[(size_t)bh * SEQ + c * LCH + laneB];
                float bc = lf;
#pragma unroll
                for (int o = 1; o < 64; o <<= 1) { const float t = __shfl_up(bc, o); if (laneB >= o) bc += t; }
                const float av = li - bc; const float mi = marr[c]; const float Gc = fmaxf(mi, wave_max(av));
                mc_sc(lds, 3)[laneB] = __expf(av - Gc);
                if (laneB == 0) misc[0] = __expf(mi - Gc);
            } }
            __syncthreads();
            const float cd = misc[0]; pprod *= cd;
            { OPQ(tC); const int laneC = tC & 63, r = laneC & 31, hf = laneC >> 5;
            bf16x8 vt[4];
            const LAS unsigned char* vbase = lds + MC_VT + (32 * wave + r) * MC_TROW + hf * 16;
#pragma unroll
            for (int ks = 0; ks < 4; ++ks) { vt[ks] = *(const LAS bf16x8*)(vbase + ks * 32);
                const f32x4 w0 = *(const LAS f32x4*)(mc_sc(lds, 3) + 16 * ks + 8 * hf), w1 = *(const LAS f32x4*)(mc_sc(lds, 3) + 16 * ks + 8 * hf + 4);
                const u32x4 vv = __builtin_bit_cast(u32x4, vt[ks]); u32x4 o;
                o.x = pk2(bflo(vv.x) * w0.x, bfhi(vv.x) * w0.y); o.y = pk2(bflo(vv.y) * w0.z, bfhi(vv.y) * w0.w); o.z = pk2(bflo(vv.z) * w1.x, bfhi(vv.z) * w1.y); o.w = pk2(bflo(vv.w) * w1.z, bfhi(vv.w) * w1.w);
                vt[ks] = __builtin_bit_cast(bf16x8, o); }
            const LAS unsigned char* kbase = lds + MC_KT + r * MC_TROW + hf * 16;
#pragma unroll
            for (int dt = 0; dt < 8; ++dt) {
#pragma unroll
                for (int i = 0; i < 16; ++i) C[dt][i] *= cd;
#pragma unroll
                for (int ks = 0; ks < 4; ++ks) { const bf16x8 kA = *(const LAS bf16x8*)(kbase + dt * 32 * MC_TROW + ks * 32); C[dt] = MFMA32(kA, vt[ks], C[dt]); } }
            if (tC < 256) { float sacc = cd * nvec[tC];
#pragma unroll
                for (int k = 0; k < 8; ++k) { const u32x4 kv = *(const LAS u32x4*)(lds + MC_KT + tC * MC_TROW + k * 16);
                    const f32x4 w0 = *(const LAS f32x4*)(mc_sc(lds, 3) + k * 8), w1 = *(const LAS f32x4*)(mc_sc(lds, 3) + k * 8 + 4);
                    sacc += bflo(kv.x) * w0.x + bfhi(kv.x) * w0.y + bflo(kv.y) * w0.z + bfhi(kv.y) * w0.w + bflo(kv.z) * w1.x + bfhi(kv.z) * w1.y + bflo(kv.w) * w1.z + bfhi(kv.w) * w1.w; }
                nvec[tC] = sacc; }
            }
            __syncthreads();
        }
        { OPQ(tD); const int laneD = tD & 63, r = laneD & 31, hf = laneD >> 5;
            float* cs = CST + (size_t)u * 65536 + 32 * wave + r;
#pragma unroll
            for (int dt = 0; dt < 8; ++dt)
#pragma unroll
                for (int i = 0; i < 16; ++i) cs[(32 * dt + crow(i, hf)) * 256] = C[dt][i];
            if (tD < 256) NST[u * 256 + tD] = nvec[tD];
            if (tD == 0) PST[u] = pprod;
        }
        __syncthreads();
    }
#undef OPQ
}
DI void phase_mcomb(const Args& a, int tid, int bid, int G) {
    float* CST = (float*)(a.ws + WS_CST); float* NST = (float*)(a.ws + WS_NST); const float* PST = (const float*)(a.ws + WS_PST);
    const int gt = bid * NTHR + tid, NGT = G * NTHR;
    for (int idx = gt; idx < BATCH * MH * 65536; idx += NGT) { const int bh = idx >> 16, e = idx & 65535; float run = 0.f;
#pragma unroll 4
        for (int sc = 0; sc < NSC; ++sc) { float* p = CST + (size_t)(bh * NSC + sc) * 65536 + e; const float tmp = *p; *p = run; run = PST[bh * NSC + sc] * run + tmp; } }
    for (int idx = gt; idx < BATCH * MH * 256; idx += NGT) { const int bh = idx >> 8, e = idx & 255; float run = 0.f;
        for (int sc = 0; sc < NSC; ++sc) { float* p = NST + (size_t)(bh * NSC + sc) * 256 + e; const float tmp = *p; *p = run; run = PST[bh * NSC + sc] * run + tmp; } }
}
DI void phase_mscan(const Args& a, LAS unsigned char* lds, int tid, int lane0, int wave, int bid, int G) {
    const bf16* QM = (const bf16*)a.out; const bf16* KM = (const bf16*)((unsigned char*)a.out + 64 * MiB); const bf16* VM = (const bf16*)(a.ws + WS_XN); const bf16* XC = (const bf16*)(a.ws + WS_G);
    const bf16* ZM = (const bf16*)(a.ws + WS_ZM); bf16* QK = (bf16*)(a.ws + WS_QK);
    const float* GLI = (const float*)(a.ws + WS_GLI); const float* GLF = (const float*)(a.ws + WS_GLF);
    const float* mh_norm = a.in[12]; const float* skip = a.in[13];
    LAS float* nvec = (LAS float*)(lds + MC_NV); LAS float* misc = (LAS float*)(lds + MC_MISC);
#define OPQ(name) int name = tid; asm volatile("" : "+v"(name))
    const float* CST = (const float*)(a.ws + WS_CST); const float* NST = (const float*)(a.ws + WS_NST); const float* MIN = (const float*)(a.ws + WS_MIN);
    for (int u = bid; u < BATCH * MH * NSC; u += G) {
        const int bh = u >> 4, sc = u & 15, b = bh >> 2, hd = bh & 3;
        f32x16 C[8];
        { OPQ(t0); const int lane_ = t0 & 63, r = lane_ & 31, hf = lane_ >> 5;
            const float* cs = CST + (size_t)u * 65536 + 32 * wave + r;
#pragma unroll
            for (int dt = 0; dt < 8; ++dt)
#pragma unroll
                for (int i = 0; i < 16; ++i) C[dt][i] = cs[(32 * dt + crow(i, hf)) * 256];
            if (t0 < 256) nvec[t0] = NST[u * 256 + t0];
        }
        float mrun = MIN[bh * NCH + sc * SCCH];
        for (int c = sc * SCCH; c < (sc + 1) * SCCH; ++c) {
            const size_t rowbase = (size_t)b * SEQ + (size_t)c * LCH;
            { OPQ(tA); const int laneA = tA & 63;
#pragma unroll
            for (int it = 0; it < 4; ++it) { const int p = it * NTHR + tA, t = p >> 5, ch = p & 31;
                const u32x4 vq = *(const u32x4*)(QM + (rowbase + t) * 1024 + hd * MD + ch * 8); const u32x4 vk = *(const u32x4*)(KM + (rowbase + t) * 1024 + hd * MD + ch * 8);
                *(LAS u32x4*)(lds + MC_QI + t * MC_QROW + ch * 16) = vq; *(LAS u32x4*)(lds + MC_KI + t * MC_QROW + ch * 16) = vk; }
#pragma unroll
            for (int cc = 0; cc < 4; ++cc) { const int c8 = wave + 8 * cc;
                const u32x4 vk = *(const u32x4*)(KM + (rowbase + laneA) * 1024 + hd * MD + c8 * 8); const u32x4 vv = *(const u32x4*)(VM + (rowbase + laneA) * 1024 + hd * MD + c8 * 8);
                LAS unsigned short* dk = (LAS unsigned short*)(lds + MC_KT + (c8 * 8) * MC_TROW + laneA * 2); LAS unsigned short* dv = (LAS unsigned short*)(lds + MC_VT + (c8 * 8) * MC_TROW + laneA * 2);
                dk[0 * 72] = (unsigned short)(vk.x & 0xffffu); dk[1 * 72] = (unsigned short)(vk.x >> 16); dk[2 * 72] = (unsigned short)(vk.y & 0xffffu); dk[3 * 72] = (unsigned short)(vk.y >> 16);
                dk[4 * 72] = (unsigned short)(vk.z & 0xffffu); dk[5 * 72] = (unsigned short)(vk.z >> 16); dk[6 * 72] = (unsigned short)(vk.w & 0xffffu); dk[7 * 72] = (unsigned short)(vk.w >> 16);
                dv[0 * 72] = (unsigned short)(vv.x & 0xffffu); dv[1 * 72] = (unsigned short)(vv.x >> 16); dv[2 * 72] = (unsigned short)(vv.y & 0xffffu); dv[3 * 72] = (unsigned short)(vv.y >> 16);
                dv[4 * 72] = (unsigned short)(vv.z & 0xffffu); dv[5 * 72] = (unsigned short)(vv.z >> 16); dv[6 * 72] = (unsigned short)(vv.w & 0xffffu); dv[7 * 72] = (unsigned short)(vv.w >> 16); }
            if (wave == 0) {
                const float lf = GLF[(size_t)bh * SEQ + c * LCH + laneA], li = GLI[(size_t)bh * SEQ + c * LCH + laneA];
                float bc = lf;
#pragma unroll
                for (int o = 1; o < 64; o <<= 1) { const float t = __shfl_up(bc, o); if (laneA >= o) bc += t; }
                const float av = li - bc; float cm = av;
#pragma unroll
                for (int o = 1; o < 64; o <<= 1) { const float t = __shfl_up(cm, o); if (laneA >= o) cm = fmaxf(cm, t); }
                const float gv = fmaxf(mrun, cm); const float Gc = __shfl(gv, 63), bL = __shfl(bc, 63);
                mc_sc(lds, 0)[laneA] = av; mc_sc(lds, 1)[laneA] = gv; mc_sc(lds, 2)[laneA] = __expf(mrun - gv); mc_sc(lds, 3)[laneA] = __expf(av - Gc); mc_sc(lds, 4)[laneA] = __expf(-(bc + gv));
                if (laneA == 0) misc[0] = __expf(mrun - Gc);
                mrun = bL + Gc;
            } }
            __syncthreads();
            { OPQ(tB); const int laneB = tB & 63, l15 = laneB & 15, l4 = laneB >> 4;
                const int tt = wave >> 1;
#pragma unroll
                for (int sti = 0; sti < 2; ++sti) { const int st = 2 * (wave & 1) + sti;
                    f32x4 acc4 = {0.f, 0.f, 0.f, 0.f};
                    if (st <= tt) {
#pragma unroll
                        for (int ks = 0; ks < 8; ++ks) { const bf16x8 A = *(const LAS bf16x8*)(lds + MC_QI + (16 * tt + l15) * MC_QROW + ks * 64 + l4 * 16);
                            const bf16x8 B = *(const LAS bf16x8*)(lds + MC_KI + (16 * st + l15) * MC_QROW + ks * 64 + l4 * 16); acc4 = MFMA16(A, B, acc4); }
                    }
                    const int sidx = 16 * st + l15; const float as_ = mc_sc(lds, 0)[sidx];
#pragma unroll
                    for (int rg = 0; rg < 4; ++rg) { const int t = 16 * tt + 4 * l4 + rg; float p = 0.f;
                        if (st <= tt && sidx <= t) p = acc4[rg] * __expf(as_ - mc_sc(lds, 1)[t]);
                        *(LAS unsigned short*)(lds + MC_P + t * MC_TROW + sidx * 2) = (unsigned short)f2bf(p);
                        float sum = p; sum += __shfl_xor(sum, 1); sum += __shfl_xor(sum, 2); sum += __shfl_xor(sum, 4); sum += __shfl_xor(sum, 8);
                        if (l15 == 0) mc_sc(lds, 7 + st)[t] = sum; }
                }
              const int t = tB >> 3, seg = tB & 7; float sacc = 0.f;
#pragma unroll
                for (int k = 0; k < 4; ++k) { const u32x4 qv = *(const LAS u32x4*)(lds + MC_QI + t * MC_QROW + (seg * 32 + k * 8) * 2);
                    const f32x4 n0 = *(const LAS f32x4*)(nvec + seg * 32 + k * 8), n1 = *(const LAS f32x4*)(nvec + seg * 32 + k * 8 + 4);
                    sacc += bflo(qv.x) * n0.x + bfhi(qv.x) * n0.y + bflo(qv.y) * n0.z + bfhi(qv.y) * n0.w + bflo(qv.z) * n1.x + bfhi(qv.z) * n1.y + bflo(qv.w) * n1.z + bfhi(qv.w) * n1.w; }
                sacc += __shfl_xor(sacc, 1); sacc += __shfl_xor(sacc, 2); sacc += __shfl_xor(sacc, 4);
                if (seg == 0) mc_sc(lds, 5)[t] = sacc; }
            __syncthreads();
            const float cd = misc[0];
            f32x16 acc[2];
            { OPQ(tC); const int laneC = tC & 63, r = laneC & 31, hf = laneC >> 5;
            if (tC < 64) { const int t = tC; const float den = mc_sc(lds, 7)[t] + mc_sc(lds, 8)[t] + mc_sc(lds, 9)[t] + mc_sc(lds, 10)[t];
                const float dn = den + mc_sc(lds, 2)[t] * mc_sc(lds, 5)[t]; mc_sc(lds, 6)[t] = 1.0f / fmaxf(fabsf(dn), mc_sc(lds, 4)[t]); }
#pragma unroll
            for (int t2 = 0; t2 < 2; ++t2)
#pragma unroll
                for (int i = 0; i < 16; ++i) acc[t2][i] = 0.f;
            const LAS unsigned char* qbase = lds + MC_QI + r * MC_QROW + hf * 8;
#pragma unroll
            for (int dt = 0; dt < 8; ++dt) { const bf16x8 cl = pack_lo(C[dt]), chh = pack_hi(C[dt]);
#pragma unroll
                for (int t2 = 0; t2 < 2; ++t2) { const LAS unsigned char* qb = qbase + t2 * 32 * MC_QROW + dt * 64;
                    const s16x4 a0l = *(const LAS s16x4*)(qb), a0h = *(const LAS s16x4*)(qb + 16), a1l = *(const LAS s16x4*)(qb + 32), a1h = *(const LAS s16x4*)(qb + 48);
                    acc[t2] = MFMA32(__builtin_shufflevector(a0l, a0h, 0, 1, 2, 3, 4, 5, 6, 7), cl, acc[t2]);
                    acc[t2] = MFMA32(__builtin_shufflevector(a1l, a1h, 0, 1, 2, 3, 4, 5, 6, 7), chh, acc[t2]); } }
#pragma unroll
            for (int t2 = 0; t2 < 2; ++t2)
#pragma unroll
                for (int i = 0; i < 16; ++i) acc[t2][i] *= mc_sc(lds, 2)[32 * t2 + crow(i, hf)];
            bf16x8 vt[4];
            const LAS unsigned char* vbase = lds + MC_VT + (32 * wave + r) * MC_TROW + hf * 16;
#pragma unroll
            for (int ks = 0; ks < 4; ++ks) vt[ks] = *(const LAS bf16x8*)(vbase + ks * 32);
            const LAS unsigned char* pbase = lds + MC_P + r * MC_TROW + hf * 16;
#pragma unroll
            for (int t2 = 0; t2 < 2; ++t2)
#pragma unroll
                for (int ks = 0; ks < 4; ++ks) { const bf16x8 pA = *(const LAS bf16x8*)(pbase + t2 * 32 * MC_TROW + ks * 32); acc[t2] = MFMA32(pA, vt[ks], acc[t2]); }
            asm volatile("" : "+v"(acc[0]), "+v"(acc[1]));
#pragma unroll
            for (int ks = 0; ks < 4; ++ks) {
                const f32x4 w0 = *(const LAS f32x4*)(mc_sc(lds, 3) + 16 * ks + 8 * hf), w1 = *(const LAS f32x4*)(mc_sc(lds, 3) + 16 * ks + 8 * hf + 4);
                const u32x4 vv = __builtin_bit_cast(u32x4, vt[ks]); u32x4 o;
                o.x = pk2(bflo(vv.x) * w0.x, bfhi(vv.x) * w0.y); o.y = pk2(bflo(vv.y) * w0.z, bfhi(vv.y) * w0.w); o.z = pk2(bflo(vv.z) * w1.x, bfhi(vv.z) * w1.y); o.w = pk2(bflo(vv.w) * w1.z, bfhi(vv.w) * w1.w);
                vt[ks] = __builtin_bit_cast(bf16x8, o); }
            const LAS unsigned char* kbase = lds + MC_KT + r * MC_TROW + hf * 16;
#pragma unroll
            for (int dt = 0; dt < 8; ++dt) {
#pragma unroll
                for (int i = 0; i < 16; ++i) C[dt][i] *= cd;
#pragma unroll
                for (int ks = 0; ks < 4; ++ks) { const bf16x8 kA = *(const LAS bf16x8*)(kbase + dt * 32 * MC_TROW + ks * 32); C[dt] = MFMA32(kA, vt[ks], C[dt]); } }
            if (tC < 256) { float sacc = cd * nvec[tC];
#pragma unroll
                for (int k = 0; k < 8; ++k) { const u32x4 kv = *(const LAS u32x4*)(lds + MC_KT + tC * MC_TROW + k * 16);
                    const f32x4 w0 = *(const LAS f32x4*)(mc_sc(lds, 3) + k * 8), w1 = *(const LAS f32x4*)(mc_sc(lds, 3) + k * 8 + 4);
                    sacc += bflo(kv.x) * w0.x + bfhi(kv.x) * w0.y + bflo(kv.y) * w0.z + bfhi(kv.y) * w0.w + bflo(kv.z) * w1.x + bfhi(kv.z) * w1.y + bflo(kv.w) * w1.z + bfhi(kv.w) * w1.w; }
                nvec[tC] = sacc; }
            }
            __syncthreads();
            { OPQ(tD); const int laneD = tD & 63, r = laneD & 31, hf = laneD >> 5;
#pragma unroll
            for (int t2 = 0; t2 < 2; ++t2)
#pragma unroll
                for (int i = 0; i < 16; ++i) *(LAS float*)(lds + MC_QI + (32 * t2 + crow(i, hf)) * MC_STROW + (32 * wave + r) * 4) = acc[t2][i];
            }
            __syncthreads();
            { OPQ(tE); const int t = tE >> 3, seg = tE & 7; const float rden = mc_sc(lds, 6)[t]; float s1 = 0.f, s2 = 0.f;
                const LAS unsigned char* sp = lds + MC_QI + t * MC_STROW + (seg * 32) * 4;
#pragma unroll
                for (int k = 0; k < 8; ++k) { const f32x4 v = *(const LAS f32x4*)(sp + k * 16) * rden;
                    s1 += (v.x + v.y) + (v.z + v.w); s2 += (v.x * v.x + v.y * v.y) + (v.z * v.z + v.w * v.w); }
                s1 += __shfl_xor(s1, 1); s1 += __shfl_xor(s1, 2); s1 += __shfl_xor(s1, 4); s2 += __shfl_xor(s2, 1); s2 += __shfl_xor(s2, 2); s2 += __shfl_xor(s2, 4);
                const float mean = s1 * (1.0f / MD); const float var = fmaxf(s2 * (1.0f / MD) - mean * mean, 0.f); const float rstd = 1.0f / sqrtf(var + LN_EPS);
                const float sc = rden * rstd, sh = -mean * rstd;
                const size_t row = rowbase + t; const int col = hd * MD + seg * 32;
#pragma unroll 1
                for (int k = 0; k < 4; ++k) { const u32x4 xv = *(const u32x4*)(XC + row * 1024 + col + k * 8); const u32x4 zv = *(const u32x4*)(ZM + row * 1024 + col + k * 8);
                    const f32x4 g0 = *(const f32x4*)(mh_norm + col + k * 8), g1 = *(const f32x4*)(mh_norm + col + k * 8 + 4), k0 = *(const f32x4*)(skip + col + k * 8), k1 = *(const f32x4*)(skip + col + k * 8 + 4);
                    const f32x4 h0 = *(const LAS f32x4*)(sp + k * 32) * sc + sh, h1 = *(const LAS f32x4*)(sp + k * 32 + 16) * sc + sh;
                    float y[8];
                    y[0] = (h0.x * g0.x + k0.x * bflo(xv.x)) * silu_f(bflo(zv.x)); y[1] = (h0.y * g0.y + k0.y * bfhi(xv.x)) * silu_f(bfhi(zv.x));
                    y[2] = (h0.z * g0.z + k0.z * bflo(xv.y)) * silu_f(bflo(zv.y)); y[3] = (h0.w * g0.w + k0.w * bfhi(xv.y)) * silu_f(bfhi(zv.y));
                    y[4] = (h1.x * g1.x + k1.x * bflo(xv.z)) * silu_f(bflo(zv.z)); y[5] = (h1.y * g1.y + k1.y * bfhi(xv.z)) * silu_f(bfhi(zv.z));
                    y[6] = (h1.z * g1.z + k1.z * bflo(xv.w)) * silu_f(bflo(zv.w)); y[7] = (h1.w * g1.w + k1.w * bfhi(xv.w)) * silu_f(bfhi(zv.w));
                    u32x4 o; o.x = pk2(y[0], y[1]); o.y = pk2(y[2], y[3]); o.z = pk2(y[4], y[5]); o.w = pk2(y[6], y[7]);
                    *(u32x4*)(QK + row * 2048 + 1024 + col + k * 8) = o; } }
            __syncthreads();
        }
    }
#undef OPQ
}

DI void phase_final(const Args& a, int lane, int wave, int bid, int G) {
    const float* x = a.in[0]; const float* g_post = a.in[3]; float* out = a.out;
    const int gw = bid * NWAVES + wave, NGW = G * NWAVES;
    const f32x4* gr = (const f32x4*)g_post + lane; f32x4 gg[4];
#pragma unroll
    for (int j = 0; j < 4; ++j) gg[j] = gr[64 * j];
    for (int m = gw; m < MTOK; m += NGW) {
        f32x4* yr = (f32x4*)(out + (size_t)m * DM) + lane; const f32x4* xr = (const f32x4*)(x + (size_t)m * DM) + lane; f32x4 v[4], xv[4]; float s = 0.f;
#pragma unroll
        for (int j = 0; j < 4; ++j) { v[j] = yr[64 * j]; xv[j] = xr[64 * j]; s += (v[j].x * v[j].x + v[j].y * v[j].y) + (v[j].z * v[j].z + v[j].w * v[j].w); }
        const float rstd = 1.0f / sqrtf(wave_sum(s) * (1.0f / DM) + RMS_EPS);
#pragma unroll
        for (int j = 0; j < 4; ++j) { f32x4 o; o.x = xv[j].x + v[j].x * rstd * gg[j].x; o.y = xv[j].y + v[j].y * rstd * gg[j].y; o.z = xv[j].z + v[j].z * rstd * gg[j].z; o.w = xv[j].w + v[j].w * rstd * gg[j].w; yr[64 * j] = o; }
    }
}

constexpr int NPHASE = 12;
#ifndef MK_MULTI
#define MK_MULTI 0
#endif
__global__ void __launch_bounds__(NTHR, 2) hymba_fwd(Args args) {
    extern __shared__ __attribute__((aligned(16))) unsigned char lds_raw[];
    LAS unsigned char* lds = (LAS unsigned char*)lds_raw;
    cg::grid_group grid = cg::this_grid();
    const int tid = threadIdx.x, lane = tid & 63, wave = __builtin_amdgcn_readfirstlane(tid >> 6), bid = blockIdx.x, G = gridDim.x;
    const int lo = args.ph_lo, hi = args.ph_hi;
#ifdef ONLY_PHASE
#define IN(k) ((k) == ONLY_PHASE && lo <= (k) && (k) < hi)
#else
#define IN(k) (lo <= (k) && (k) < hi)
#endif
#define SEAM(k) do { if (IN(k) && IN((k) + 1)) grid.sync(); } while (0)
    unsigned char* ws = args.ws;
    if (IN(0)) { phase_prologue(args, lds, tid, lane, wave, bid, G); } SEAM(0);
    if (IN(1)) {
        pg8::Gemm g{(const pg8::bf16_t*)(ws + WS_XN), (const pg8::bf16_t*)(ws + WS_WINT), MTOK, NIN, DM}; pg8::StaticOrder S; S.init(MTOK, NIN, G, bid);
        pg8::EpiProj E{(pg8::bf16_t*)(ws + WS_QK), (pg8::bf16_t*)(ws + WS_V), (pg8::bf16_t*)(ws + WS_G), (pg8::bf16_t*)(ws + WS_XM), (pg8::bf16_t*)(ws + WS_ZM), QSCALE};
        pg8::gemm_phase<pg8::EpiProj, pg8::StaticOrder, true, true>(lds, g, S, E);
    } SEAM(1);
    if (IN(2)) { phase_kstat(args, lds, tid, lane, wave, bid, G); } SEAM(2);
    if (IN(3)) { phase_sel(args, lds, tid, lane, wave, bid, G); } SEAM(3);
    if (IN(4)) { phase_att_gather(args, lds, tid, lane, wave, bid, G); } SEAM(4);
    if (IN(5)) { phase_att_own(args, lds, tid, lane, wave, bid, G); } SEAM(5);
    if (IN(6)) { phase_mpre(args, lds, tid, lane, wave, bid, G); } SEAM(6);
    if (IN(7)) { phase_mstate(args, lds, tid, lane, wave, bid, G); } SEAM(7);
    if (IN(8)) { phase_mcomb(args, tid, bid, G); } SEAM(8);
    if (IN(9)) { phase_mscan(args, lds, tid, lane, wave, bid, G); } SEAM(9);
    if (IN(10)) {
        pg8::Gemm g{(const pg8::bf16_t*)(ws + WS_QK), (const pg8::bf16_t*)(ws + WS_WOUTT), MTOK, DM, MIXW}; pg8::StaticOrder S; S.init(MTOK, DM, G, bid);
        pg8::EpiF32 E{args.out, DM};
        pg8::gemm_phase<pg8::EpiF32, pg8::StaticOrder, true, true>(lds, g, S, E);
    } SEAM(10);
    if (IN(11)) { phase_final(args, lane, wave, bid, G); }
#undef IN
#undef SEAM
}

extern "C" void kernel_launch(void* const* d_in, const int* in_sizes, int n_in, void* d_out, int out_size, void* d_ws, size_t ws_size, hipStream_t stream) {
    static int grid = 0;
    if (grid == 0) {
        if (n_in != 15 || out_size != MTOK * DM || ws_size < WS_END) { fprintf(stderr, "kernel_launch: unexpected shapes (n_in %d out %d ws %zu)\n", n_in, out_size, ws_size); grid = -1; return; }
        int dev = 0, cus = 0, per_cu = 0;
        if (hipGetDevice(&dev) != hipSuccess || hipDeviceGetAttribute(&cus, hipDeviceAttributeMultiprocessorCount, dev) != hipSuccess) { grid = -1; return; }
        if (hipFuncSetAttribute((const void*)hymba_fwd, hipFuncAttributeMaxDynamicSharedMemorySize, LDS_BYTES) != hipSuccess) { fprintf(stderr, "kernel_launch: hipFuncSetAttribute failed\n"); grid = -1; return; }
        if (hipOccupancyMaxActiveBlocksPerMultiprocessor(&per_cu, (const void*)hymba_fwd, NTHR, LDS_BYTES) != hipSuccess || per_cu < 1) { fprintf(stderr, "kernel_launch: occupancy query says %d\n", per_cu); per_cu = 1; }
        (void)hipGetLastError();
        grid = cus * 1;
        fprintf(stderr, "kernel_launch: grid %d (cus %d, query per_cu %d)\n", grid, cus, per_cu);
    }
    if (grid < 0) return;
    (void)hipMemsetAsync((char*)d_ws + WS_CTL, 0, CTL_ZERO_BYTES, stream);
    Args a{};
    for (int i = 0; i < 15; ++i) a.in[i] = (const float*)d_in[i];
    a.out = (float*)d_out; a.ws = (unsigned char*)d_ws;
#if MK_MULTI
    for (int p = 0; p < NPHASE; ++p) { a.ph_lo = p; a.ph_hi = p + 1; hipLaunchKernelGGL(hymba_fwd, dim3(grid), dim3(NTHR), LDS_BYTES, stream, a); }
#else
    a.ph_lo = 0; a.ph_hi = NPHASE;
    void* kargs[] = {&a};
    hipError_t e = hipLaunchCooperativeKernel((const void*)hymba_fwd, dim3(grid), dim3(NTHR), kargs, LDS_BYTES, stream);
    if (e != hipSuccess) fprintf(stderr, "kernel_launch: cooperative launch failed: %s (grid %d)\n", hipGetErrorString(e), grid);
#endif
}
```

```cpp
#include <hip/hip_runtime.h>
#include <hip/hip_cooperative_groups.h>
#include <cstdio>
#include <cstdint>
namespace cg = cooperative_groups;
namespace pg8 {
#define PG8_LAS __attribute__((address_space(3)))
typedef unsigned short bf16_t;
typedef short bf16x8 __attribute__((ext_vector_type(8)));
typedef float f32x4 __attribute__((ext_vector_type(4)));
typedef unsigned u32x4 __attribute__((ext_vector_type(4)));
constexpr int BM = 256, BK = 64, HALF = 128, HTB = HALF * BK * 2  , STAGE_BYTES = 8 * HTB, NXCD = 8, WGM = 8;

__host__ __device__ __forceinline__ int lds_byte(int r, int c) { const int st = (r >> 4) * 2 + (c >> 5), rr = r & 15, cc = c & 31, ob = rr * 64 + cc * 2; return st * 1024 + (ob ^ (((ob >> 9) & 1) << 5)); }
__host__ __device__ __forceinline__ void stage_rc(int b, int& R, int& C) { const int st = b / 1024, sb = b % 1024, swz = sb ^ (((sb >> 9) & 1) << 5); R = (st >> 1) * 16 + swz / 64; C = (st & 1) * 32 + (swz % 64) / 2; }
__host__ __device__ __forceinline__ int perm32(int rho) { const int n = rho >> 4, i = rho & 15; return 8 * (i >> 2) + 4 * n + (i & 3); }

struct Unit { int pm, pn; };
struct Gemm { const bf16_t* A; const bf16_t* Bt; int M, N, K; };

struct StaticOrder {
    int nM, nN, nwg, G, c;
    __host__ __device__ void init(int M, int N, int G_, int c_) { nM = M / BM; nN = N / BM; nwg = nM * nN; G = G_; c = c_; }
    __host__ __device__ bool next(int i, Unit& u) const {
        const long L = (long)i * G + c; if (L >= nwg) return false;
        int wgid = (int)L; { const int q = nwg / NXCD, r = nwg % NXCD, xcd = wgid % NXCD, off = wgid / NXCD; wgid = (xcd < r ? xcd * (q + 1) : r * (q + 1) + (xcd - r) * q) + off; }
        const int nig = WGM * nN, gid = wgid / nig, fm = gid * WGM, gsz = (nM - fm) < WGM ? (nM - fm) : WGM;
        u.pm = fm + ((wgid % nig) % gsz); u.pn = (wgid % nig) / gsz; return true;
    }
    __device__ __forceinline__ void a_ready(const Unit&) const {}
    __device__ __forceinline__ void done(const Unit&) const {}
};

__device__ __forceinline__ unsigned cvt_pk_bf16(float lo, float hi) { unsigned r; asm volatile("v_cvt_pk_bf16_f32 %0, %1, %2" : "=v"(r) : "v"(lo), "v"(hi)); return r; }
typedef float f32x2 __attribute__((ext_vector_type(2)));
struct EpiProj {
    static constexpr bool PERM = true, AFTER_DRAIN = false;
    bf16_t* QK; bf16_t* V; bf16_t* G; bf16_t* XM; bf16_t* ZM; float qscale;
    __device__ __forceinline__ void operator()(const f32x4 (&acc)[2][2][4][2], const Unit& u, int wr, int wc, int fr, int fq) const {
        const int row0 = u.pm * BM + wr * 64 + fr; const int colt = u.pn * BM; const int t = colt >> 10; const int cgp = colt & 1023;
        bf16_t* base; int ldc; float sc = 1.f;
        if (t == 0) { base = QK; ldc = 2048; sc = qscale; } else if (t == 1) { base = QK + 1024; ldc = 2048; } else if (t == 2) { base = V; ldc = 1024; }
        else if (t == 3) { base = G; ldc = 1024; } else if (t == 4) { base = XM; ldc = 1024; } else { base = ZM; ldc = 1024; }
        const int col0 = cgp + wc * 32 + 8 * fq;
#pragma unroll
        for (int ai = 0; ai < 2; ++ai)
#pragma unroll
            for (int m = 0; m < 4; ++m) { bf16_t* rowp = base + (size_t)(row0 + ai * HALF + m * 16) * ldc + col0;
#pragma unroll
                for (int bj = 0; bj < 2; ++bj) { f32x4 v0 = acc[ai][bj][m][0] * sc, v1 = acc[ai][bj][m][1] * sc;
                    u32x4 w; w.x = cvt_pk_bf16(v0[0], v0[1]); w.y = cvt_pk_bf16(v0[2], v0[3]); w.z = cvt_pk_bf16(v1[0], v1[1]); w.w = cvt_pk_bf16(v1[2], v1[3]);
                    *(u32x4*)(rowp + bj * HALF) = w; } }
    }
};
struct EpiF32 {
    static constexpr bool PERM = false, AFTER_DRAIN = false;
    float* O; int ldc;
    __device__ __forceinline__ void operator()(const f32x4 (&acc)[2][2][4][2], const Unit& u, int wr, int wc, int fr, int fq) const {
        const int col0 = u.pn * BM + wc * 32 + 4 * fq;
#pragma unroll
        for (int ai = 0; ai < 2; ++ai)
#pragma unroll
            for (int m = 0; m < 4; ++m) { const int r = ai * HALF + wr * 64 + m * 16 + fr; const size_t off = (size_t)(u.pm * BM + r) * ldc + col0;
#pragma unroll
                for (int bj = 0; bj < 2; ++bj)
#pragma unroll
                    for (int n = 0; n < 2; ++n) *(f32x4*)(O + off + bj * HALF + n * 16) = acc[ai][bj][m][n]; }
    }
};
template <class Epi, class Sched, bool ALIGN_EPI = false, bool SP2 = false>
__device__ __forceinline__ void gemm_phase(PG8_LAS unsigned char* lds, const Gemm g, const Sched& S, const Epi& E) {
    const int tid = threadIdx.x, wid = __builtin_amdgcn_readfirstlane(tid >> 6), lane = tid & 63, wr = wid >> 2, wc = wid & 3, fr = lane & 15, fq = lane >> 4;
    const int K = g.K, nt = K / BK;
    unsigned voffA[2], voffB[2];
#pragma unroll
    for (int i = 0; i < 2; ++i) { int R, C; stage_rc(tid * 16 + i * 8192, R, C); const int Rb = Epi::PERM ? ((R & ~31) + perm32(R & 31)) : R;
        voffA[i] = (unsigned)(R * K + C) * 2u; voffB[i] = (unsigned)(Rb * K + C) * 2u; }
    const size_t kstep = (size_t)(BK * 2);
    const size_t hstep = (size_t)HALF * K * 2;
    const size_t tstep = 2 * hstep;
    const unsigned ldsw = (unsigned)wid * 1024u;
    const int aoff = lds_byte(wr * 64 + fr, fq * 8), boff = lds_byte(wc * 32 + fr, fq * 8);
#define PG8_SA(b, h) (((b) * 2 + (h)) * HTB)
#define PG8_SB(b, h) ((4 + (b) * 2 + (h)) * HTB)
#define PG8_STAGE(bufoff, gbase, voff) do { _Pragma("unroll") for (int _i = 0; _i < 2; ++_i) \
        __builtin_amdgcn_global_load_lds((const unsigned*)((const char*)(gbase) + (voff)[_i]), (PG8_LAS unsigned*)(lds + (bufoff) + ldsw + _i * 8192), 16, 0, 0); } while (0)
#define PG8_LDA(dst, b, h) do { _Pragma("unroll") for (int m = 0; m < 4; ++m) _Pragma("unroll") for (int k = 0; k < 2; ++k) dst[m][k] = *(const PG8_LAS bf16x8*)(lds + PG8_SA(b, h) + aoff + m * 2048 + k * 1024); } while (0)
#define PG8_LDB(dst, b, h) do { _Pragma("unroll") for (int n = 0; n < 2; ++n) _Pragma("unroll") for (int k = 0; k < 2; ++k) dst[n][k] = *(const PG8_LAS bf16x8*)(lds + PG8_SB(b, h) + boff + n * 2048 + k * 1024); } while (0)
#define PG8_MMA(ai, bj, At, Bt) do { __builtin_amdgcn_s_setprio(1); _Pragma("unroll") for (int m = 0; m < 4; ++m) _Pragma("unroll") for (int n = 0; n < 2; ++n) _Pragma("unroll") for (int k = 0; k < 2; ++k) \
        acc[ai][bj][m][n] = __builtin_amdgcn_mfma_f32_16x16x32_bf16(Bt[n][k], At[m][k], acc[ai][bj][m][n], 0, 0, 0); __builtin_amdgcn_s_setprio(0); } while (0)
#define PG8_WAIT_V(n) asm volatile("s_waitcnt vmcnt(" #n ")" ::: "memory")
#define PG8_WAIT_L(n) asm volatile("s_waitcnt lgkmcnt(" #n ")" ::: "memory")
#define PG8_BAR __builtin_amdgcn_s_barrier()
#define PG8_SCHED __builtin_amdgcn_sched_barrier(0)
    Unit cur, nxt; int ui = 0;
    if (!S.next(0, cur)) return;
    f32x4 acc[2][2][4][2];
#pragma unroll
    for (int a = 0; a < 2; ++a)
#pragma unroll
        for (int b = 0; b < 2; ++b)
#pragma unroll
            for (int m = 0; m < 4; ++m)
#pragma unroll
                for (int n = 0; n < 2; ++n) acc[a][b][m][n] = (f32x4){0.f, 0.f, 0.f, 0.f};
    bf16x8 At[4][2], B0[2][2], B1[2][2];
    const char* cA = (const char*)g.A + (size_t)cur.pm * tstep; const char* cB = (const char*)g.Bt + (size_t)cur.pn * tstep;
    S.a_ready(cur);
    if constexpr (SP2) {
        PG8_STAGE(PG8_SB(0, 0), cB, voffB); PG8_STAGE(PG8_SB(0, 1), cB + hstep, voffB); PG8_STAGE(PG8_SA(0, 0), cA, voffA); PG8_STAGE(PG8_SA(0, 1), cA + hstep, voffA);
        if (wr == 1) PG8_BAR;
        PG8_WAIT_V(2); PG8_BAR;
        PG8_STAGE(PG8_SB(1, 0), cB + kstep, voffB); PG8_STAGE(PG8_SA(1, 0), cA + kstep, voffA); PG8_STAGE(PG8_SB(1, 1), cB + hstep + kstep, voffB);
        PG8_WAIT_V(6); PG8_BAR;
    } else {
        PG8_STAGE(PG8_SB(0, 0), cB, voffB); PG8_STAGE(PG8_SA(0, 0), cA, voffA); PG8_STAGE(PG8_SB(0, 1), cB + hstep, voffB); PG8_STAGE(PG8_SA(0, 1), cA + hstep, voffA);
        if (wr == 1) PG8_BAR;
        PG8_WAIT_V(4); PG8_BAR;
        PG8_STAGE(PG8_SB(1, 0), cB + kstep, voffB); PG8_STAGE(PG8_SA(1, 0), cA + kstep, voffA); PG8_STAGE(PG8_SB(1, 1), cB + hstep + kstep, voffB);
        PG8_WAIT_V(6); PG8_BAR;
    }
    for (;;) {
        const bool has_next = S.next(ui + 1, nxt);
        const char* nA = has_next ? (const char*)g.A + (size_t)nxt.pm * tstep : cA; const char* nB = has_next ? (const char*)g.Bt + (size_t)nxt.pn * tstep : cB;
        for (int t = 0; t < nt; t += 2) {
            const bool last = (t == nt - 2);
            const char* a1 = cA + (size_t)(t + 1) * kstep;
            const char* a2 = last ? nA : cA + (size_t)(t + 2) * kstep; const char* b2 = last ? nB : cB + (size_t)(t + 2) * kstep;
            const char* a3 = a2 + kstep; const char* b3 = b2 + kstep;
            if (last && has_next) S.a_ready(nxt);
            if constexpr (SP2) {
            PG8_LDB(B0, 0, 0); PG8_LDB(B1, 0, 1); PG8_SCHED; PG8_LDA(At, 0, 0); PG8_STAGE(PG8_SA(1, 1), a1 + hstep, voffA);
            PG8_WAIT_V(8); PG8_WAIT_L(0); PG8_BAR; PG8_MMA(0, 0, At, B0); PG8_MMA(0, 1, At, B1); PG8_BAR; PG8_SCHED;
            PG8_LDA(At, 0, 1); PG8_STAGE(PG8_SB(0, 0), b2, voffB); PG8_STAGE(PG8_SB(0, 1), b2 + hstep, voffB); PG8_STAGE(PG8_SA(0, 0), a2, voffA);
            PG8_WAIT_V(8); PG8_WAIT_L(0); PG8_BAR; PG8_MMA(1, 0, At, B0); PG8_MMA(1, 1, At, B1); PG8_BAR; PG8_SCHED;
            PG8_LDB(B0, 1, 0); PG8_LDB(B1, 1, 1); PG8_SCHED; PG8_LDA(At, 1, 0); PG8_STAGE(PG8_SA(0, 1), a2 + hstep, voffA);
            PG8_WAIT_V(8); PG8_WAIT_L(0); PG8_BAR; PG8_MMA(0, 0, At, B0); PG8_MMA(0, 1, At, B1); PG8_BAR; PG8_SCHED;
            PG8_LDA(At, 1, 1); PG8_STAGE(PG8_SB(1, 0), b3, voffB); PG8_STAGE(PG8_SB(1, 1), b3 + hstep, voffB); PG8_STAGE(PG8_SA(1, 0), a3, voffA);
            PG8_WAIT_V(8); PG8_WAIT_L(0); PG8_BAR; PG8_MMA(1, 0, At, B0); PG8_MMA(1, 1, At, B1); PG8_BAR; PG8_SCHED;
            } else {
            PG8_LDB(B0, 0, 0); PG8_SCHED; PG8_LDA(At, 0, 0); PG8_STAGE(PG8_SA(1, 1), a1 + hstep, voffA);
            PG8_WAIT_L(8); PG8_BAR; PG8_WAIT_L(0); PG8_MMA(0, 0, At, B0); PG8_BAR; PG8_SCHED;
            PG8_LDB(B1, 0, 1); PG8_STAGE(PG8_SB(0, 0), b2, voffB);
            PG8_BAR; PG8_WAIT_L(0); PG8_MMA(0, 1, At, B1); PG8_BAR;
            PG8_LDA(At, 0, 1); PG8_STAGE(PG8_SA(0, 0), a2, voffA);
            PG8_BAR; PG8_WAIT_L(0); PG8_MMA(1, 0, At, B0); PG8_BAR; PG8_SCHED;
            PG8_STAGE(PG8_SB(0, 1), b2 + hstep, voffB);
            PG8_WAIT_V(6); PG8_BAR; PG8_MMA(1, 1, At, B1); PG8_BAR;
            PG8_LDB(B0, 1, 0); PG8_SCHED; PG8_LDA(At, 1, 0); PG8_STAGE(PG8_SA(0, 1), a2 + hstep, voffA);
            PG8_WAIT_L(8); PG8_BAR; PG8_WAIT_L(0); PG8_MMA(0, 0, At, B0); PG8_BAR; PG8_SCHED;
            PG8_LDB(B1, 1, 1); PG8_STAGE(PG8_SB(1, 0), b3, voffB);
            PG8_BAR; PG8_WAIT_L(0); PG8_MMA(0, 1, At, B1); PG8_BAR;
            PG8_LDA(At, 1, 1); PG8_STAGE(PG8_SA(1, 0), a3, voffA);
            PG8_BAR; PG8_WAIT_L(0); PG8_MMA(1, 0, At, B0); PG8_BAR; PG8_SCHED;
            PG8_STAGE(PG8_SB(1, 1), b3 + hstep, voffB);
            PG8_WAIT_V(6); PG8_BAR; PG8_MMA(1, 1, At, B1); PG8_BAR;
            }
        }
        if constexpr (ALIGN_EPI) { if (wr == 0) PG8_BAR; }
        if constexpr (!Epi::AFTER_DRAIN) { E(acc, cur, wr, wc, fr, fq); S.done(cur); }
        if (!has_next) break;
#pragma unroll
        for (int a = 0; a < 2; ++a)
#pragma unroll
            for (int b = 0; b < 2; ++b)
#pragma unroll
                for (int m = 0; m < 4; ++m)
#pragma unroll
                    for (int n = 0; n < 2; ++n) acc[a][b][m][n] = (f32x4){0.f, 0.f, 0.f, 0.f};
        cur = nxt; cA = nA; cB = nB; ++ui;
        if constexpr (ALIGN_EPI) { if (wr == 1) PG8_BAR; }
    }
    PG8_WAIT_V(0);
    if constexpr (!ALIGN_EPI) { if (wr == 0) PG8_BAR; }
    PG8_BAR;
    if constexpr (Epi::AFTER_DRAIN) { E.fused(acc, cur, wr, wc, fr, fq, lds, wid, lane); S.done(cur); }
#undef PG8_SA
#undef PG8_SB
#undef PG8_STAGE
#undef PG8_LDA
#undef PG8_LDB
#undef PG8_MMA
#undef PG8_WAIT_V
#undef PG8_WAIT_L
#undef PG8_BAR
#undef PG8_SCHED
}
}

constexpr int NWAVES = 8, NTHR = 512;
constexpr int BATCH = 4, SEQ = 8192, DM = 1024, MTOK = BATCH * SEQ, NIN = 6144, MIXW = 2048;
constexpr int NH = 8, DH = 128, NBLK = SEQ / 256;
constexpr int MH = 4, MD = 256, LCH = 64, NCH = SEQ / LCH;
constexpr float LOG2E = 1.4426950408889634f;
constexpr float QSCALE = 0.08838834764831845f * LOG2E;
constexpr float RMS_EPS = 1e-6f, LN_EPS = 1e-5f;
constexpr int LISTSZ = 256 * 496;
__host__ __device__ constexpr int list_off(int j) { return 256 * (31 * j - (j * (j - 1)) / 2); }

constexpr size_t MiB = 1u << 20;
constexpr size_t WS_CTL = 0, CTL_ZERO_BYTES = 64 * 1024;
constexpr size_t WS_BIASD = 1 * MiB;
constexpr size_t WS_WEFF = 1 * MiB + 64 * 1024;
constexpr size_t WS_KMEAN = 1 * MiB + 128 * 1024;
constexpr size_t WS_KMAX = 1 * MiB + 640 * 1024;
constexpr size_t WS_GLI = 2 * MiB, WS_GLF = 2 * MiB + 512 * 1024;
constexpr size_t WS_SEL = 3 * MiB;
constexpr size_t WS_LPART = 7 * MiB;
constexpr size_t WS_WINT = 10 * MiB;
constexpr size_t WS_WOUTT = 22 * MiB;
constexpr size_t WS_LIST = 26 * MiB;
constexpr size_t WS_XN = 64 * MiB;
constexpr size_t WS_QK = 128 * MiB;
constexpr size_t WS_V = 256 * MiB, WS_G = 320 * MiB, WS_XM = 384 * MiB, WS_ZM = 448 * MiB, WS_END = 512 * MiB;
constexpr size_t WS_NST = 42 * MiB;
constexpr size_t WS_PST = 42 * MiB + 512 * 1024, WS_MIN = 42 * MiB + 516 * 1024;
constexpr size_t WS_CST = WS_V;
constexpr int NSC = 16, SCCH = NCH / NSC;
constexpr int CW_CNT = 1024;
constexpr int CW_BAR = 4096;
constexpr int LDS_BARST = 163840 - 64;

constexpr int LDS_BYTES = 163840;
#define GAS __attribute__((address_space(1)))
#define LAS __attribute__((address_space(3)))
#define DI __device__ __forceinline__
typedef unsigned short bf16;
typedef unsigned u32x4 __attribute__((ext_vector_type(4)));
typedef unsigned u32x2 __attribute__((ext_vector_type(2)));
typedef int i32x4 __attribute__((ext_vector_type(4)));
typedef float f32x4 __attribute__((ext_vector_type(4)));
typedef float f32x16 __attribute__((ext_vector_type(16)));
typedef short bf16x8 __attribute__((ext_vector_type(8)));
typedef short s16x4 __attribute__((ext_vector_type(4)));
typedef float f32x2_t __attribute__((ext_vector_type(2)));
typedef __bf16 bf16x2_t __attribute__((ext_vector_type(2)));
#define MFMA32(a, b, c) __builtin_amdgcn_mfma_f32_32x32x16_bf16((a), (b), (c), 0, 0, 0)
#define MFMA16(a, b, c) __builtin_amdgcn_mfma_f32_16x16x32_bf16((a), (b), (c), 0, 0, 0)

DI float bf2f(unsigned u16) { return __uint_as_float(u16 << 16); }
DI float bflo(unsigned w) { return __uint_as_float(w << 16); }
DI float bfhi(unsigned w) { return __uint_as_float(w & 0xffff0000u); }
DI unsigned pk2(float lo, float hi) { f32x2_t v = {lo, hi}; bf16x2_t b = __builtin_convertvector(v, bf16x2_t); return __builtin_bit_cast(unsigned, b); }
DI unsigned f2bf(float f) { return pk2(f, 0.f) & 0xffffu; }
DI int crow(int reg, int h) { return (reg & 3) + 8 * (reg >> 2) + 4 * h; }
DI float wave_sum(float v) {
#pragma unroll
    for (int o = 1; o < 64; o <<= 1) v += __shfl_xor(v, o);
    return v;
}
DI float wave_max(float v) {
#pragma unroll
    for (int o = 1; o < 64; o <<= 1) v = fmaxf(v, __shfl_xor(v, o));
    return v;
}
DI bf16x8 pack_lo(const f32x16& x) { u32x4 p; p.x = pk2(x[0], x[1]); p.y = pk2(x[2], x[3]); p.z = pk2(x[4], x[5]); p.w = pk2(x[6], x[7]); return __builtin_bit_cast(bf16x8, p); }
DI bf16x8 pack_hi(const f32x16& x) { u32x4 p; p.x = pk2(x[8], x[9]); p.y = pk2(x[10], x[11]); p.z = pk2(x[12], x[13]); p.w = pk2(x[14], x[15]); return __builtin_bit_cast(bf16x8, p); }
DI float silu_f(float v) { return v / (1.0f + __expf(-v)); }

struct Args { const float* in[15]; float* out; unsigned char* ws; int ph_lo, ph_hi; };

DI void p0_transpose_item(const float* W, int K, int N, bf16* WT, LAS float* scr, int item, int lane) {
    const int nblk = N / 32, kb = item / nblk, nb = item % nblk, k0 = 64 * kb, n0 = 32 * nb;
#pragma unroll 8
    for (int i = 0; i < 32; ++i) { const int kk = 2 * i + (lane >> 5); scr[kk * 33 + (lane & 31)] = W[(size_t)(k0 + kk) * N + n0 + (lane & 31)]; }
    asm volatile("s_waitcnt lgkmcnt(0)" ::: "memory");
    const int c = lane & 7;
#pragma unroll
    for (int j = 0; j < 4; ++j) { const int n = (lane >> 3) + 8 * j; const LAS float* s = scr + (8 * c) * 33 + n;
        u32x4 o; o.x = pk2(s[0 * 33], s[1 * 33]); o.y = pk2(s[2 * 33], s[3 * 33]); o.z = pk2(s[4 * 33], s[5 * 33]); o.w = pk2(s[6 * 33], s[7 * 33]);
        *(u32x4*)(WT + (size_t)(n0 + n) * K + k0 + 8 * c) = o; }
    asm volatile("s_waitcnt lgkmcnt(0)" ::: "memory");
}
DI int t5_bucket(int n) {
    if (n < 16) return n;
    int b = 16;
    b += (n >= 22); b += (n >= 30); b += (n >= 40); b += (n >= 54); b += (n >= 73); b += (n >= 99); b += (n >= 134); b += (n >= 182);
    b += (n >= 246); b += (n >= 332); b += (n >= 450); b += (n >= 609); b += (n >= 825); b += (n >= 1117); b += (n >= 1513);
    return b;
}
DI void phase_prologue(const Args& a, LAS unsigned char* lds, int tid, int lane, int wave, int bid, int G) {
    const float* x = a.in[0]; const float* rel_bias = a.in[1]; const float* g_pre = a.in[2]; const float* w_in = a.in[4];
    const float* wq = a.in[7]; const float* wk = a.in[8]; const float* wv = a.in[9]; const float* w_if = a.in[10]; const float* w_out = a.in[14];
    unsigned char* ws = a.ws;
    LAS float* scr = (LAS float*)(lds + wave * 16384);
    const int gw = bid * NWAVES + wave, NGW = G * NWAVES;
    constexpr int I_IN = (DM / 64) * (NIN / 32), I_OUT = (MIXW / 64) * (DM / 32);
    for (int it = gw; it < I_IN + I_OUT; it += NGW) {
        if (it < I_IN) p0_transpose_item(w_in, DM, NIN, (bf16*)(ws + WS_WINT), scr, it, lane);
        else p0_transpose_item(w_out, MIXW, DM, (bf16*)(ws + WS_WOUTT), scr, it - I_IN, lane);
    }
    {
        const f32x4* gr = (const f32x4*)g_pre + lane; f32x4 gg[4];
#pragma unroll
        for (int j = 0; j < 4; ++j) gg[j] = gr[64 * j];
        bf16* XN = (bf16*)(ws + WS_XN);
        for (int m = gw; m < MTOK; m += NGW) {
            const f32x4* xr = (const f32x4*)(x + (size_t)m * DM) + lane; f32x4 v[4]; float s = 0.f;
#pragma unroll
            for (int j = 0; j < 4; ++j) { v[j] = xr[64 * j]; s += (v[j].x * v[j].x + v[j].y * v[j].y) + (v[j].z * v[j].z + v[j].w * v[j].w); }
            const float rstd = 1.0f / sqrtf(wave_sum(s) * (1.0f / DM) + RMS_EPS);
            u32x2* o8 = (u32x2*)(XN + (size_t)m * DM) + lane;
#pragma unroll
            for (int j = 0; j < 4; ++j) { u32x2 o; o.x = pk2(v[j].x * rstd * gg[j].x, v[j].y * rstd * gg[j].y); o.y = pk2(v[j].z * rstd * gg[j].z, v[j].w * rstd * gg[j].w); o8[64 * j] = o; }
        }
    }
    const int gt = bid * NTHR + tid, NGT = G * NTHR;
    float* biasd = (float*)(ws + WS_BIASD);
    for (int idx = gt; idx < NH * 2048; idx += NGT) { const int h = idx >> 11, d = idx & 2047; biasd[idx] = rel_bias[t5_bucket(d) * NH + h] * LOG2E; }
    if (gt < NH) { float m = -1e30f; for (int b = 0; b < 32; ++b) m = fmaxf(m, rel_bias[b * NH + gt] * LOG2E); ((float*)(ws + WS_KMAX + 4096))[gt] = m; }
    float* weff = (float*)(ws + WS_WEFF);
    for (int idx = gt; idx < 2 * 1024 * 8; idx += NGT) {
        const int which = idx >> 13, c = (idx >> 3) & 1023, g = idx & 7, n = c >> 2, i = c & 3; float s = 0.f;
        if (which == 0) { for (int o = 0; o < 4; ++o) s += wq[n * 16 + i * 4 + o] * w_if[(4 * n + o) * 8 + g] + wk[n * 16 + i * 4 + o] * w_if[(1024 + 4 * n + o) * 8 + g]; }
        else { for (int o = 0; o < 4; ++o) s += wv[n * 16 + i * 4 + o] * w_if[(2048 + 4 * n + o) * 8 + g]; }
        weff[idx] = s;
    }
}

DI void phase_kstat(const Args& a, LAS unsigned char* lds, int tid, int lane, int wave, int bid, int G) {
    const bf16* QK = (const bf16*)(a.ws + WS_QK); float* KMEAN = (float*)(a.ws + WS_KMEAN); float* KMAX = (float*)(a.ws + WS_KMAX);
    LAS float* red = (LAS float*)lds; LAS float* wmx = (LAS float*)(lds + 32 * 128 * 4);
    for (int u = bid; u < 32 * NBLK; u += G) {
        const int bh = u >> 5, blk = u & 31, b = bh >> 3, h = bh & 7;
        const bf16* Kb = QK + (size_t)(b * SEQ + blk * 256) * 2048 + 1024 + h * DH;
        const int rg = tid >> 4, ch = tid & 15;
        float cs[8]; float mx = 0.f;
#pragma unroll
        for (int e = 0; e < 8; ++e) cs[e] = 0.f;
#pragma unroll
        for (int rr = 0; rr < 8; ++rr) {
            const u32x4 v = *(const u32x4*)(Kb + (size_t)(rg * 8 + rr) * 2048 + ch * 8);
            const float f0 = bflo(v.x), f1 = bfhi(v.x), f2 = bflo(v.y), f3 = bfhi(v.y), f4 = bflo(v.z), f5 = bfhi(v.z), f6 = bflo(v.w), f7 = bfhi(v.w);
            cs[0] += f0; cs[1] += f1; cs[2] += f2; cs[3] += f3; cs[4] += f4; cs[5] += f5; cs[6] += f6; cs[7] += f7;
            float ss = (f0 * f0 + f1 * f1) + (f2 * f2 + f3 * f3) + (f4 * f4 + f5 * f5) + (f6 * f6 + f7 * f7);
            ss += __shfl_xor(ss, 1); ss += __shfl_xor(ss, 2); ss += __shfl_xor(ss, 4); ss += __shfl_xor(ss, 8);
            mx = fmaxf(mx, ss);
        }
#pragma unroll
        for (int e = 0; e < 8; ++e) red[rg * 128 + ch * 8 + e] = cs[e];
        mx = wave_max(mx); if (lane == 0) wmx[wave] = mx;
        __syncthreads();
        if (tid < 128) { float s = 0.f; for (int r = 0; r < 32; ++r) s += red[r * 128 + tid]; KMEAN[(size_t)(bh * 32 + blk) * 128 + tid] = s * (1.0f / 256.0f); }
        if (tid == 0) { float m = wmx[0]; for (int w = 1; w < 8; ++w) m = fmaxf(m, wmx[w]); KMAX[bh * 32 + blk] = m; }
        __syncthreads();
    }
}

DI void phase_sel(const Args& a, LAS unsigned char* lds, int tid, int lane, int wave, int bid, int G) {
    const bf16* QK = (const bf16*)(a.ws + WS_QK); const float* KMEAN = (const float*)(a.ws + WS_KMEAN); const float* KMAX = (const float*)(a.ws + WS_KMAX);
    const float* BMAX = (const float*)(a.ws + WS_KMAX + 4096);
    i32x4* SEL = (i32x4*)(a.ws + WS_SEL); unsigned* cnt = (unsigned*)(a.ws + WS_CTL) + CW_CNT; unsigned* LIST = (unsigned*)(a.ws + WS_LIST);
    LAS float* km = (LAS float*)lds; LAS float* misc = (LAS float*)(lds + 32 * 128 * 4);
    for (int u = bid; u < 32 * NBLK; u += G) {
        const int bh = u >> 5, i = u & 31, b = bh >> 3, h = bh & 7;
        for (int idx = tid; idx < i * 128; idx += NTHR) km[idx] = KMEAN[(size_t)bh * 32 * 128 + idx];
        if (tid < 64) { float v = tid < 32 ? KMAX[bh * 32 + tid] : 0.f; v = wave_max(v); if (tid == 0) misc[0] = sqrtf(v); }
        __syncthreads();
        const float kmaxn = misc[0];
        const int q = tid >> 1, half = tid & 1; const int row = b * SEQ + i * 256 + q;
        const bf16* qp = QK + (size_t)row * 2048 + h * DH + half * 64;
        float qv[64];
#pragma unroll
        for (int c = 0; c < 8; ++c) { const u32x4 v = *(const u32x4*)(qp + c * 8);
            qv[c * 8 + 0] = bflo(v.x); qv[c * 8 + 1] = bfhi(v.x); qv[c * 8 + 2] = bflo(v.y); qv[c * 8 + 3] = bfhi(v.y);
            qv[c * 8 + 4] = bflo(v.z); qv[c * 8 + 5] = bfhi(v.z); qv[c * 8 + 6] = bflo(v.w); qv[c * 8 + 7] = bfhi(v.w); }
        float qn2 = 0.f;
#pragma unroll
        for (int d = 0; d < 64; ++d) qn2 += qv[d] * qv[d];
        qn2 += __shfl_xor(qn2, 1);
        float v0 = -INFINITY, v1 = -INFINITY, v2 = -INFINITY; int i0 = -1, i1 = -1, i2 = -1;
        for (int j = 0; j < i; ++j) {
            const LAS float* kr = km + j * 128 + half * 64; float dot = 0.f;
#pragma unroll
            for (int d = 0; d < 64; d += 4) { const f32x4 kk = *(const LAS f32x4*)(kr + d); dot += qv[d] * kk.x + qv[d + 1] * kk.y + qv[d + 2] * kk.z + qv[d + 3] * kk.w; }
            dot += __shfl_xor(dot, 1);
            if (dot > v0) { v2 = v1; i2 = i1; v1 = v0; i1 = i0; v0 = dot; i0 = j; }
            else if (dot > v1) { v2 = v1; i2 = i1; v1 = dot; i1 = j; }
            else if (dot > v2) { v2 = dot; i2 = j; }
        }
        const float shift = sqrtf(qn2) * kmaxn + BMAX[h];
        LAS int* lcnt = (LAS int*)(lds + 32 * 128 * 4 + 256);
        if (tid < 32) lcnt[tid] = 0;
        __syncthreads();
        int p0 = 0, p1 = 0, p2 = 0;
        if (half == 0) {
            i32x4 s4; s4.x = i0; s4.y = i1; s4.z = i2; s4.w = __float_as_int(shift);
            SEL[(size_t)row * 8 + h] = s4;
            if (i0 >= 0) p0 = __hip_atomic_fetch_add(lcnt + i0, 1, __ATOMIC_RELAXED, __HIP_MEMORY_SCOPE_WORKGROUP);
            if (i1 >= 0) p1 = __hip_atomic_fetch_add(lcnt + i1, 1, __ATOMIC_RELAXED, __HIP_MEMORY_SCOPE_WORKGROUP);
            if (i2 >= 0) p2 = __hip_atomic_fetch_add(lcnt + i2, 1, __ATOMIC_RELAXED, __HIP_MEMORY_SCOPE_WORKGROUP);
        }
        __syncthreads();
        if (tid < i) { const int c = lcnt[tid]; int base = 0; if (c > 0) base = (int)atomicAdd(&cnt[bh * 32 + tid], (unsigned)c); lcnt[tid] = base; }
        __syncthreads();
        if (half == 0) {
            const unsigned qpos = (unsigned)(i * 256 + q);
            if (i0 >= 0) LIST[(size_t)bh * LISTSZ + list_off(i0) + lcnt[i0] + p0] = qpos | (0u << 16);
            if (i1 >= 0) LIST[(size_t)bh * LISTSZ + list_off(i1) + lcnt[i1] + p1] = qpos | (1u << 16);
            if (i2 >= 0) LIST[(size_t)bh * LISTSZ + list_off(i2) + lcnt[i2] + p2] = qpos | (2u << 16);
        }
        __syncthreads();
    }
}

constexpr int ATT_KIMG = 0, ATT_KROW = 272, ATT_VT = 69632, ATT_VROW = 520, ATT_BIASD = 136192, ATT_PREF = 144384, ATT_LST = 148480, ATT_MISC = 149504;
DI void att_fill_kv(LAS unsigned char* lds, const bf16* Kg, const bf16* Vg, int tid, int lane, int wave) {
#pragma unroll
    for (int it = 0; it < 8; ++it) { const int p = it * NTHR + tid, key = p >> 4, ch = p & 15;
        const u32x4 v = *(const u32x4*)(Kg + (size_t)key * 2048 + ch * 8); *(LAS u32x4*)(lds + ATT_KIMG + key * ATT_KROW + ch * 16) = v; }
#pragma unroll
    for (int dcw = 0; dcw < 2; ++dcw) { const int dc = wave + 8 * dcw;
#pragma unroll
        for (int kp = 0; kp < 4; ++kp) { const int key = kp * 64 + lane;
            const u32x4 v = *(const u32x4*)(Vg + (size_t)key * 1024 + dc * 8);
            LAS unsigned short* dst = (LAS unsigned short*)(lds + ATT_VT + (dc * 8) * ATT_VROW + key * 2);
            dst[0 * (ATT_VROW / 2)] = (unsigned short)(v.x & 0xffffu); dst[1 * (ATT_VROW / 2)] = (unsigned short)(v.x >> 16);
            dst[2 * (ATT_VROW / 2)] = (unsigned short)(v.y & 0xffffu); dst[3 * (ATT_VROW / 2)] = (unsigned short)(v.y >> 16);
            dst[4 * (ATT_VROW / 2)] = (unsigned short)(v.z & 0xffffu); dst[5 * (ATT_VROW / 2)] = (unsigned short)(v.z >> 16);
            dst[6 * (ATT_VROW / 2)] = (unsigned short)(v.w & 0xffffu); dst[7 * (ATT_VROW / 2)] = (unsigned short)(v.w >> 16); } }
}
template <bool OWN>
DI void att_tile(LAS unsigned char* lds, const bf16x8 (&qf)[8], int qpos, float shift, int kbase, int kt_end, int wdiag, bool far, float b31,
                 f32x16 (&o)[4], float& lsum, int r, int hf) {
    const LAS float* biasd = (const LAS float*)(lds + ATT_BIASD);
    for (int kt = 0; kt < kt_end; ++kt) {
        f32x16 x;
#pragma unroll
        for (int i = 0; i < 16; ++i) x[i] = 0.f;
#pragma unroll
        for (int ks = 0; ks < 8; ++ks) { const bf16x8 kf = *(const LAS bf16x8*)(lds + ATT_KIMG + (32 * kt + r) * ATT_KROW + ks * 32 + hf * 16); x = MFMA32(kf, qf[ks], x); }
        if (far) {
#pragma unroll
            for (int i = 0; i < 16; ++i) { const float p = __builtin_amdgcn_exp2f(x[i] + (b31 - shift)); lsum += p; x[i] = p; }
        } else {
#pragma unroll
            for (int i = 0; i < 16; ++i) { const int key = 32 * kt + crow(i, hf); int dist = qpos - (kbase + key); dist = dist < 0 ? 0 : (dist > 2047 ? 2047 : dist);
                float p = __builtin_amdgcn_exp2f(x[i] + biasd[dist] - shift);
                if (OWN) { if (kt == wdiag && crow(i, hf) > r) p = 0.f; }
                lsum += p; x[i] = p; }
        }
        const bf16x8 pa0 = pack_lo(x), pa1 = pack_hi(x);
#pragma unroll
        for (int dt = 0; dt < 4; ++dt) {
            const LAS unsigned char* vb = lds + ATT_VT + (32 * dt + r) * ATT_VROW + 2 * (32 * kt + 4 * hf);
            const s16x4 l0 = *(const LAS s16x4*)(vb), h0 = *(const LAS s16x4*)(vb + 16), l1 = *(const LAS s16x4*)(vb + 32), h1 = *(const LAS s16x4*)(vb + 48);
            const bf16x8 vf0 = __builtin_shufflevector(l0, h0, 0, 1, 2, 3, 4, 5, 6, 7), vf1 = __builtin_shufflevector(l1, h1, 0, 1, 2, 3, 4, 5, 6, 7);
            o[dt] = MFMA32(pa0, vf0, o[dt]); o[dt] = MFMA32(pa1, vf1, o[dt]);
        }
    }
}
DI void att_load_biasd(const Args& a, LAS unsigned char* lds, int h, int tid) {
    const float* biasd = (const float*)(a.ws + WS_BIASD) + h * 2048; LAS float* dst = (LAS float*)(lds + ATT_BIASD);
    for (int i = tid; i < 2048; i += NTHR) dst[i] = biasd[i];
}
DI bf16* opart_base(const Args& a, int slot) { return slot == 0 ? (bf16*)a.out : (slot == 1 ? (bf16*)((unsigned char*)a.out + 64 * MiB) : (bf16*)(a.ws + WS_XN)); }

DI void phase_att_gather(const Args& a, LAS unsigned char* lds, int tid, int lane, int wave, int bid, int G) {
    const bf16* QK = (const bf16*)(a.ws + WS_QK); const bf16* Vb = (const bf16*)(a.ws + WS_V);
    const i32x4* SEL = (const i32x4*)(a.ws + WS_SEL); const unsigned* cnt = (const unsigned*)(a.ws + WS_CTL) + CW_CNT; const unsigned* LIST = (const unsigned*)(a.ws + WS_LIST);
    float* LPART = (float*)(a.ws + WS_LPART);
    LAS int* pref = (LAS int*)(lds + ATT_PREF);
    if (tid < 64) {
        int nu[16]; int s = 0;
#pragma unroll
        for (int k = 0; k < 16; ++k) { const int l = tid * 16 + k; int n = 0; if (l < 992) { const int bh = l / 31, j = l % 31; n = (int)((cnt[bh * 32 + j] + 255u) >> 8); } nu[k] = n; s += n; }
        int incl = s;
#pragma unroll
        for (int o = 1; o < 64; o <<= 1) { const int t = __shfl_up(incl, o); if (lane >= o) incl += t; }
        int run = incl - s;
#pragma unroll
        for (int k = 0; k < 16; ++k) { const int l = tid * 16 + k; if (l <= 992) pref[l] = run; run += nu[k]; }
    }
    __syncthreads();
    const int U = pref[992];
    const int r = lane & 31, hf = lane >> 5;
    int cur_h = -1;
    for (int u = bid; u < U; u += G) {
        int lo = 0, hi = 992;
        while (hi - lo > 1) { const int mid = (lo + hi) >> 1; if (pref[mid] <= u) lo = mid; else hi = mid; }
        const int l = lo, bh = l / 31, j = l % 31, chunk = u - pref[l], b = bh >> 3, h = bh & 7;
        const int n = (int)cnt[bh * 32 + j]; const int nrows = min(256, n - chunk * 256);
        if (h != cur_h) { att_load_biasd(a, lds, h, tid); cur_h = h; }
        att_fill_kv(lds, QK + (size_t)(b * SEQ + j * 256) * 2048 + 1024 + h * DH, Vb + (size_t)(b * SEQ + j * 256) * 1024 + h * DH, tid, lane, wave);
        __syncthreads();
        const int nv = min(32, max(0, nrows - 32 * wave));
        const unsigned* lp = LIST + (size_t)bh * LISTSZ + list_off(j) + chunk * 256 + 32 * wave;
        unsigned ent = 0; f32x16 o[4]; float lsum = 0.f;
#pragma unroll
        for (int dt = 0; dt < 4; ++dt)
#pragma unroll
            for (int i = 0; i < 16; ++i) o[dt][i] = 0.f;
        if (nv > 0) {
            ent = lp[r < nv ? r : 0];
            const int qpos = (int)(ent & 0xffffu); const size_t row = (size_t)b * SEQ + qpos;
            const float shift = __int_as_float(SEL[row * 8 + h].w);
            bf16x8 qf[8];
#pragma unroll
            for (int ks = 0; ks < 8; ++ks) qf[ks] = *(const bf16x8*)(QK + row * 2048 + h * DH + ks * 16 + hf * 8);
            const bool far = __all(qpos - (j * 256 + 255) >= 1513);
            const float b31 = *(const LAS float*)(lds + ATT_BIASD + 2047 * 4);
            att_tile<false>(lds, qf, qpos, shift, j * 256, 8, -1, far, b31, o, lsum, r, hf);
            lsum += __shfl_xor(lsum, 32);
        }
        __syncthreads();
        if (nv > 0) {
            LAS unsigned char* stg = lds + wave * 8192;
#pragma unroll
            for (int dt = 0; dt < 4; ++dt)
#pragma unroll
                for (int i = 0; i < 16; ++i) *(LAS unsigned short*)(stg + crow(i, hf) * 256 + (32 * dt + r) * 2) = (unsigned short)f2bf(o[dt][i]);
#pragma unroll
            for (int it = 0; it < 8; ++it) { const int item = it * 64 + lane, rho = item >> 4, ch = item & 15;
                const unsigned e2 = (unsigned)__shfl((int)ent, rho); const int q2 = (int)(e2 & 0xffffu), slot2 = (int)(e2 >> 16);
                const u32x4 v = *(const LAS u32x4*)(stg + rho * 256 + ch * 16);
                if (rho < nv) *(u32x4*)(opart_base(a, slot2) + (((size_t)b * SEQ + q2) * 8 + h) * 128 + ch * 8) = v; }
            if (hf == 0 && r < nv) { const int q1 = (int)(ent & 0xffffu), slot1 = (int)(ent >> 16); LPART[(size_t)slot1 * MTOK * 8 + ((size_t)b * SEQ + q1) * 8 + h] = lsum; }
        }
        __syncthreads();
    }
}

DI void phase_att_own(const Args& a, LAS unsigned char* lds, int tid, int lane, int wave, int bid, int G) {
    bf16* QK = (bf16*)(a.ws + WS_QK); const bf16* Vb = (const bf16*)(a.ws + WS_V); const bf16* Gb = (const bf16*)(a.ws + WS_G);
    const i32x4* SEL = (const i32x4*)(a.ws + WS_SEL); const float* LPART = (const float*)(a.ws + WS_LPART);
    const int r = lane & 31, hf = lane >> 5;
    int cur_h = -1;
    for (int u = bid; u < 32 * NBLK; u += G) {
        const int bh = u >> 5, i = u & 31, b = bh >> 3, h = bh & 7;
        if (h != cur_h) { att_load_biasd(a, lds, h, tid); cur_h = h; }
        att_fill_kv(lds, QK + (size_t)(b * SEQ + i * 256) * 2048 + 1024 + h * DH, Vb + (size_t)(b * SEQ + i * 256) * 1024 + h * DH, tid, lane, wave);
        __syncthreads();
        const int qpos = i * 256 + 32 * wave + r; const size_t row = (size_t)b * SEQ + qpos;
        const float shift = __int_as_float(SEL[row * 8 + h].w);
        bf16x8 qf[8];
#pragma unroll
        for (int ks = 0; ks < 8; ++ks) qf[ks] = *(const bf16x8*)(QK + row * 2048 + h * DH + ks * 16 + hf * 8);
        f32x16 o[4]; float lsum = 0.f;
#pragma unroll
        for (int dt = 0; dt < 4; ++dt)
#pragma unroll
            for (int k = 0; k < 16; ++k) o[dt][k] = 0.f;
        att_tile<true>(lds, qf, qpos, shift, i * 256, wave + 1, wave, false, 0.f, o, lsum, r, hf);
        lsum += __shfl_xor(lsum, 32);
        __syncthreads();
        LAS unsigned char* stg = lds + wave * 16384;
        LAS float* lst = (LAS float*)(lds + ATT_LST) + wave * 32;
#pragma unroll
        for (int dt = 0; dt < 4; ++dt)
#pragma unroll
            for (int k = 0; k < 16; ++k) *(LAS float*)(stg + crow(k, hf) * 512 + (32 * dt + r) * 4) = o[dt][k];
        if (hf == 0) lst[r] = lsum;
#pragma unroll
        for (int it = 0; it < 8; ++it) { const int item = it * 64 + lane, rho = item >> 4, ch = item & 15;
            const size_t row2 = (size_t)b * SEQ + i * 256 + 32 * wave + rho;
            const f32x4 a0 = *(const LAS f32x4*)(stg + rho * 512 + ch * 32), a1 = *(const LAS f32x4*)(stg + rho * 512 + ch * 32 + 16);
            float acc[8] = {a0.x, a0.y, a0.z, a0.w, a1.x, a1.y, a1.z, a1.w};
            float l = lst[rho];
            const i32x4 s4 = SEL[row2 * 8 + h];
#pragma unroll
            for (int k = 0; k < 3; ++k) { const int sk = (k == 0) ? s4.x : (k == 1 ? s4.y : s4.z);
                if (sk >= 0) { const u32x4 pv = *(const u32x4*)(opart_base(a, k) + (row2 * 8 + h) * 128 + ch * 8);
                    acc[0] += bflo(pv.x); acc[1] += bfhi(pv.x); acc[2] += bflo(pv.y); acc[3] += bfhi(pv.y); acc[4] += bflo(pv.z); acc[5] += bfhi(pv.z); acc[6] += bflo(pv.w); acc[7] += bfhi(pv.w);
                    l += LPART[(size_t)k * MTOK * 8 + row2 * 8 + h]; } }
            const u32x4 gv = *(const u32x4*)(Gb + row2 * 1024 + h * DH + ch * 8);
            const float rl = 1.0f / l;
            u32x4 ov; ov.x = pk2(acc[0] * rl * silu_f(bflo(gv.x)), acc[1] * rl * silu_f(bfhi(gv.x))); ov.y = pk2(acc[2] * rl * silu_f(bflo(gv.y)), acc[3] * rl * silu_f(bfhi(gv.y)));
            ov.z = pk2(acc[4] * rl * silu_f(bflo(gv.z)), acc[5] * rl * silu_f(bfhi(gv.z))); ov.w = pk2(acc[6] * rl * silu_f(bflo(gv.w)), acc[7] * rl * silu_f(bfhi(gv.w)));
            *(u32x4*)(QK + row2 * 2048 + h * DH + ch * 8) = ov; }
        __syncthreads();
    }
}

DI void phase_mpre(const Args& a, LAS unsigned char* lds, int tid, int lane, int wave, int bid, int G) {
    const float* conv_w = a.in[5]; const float* conv_b = a.in[6]; const float* wq = a.in[7]; const float* wk = a.in[8]; const float* wv = a.in[9]; const float* b_if = a.in[11];
    const float* weff = (const float*)(a.ws + WS_WEFF);
    const bf16* XM = (const bf16*)(a.ws + WS_XM);
    bf16* QM = (bf16*)a.out; bf16* KM = (bf16*)((unsigned char*)a.out + 64 * MiB); bf16* VM = (bf16*)(a.ws + WS_XN); bf16* XC = (bf16*)(a.ws + WS_G);
    float* GLI = (float*)(a.ws + WS_GLI); float* GLF = (float*)(a.ws + WS_GLF);
    LAS float* red = (LAS float*)lds;
    const int tk = tid >> 8, n = tid & 255;
    float cw[4][4], cb[4], fq[16], fk[16], fv[16], wc[4][8], wm[4][8];
#pragma unroll
    for (int w = 0; w < 4; ++w) { const f32x4 t = *(const f32x4*)(conv_w + w * 1024 + 4 * n); cw[w][0] = t.x; cw[w][1] = t.y; cw[w][2] = t.z; cw[w][3] = t.w; }
    { const f32x4 t = *(const f32x4*)(conv_b + 4 * n); cb[0] = t.x; cb[1] = t.y; cb[2] = t.z; cb[3] = t.w; }
#pragma unroll
    for (int k = 0; k < 16; ++k) { fq[k] = wq[n * 16 + k]; fk[k] = wk[n * 16 + k] * 0.0625f; fv[k] = wv[n * 16 + k]; }
#pragma unroll
    for (int i = 0; i < 4; ++i)
#pragma unroll
        for (int g = 0; g < 8; ++g) { wc[i][g] = weff[(4 * n + i) * 8 + g]; wm[i][g] = weff[8192 + (4 * n + i) * 8 + g]; }
    for (int tp = bid; tp < MTOK / 2; tp += G) {
        const int m = 2 * tp + tk, s = m & (SEQ - 1);
        float xw[4][4];
#pragma unroll
        for (int w = 0; w < 4; ++w) {
            u32x2 v; v.x = 0u; v.y = 0u;
            if (s - 3 + w >= 0) v = *(const u32x2*)(XM + (size_t)(m - 3 + w) * 1024 + 4 * n);
            xw[w][0] = bflo(v.x); xw[w][1] = bfhi(v.x); xw[w][2] = bflo(v.y); xw[w][3] = bfhi(v.y);
        }
        float xc[4];
#pragma unroll
        for (int c = 0; c < 4; ++c) { float y = cb[c];
#pragma unroll
            for (int w = 0; w < 4; ++w) y += xw[w][c] * cw[w][c];
            xc[c] = silu_f(y); }
        float qo[4], ko[4], vo[4];
#pragma unroll
        for (int o = 0; o < 4; ++o) { float sq = 0.f, sk = 0.f, sv = 0.f;
#pragma unroll
            for (int i = 0; i < 4; ++i) { sq += xc[i] * fq[i * 4 + o]; sk += xc[i] * fk[i * 4 + o]; sv += xw[3][i] * fv[i * 4 + o]; }
            qo[o] = sq; ko[o] = sk; vo[o] = sv; }
        float gp[8];
#pragma unroll
        for (int g = 0; g < 8; ++g) { float sg = 0.f;
#pragma unroll
            for (int i = 0; i < 4; ++i) sg += xc[i] * wc[i][g] + xw[3][i] * wm[i][g];
            gp[g] = sg; }
        const size_t off = (size_t)m * 1024 + 4 * n;
        { u32x2 o; o.x = pk2(qo[0], qo[1]); o.y = pk2(qo[2], qo[3]); *(u32x2*)(QM + off) = o; }
        { u32x2 o; o.x = pk2(ko[0], ko[1]); o.y = pk2(ko[2], ko[3]); *(u32x2*)(KM + off) = o; }
        { u32x2 o; o.x = pk2(vo[0], vo[1]); o.y = pk2(vo[2], vo[3]); *(u32x2*)(VM + off) = o; }
        { u32x2 o; o.x = pk2(xc[0], xc[1]); o.y = pk2(xc[2], xc[3]); *(u32x2*)(XC + off) = o; }
#pragma unroll
        for (int g = 0; g < 8; ++g) gp[g] = wave_sum(gp[g]);
        if (lane == 0) {
#pragma unroll
            for (int g = 0; g < 8; ++g) red[(tk * 4 + (wave & 3)) * 8 + g] = gp[g]; }
        __syncthreads();
        if (tid < 16) { const int t2 = tid >> 3, g = tid & 7; const int m2 = 2 * tp + t2, s2 = m2 & (SEQ - 1), b2 = m2 >> 13;
            const float gate = red[(t2 * 4 + 0) * 8 + g] + red[(t2 * 4 + 1) * 8 + g] + red[(t2 * 4 + 2) * 8 + g] + red[(t2 * 4 + 3) * 8 + g] + b_if[g];
            if (g < 4) GLI[(size_t)(b2 * 4 + g) * SEQ + s2] = gate;
            else GLF[(size_t)(b2 * 4 + g - 4) * SEQ + s2] = fminf(gate, 0.f) - log1pf(__expf(-fabsf(gate))); }
        __syncthreads();
    }
}

constexpr int MC_QI = 0, MC_QROW = 528, MC_KI = 33792, MC_KT = 67584, MC_TROW = 144, MC_VT = 104448, MC_P = 141312, MC_SC = 150528, MC_NV = 153600, MC_MISC = 154624;
constexpr int MC_STROW = 1040;
DI LAS float* mc_sc(LAS unsigned char* lds, int k) { return (LAS float*)(lds + MC_SC + k * 256); }

DI void phase_mstate(const Args& a, LAS unsigned char* lds, int tid, int lane0, int wave, int bid, int G) {
    const bf16* KM = (const bf16*)((unsigned char*)a.out + 64 * MiB); const bf16* VM = (const bf16*)(a.ws + WS_XN);
    const float* GLI = (const float*)(a.ws + WS_GLI); const float* GLF = (const float*)(a.ws + WS_GLF);
    float* CST = (float*)(a.ws + WS_CST); float* NST = (float*)(a.ws + WS_NST); float* PST = (float*)(a.ws + WS_PST); float* MIN = (float*)(a.ws + WS_MIN);
    LAS float* nvec = (LAS float*)(lds + MC_NV); LAS float* misc = (LAS float*)(lds + MC_MISC);
    LAS float* aggb = (LAS float*)(lds + MC_QI); LAS float* agga = aggb + 128; LAS float* marr = aggb + 256;
#define OPQ(name) int name = tid; asm volatile("" : "+v"(name))
    for (int u = bid; u < BATCH * MH * NSC; u += G) {
        const int bh = u >> 4, sc = u & 15, b = bh >> 2, hd = bh & 3; const int c0 = sc * SCCH, c1 = c0 + SCCH;
        { OPQ(tA); const int laneA = tA & 63;
            for (int c = wave; c < c1; c += NWAVES) {
                const float lf = GLF[(size_t)bh * SEQ + c * LCH + laneA], li = GLI[(size_t)bh * SEQ + c * LCH + laneA];
                float bc = lf;
#pragma unroll
                for (int o = 1; o < 64; o <<= 1) { const float t = __shfl_up(bc, o); if (laneA >= o) bc += t; }
                const float am = wave_max(li - bc); const float bL = __shfl(bc, 63);
                if (laneA == 0) { aggb[c] = bL; agga[c] = am; }
            }
        }
        __syncthreads();
        if (tid == 0) { float m = 0.f; for (int c = 0; c < c1; ++c) { marr[c] = m; m = aggb[c] + fmaxf(m, agga[c]); } }
        __syncthreads();
        if (tid < SCCH) MIN[bh * NCH + c0 + tid] = marr[c0 + tid];
        f32x16 C[8];
#pragma unroll
        for (int dt = 0; dt < 8; ++dt)
#pragma unroll
            for (int i = 0; i < 16; ++i) C[dt][i] = 0.f;
        if (tid < 256) nvec[tid] = 0.f;
        float pprod = 1.f;
        for (int c = c0; c < c1; ++c) {
            const size_t rowbase = (size_t)b * SEQ + (size_t)c * LCH;
            { OPQ(tB); const int laneB = tB & 63;
#pragma unroll
            for (int cc = 0; cc < 4; ++cc) { const int c8 = wave + 8 * cc;
                const u32x4 vk = *(const u32x4*)(KM + (rowbase + laneB) * 1024 + hd * MD + c8 * 8); const u32x4 vv = *(const u32x4*)(VM + (rowbase + laneB) * 1024 + hd * MD + c8 * 8);
                LAS unsigned short* dk = (LAS unsigned short*)(lds + MC_KT + (c8 * 8) * MC_TROW + laneB * 2); LAS unsigned short* dv = (LAS unsigned short*)(lds + MC_VT + (c8 * 8) * MC_TROW + laneB * 2);
                dk[0 * 72] = (unsigned short)(vk.x & 0xffffu); dk[1 * 72] = (unsigned short)(vk.x >> 16); dk[2 * 72] = (unsigned short)(vk.y & 0xffffu); dk[3 * 72] = (unsigned short)(vk.y >> 16);
                dk[4 * 72] = (unsigned short)(vk.z & 0xffffu); dk[5 * 72] = (unsigned short)(vk.z >> 16); dk[6 * 72] = (unsigned short)(vk.w & 0xffffu); dk[7 * 72] = (unsigned short)(vk.w >> 16);
                dv[0 * 72] = (unsigned short)(vv.x & 0xffffu); dv[1 * 72] = (unsigned short)(vv.x >> 16); dv[2 * 72] = (unsigned short)(vv.y & 0xffffu); dv[3 * 72] = (unsigned short)(vv.y >> 16);
                dv[4 * 72] = (unsigned short)(vv.z & 0xffffu); dv[5 * 72] = (unsigned short)(vv.z >> 16); dv[6 * 72] = (unsigned short)(vv.w & 0xffffu); dv[7 * 72] = (unsigned short)(vv.w >> 16); }
            if (wave == 0) {
                const float lf = GLF[(size_t)bh * SEQ + c * LCH + laneB], li = GLI[(size_t)bh * SEQ + c * LCH + laneB];
                float bc = lf;
#pragma unroll
                for (int o = 1; o < 64; o <<= 1) { const float t = __shfl_up(bc, o); if (laneB >= o) bc += t; }
                const float av = li - bc; const float mi = marr[c]; const float Gc = fmaxf(mi, wave_max(av));
                mc_sc(lds, 3)[laneB] = __expf(av - Gc);
                if (laneB == 0) misc[0] = __expf(mi - Gc);
            } }
            __syncthreads();
            const float cd = misc[0]; pprod *= cd;
            { OPQ(tC); const int laneC = tC & 63, r = laneC & 31, hf = laneC >> 5;
            bf16x8 vt[4];
            const LAS unsigned char* vbase = lds + MC_VT + (32 * wave + r) * MC_TROW + hf * 16;
#pragma unroll
            for (int ks = 0; ks < 4; ++ks) { vt[ks] = *(const LAS bf16x8*)(vbase + ks * 32);
                const f32x4 w0 = *(const LAS f32x4*)(mc_sc(lds, 3) + 16 * ks + 8 * hf), w1 = *(const LAS f32x4*)(mc_sc(lds, 3) + 16 * ks + 8 * hf + 4);
                const u32x4 vv = __builtin_bit_cast(u32x4, vt[ks]); u32x4 o;
                o.x = pk2(bflo(vv.x) * w0.x, bfhi(vv.x) * w0.y); o.y = pk2(bflo(vv.y) * w0.z, bfhi(vv.y) * w0.w); o.z = pk2(bflo(vv.z) * w1.x, bfhi(vv.z) * w1.y); o.w = pk2(bflo(vv.w) * w1.z, bfhi(vv.w) * w1.w);
                vt[ks] = __builtin_bit_cast(bf16x8, o); }
            const LAS unsigned char* kbase = lds + MC_KT + r * MC_TROW + hf * 16;
#pragma unroll
            for (int dt = 0; dt < 8; ++dt) {
#pragma unroll
                for (int i = 0; i < 16; ++i) C[dt][i] *= cd;
#pragma unroll
                for (int ks = 0; ks < 4; ++ks) { const bf16x8 kA = *(const LAS bf16x8*)(kbase + dt * 32 * MC_TROW + ks * 32); C[dt] = MFMA32(kA, vt[ks], C[dt]); } }
            if (tC < 256) { float sacc = cd * nvec[tC];
#pragma unroll
                for (int k = 0; k < 8; ++k) { const u32x4 kv = *(const LAS u32x4*)(lds + MC_KT + tC * MC_TROW + k * 16);
                    const f32x4 w0 = *(const LAS f32x4*)(mc_sc(lds, 3) + k * 8), w1 = *(const LAS f32x4*)(mc_sc(lds, 3) + k * 8 + 4);
                    sacc += bflo(kv.x) * w0.x + bfhi(kv.x) * w0.y + bflo(kv.y) * w0.z + bfhi(kv.y) * w0.w + bflo(kv.z) * w1.x + bfhi(kv.z) * w1.y + bflo(kv.w) * w1.z + bfhi(kv.w) * w1.w; }
                nvec[tC] = sacc; }
            }
            __syncthreads();
        }
        { OPQ(tD); const int laneD = tD & 63, r = laneD & 31, hf = laneD >> 5;
            float* cs = CST + (size_t)u * 65536 + 32 * wave + r;
#pragma unroll
            for (int dt = 0; dt < 8; ++dt)
#pragma unroll
                for (int i = 0; i < 16; ++i) cs[(32 * dt + crow(i, hf)) * 256] = C[dt][i];
            if (tD < 256) NST[u * 256 + tD] = nvec[tD];
            if (tD == 0) PST[u] = pprod;
        }
        __syncthreads();
    }
#undef OPQ
}
DI void phase_mcomb(const Args& a, int tid, int bid, int G) {
    float* CST = (float*)(a.ws + WS_CST); float* NST = (float*)(a.ws + WS_NST); const float* PST = (const float*)(a.ws + WS_PST);
    const int gt = bid * NTHR + tid, NGT = G * NTHR;
    for (int idx = gt; idx < BATCH * MH * 65536; idx += NGT) { const int bh = idx >> 16, e = idx & 65535; float run = 0.f;
#pragma unroll 4
        for (int sc = 0; sc < NSC; ++sc) { float* p = CST + (size_t)(bh * NSC + sc) * 65536 + e; const float tmp = *p; *p = run; run = PST[bh * NSC + sc] * run + tmp; } }
    for (int idx = gt; idx < BATCH * MH * 256; idx += NGT) { const int bh = idx >> 8, e = idx & 255; float run = 0.f;
        for (int sc = 0; sc < NSC; ++sc) { float* p = NST + (size_t)(bh * NSC + sc) * 256 + e; const float tmp = *p; *p = run; run = PST[bh * NSC + sc] * run + tmp; } }
}
DI void phase_mscan(const Args& a, LAS unsigned char* lds, int tid, int lane0, int wave, int bid, int G) {
    const bf16* QM = (const bf16*)a.out; const bf16* KM = (const bf16*)((unsigned char*)a.out + 64 * MiB); const bf16* VM = (const bf16*)(a.ws + WS_XN); const bf16* XC = (const bf16*)(a.ws + WS_G);
    const bf16* ZM = (const bf16*)(a.ws + WS_ZM); bf16* QK = (bf16*)(a.ws + WS_QK);
    const float* GLI = (const float*)(a.ws + WS_GLI); const float* GLF = (const float*)(a.ws + WS_GLF);
    const float* mh_norm = a.in[12]; const float* skip = a.in[13];
    LAS float* nvec = (LAS float*)(lds + MC_NV); LAS float* misc = (LAS float*)(lds + MC_MISC);
#define OPQ(name) int name = tid; asm volatile("" : "+v"(name))
    const float* CST = (const float*)(a.ws + WS_CST); const float* NST = (const float*)(a.ws + WS_NST); const float* MIN = (const float*)(a.ws + WS_MIN);
    for (int u = bid; u < BATCH * MH * NSC; u += G) {
        const int bh = u >> 4, sc = u & 15, b = bh >> 2, hd = bh & 3;
        f32x16 C[8];
        { OPQ(t0); const int lane_ = t0 & 63, r = lane_ & 31, hf = lane_ >> 5;
            const float* cs = CST + (size_t)u * 65536 + 32 * wave + r;
#pragma unroll
            for (int dt = 0; dt < 8; ++dt)
#pragma unroll
                for (int i = 0; i < 16; ++i) C[dt][i] = cs[(32 * dt + crow(i, hf)) * 256];
            if (t0 < 256) nvec[t0] = NST[u * 256 + t0];
        }
        float mrun = MIN[bh * NCH + sc * SCCH];
        for (int c = sc * SCCH; c < (sc + 1) * SCCH; ++c) {
            const size_t rowbase = (size_t)b * SEQ + (size_t)c * LCH;
            { OPQ(tA); const int laneA = tA & 63;
#pragma unroll
            for (int it = 0; it < 4; ++it) { const int p = it * NTHR + tA, t = p >> 5, ch = p & 31;
                const u32x4 vq = *(const u32x4*)(QM + (rowbase + t) * 1024 + hd * MD + ch * 8); const u32x4 vk = *(const u32x4*)(KM + (rowbase + t) * 1024 + hd * MD + ch * 8);
                *(LAS u32x4*)(lds + MC_QI + t * MC_QROW + ch * 16) = vq; *(LAS u32x4*)(lds + MC_KI + t * MC_QROW + ch * 16) = vk; }
#pragma unroll
            for (int cc = 0; cc < 4; ++cc) { const int c8 = wave + 8 * cc;
                const u32x4 vk = *(const u32x4*)(KM + (rowbase + laneA) * 1024 + hd * MD + c8 * 8); const u32x4 vv = *(const u32x4*)(VM + (rowbase + laneA) * 1024 + hd * MD + c8 * 8);
                LAS unsigned short* dk = (LAS unsigned short*)(lds + MC_KT + (c8 * 8) * MC_TROW + laneA * 2); LAS unsigned short* dv = (LAS unsigned short*)(lds + MC_VT + (c8 * 8) * MC_TROW + laneA * 2);
                dk[0 * 72] = (unsigned short)(vk.x & 0xffffu); dk[1 * 72] = (unsigned short)(vk.x >> 16); dk[2 * 72] = (unsigned short)(vk.y & 0xffffu); dk[3 * 72] = (unsigned short)(vk.y >> 16);
                dk[4 * 72] = (unsigned short)(vk.z & 0xffffu); dk[5 * 72] = (unsigned short)(vk.z >> 16); dk[6 * 72] = (unsigned short)(vk.w & 0xffffu); dk[7 * 72] = (unsigned short)(vk.w >> 16);
                dv[0 * 72] = (unsigned short)(vv.x & 0xffffu); dv[1 * 72] = (unsigned short)(vv.x >> 16); dv[2 * 72] = (unsigned short)(vv.y & 0xffffu); dv[3 * 72] = (unsigned short)(vv.y >> 16);
                dv[4 * 72] = (unsigned short)(vv.z & 0xffffu); dv[5 * 72] = (unsigned short)(vv.z >> 16); dv[6 * 72] = (unsigned short)(vv.w & 0xffffu); dv[7 * 72] = (unsigned short)(vv.w >> 16); }
            if (wave == 0) {
                const float lf = GLF[(size_t)bh * SEQ + c * LCH + laneA], li = GLI[(size_t)bh * SEQ + c * LCH + laneA];
                float bc = lf;
#pragma unroll
                for (int o = 1; o < 64; o <<= 1) { const float t = __shfl_up(bc, o); if (laneA >= o) bc += t; }
                const float av = li - bc; float cm = av;
#pragma unroll
                for (int o = 1; o < 64; o <<= 1) { const float t = __shfl_up(cm, o); if (laneA >= o) cm = fmaxf(cm, t); }
                const float gv = fmaxf(mrun, cm); const float Gc = __shfl(gv, 63), bL = __shfl(bc, 63);
                mc_sc(lds, 0)[laneA] = av; mc_sc(lds, 1)[laneA] = gv; mc_sc(lds, 2)[laneA] = __expf(mrun - gv); mc_sc(lds, 3)[laneA] = __expf(av - Gc); mc_sc(lds, 4)[laneA] = __expf(-(bc + gv));
                if (laneA == 0) misc[0] = __expf(mrun - Gc);
                mrun = bL + Gc;
            } }
            __syncthreads();
            { OPQ(tB); const int laneB = tB & 63, l15 = laneB & 15, l4 = laneB >> 4;
                const int tt = wave >> 1;
#pragma unroll
                for (int sti = 0; sti < 2; ++sti) { const int st = 2 * (wave & 1) + sti;
                    f32x4 acc4 = {0.f, 0.f, 0.f, 0.f};
                    if (st <= tt) {
#pragma unroll
                        for (int ks = 0; ks < 8; ++ks) { const bf16x8 A = *(const LAS bf16x8*)(lds + MC_QI + (16 * tt + l15) * MC_QROW + ks * 64 + l4 * 16);
                            const bf16x8 B = *(const LAS bf16x8*)(lds + MC_KI + (16 * st + l15) * MC_QROW + ks * 64 + l4 * 16); acc4 = MFMA16(A, B, acc4); }
                    }
                    const int sidx = 16 * st + l15; const float as_ = mc_sc(lds, 0)[sidx];
#pragma unroll
                    for (int rg = 0; rg < 4; ++rg) { const int t = 16 * tt + 4 * l4 + rg; float p = 0.f;
                        if (st <= tt && sidx <= t) p = acc4[rg] * __expf(as_ - mc_sc(lds, 1)[t]);
                        *(LAS unsigned short*)(lds + MC_P + t * MC_TROW + sidx * 2) = (unsigned short)f2bf(p);
                        float sum = p; sum += __shfl_xor(sum, 1); sum += __shfl_xor(sum, 2); sum += __shfl_xor(sum, 4); sum += __shfl_xor(sum, 8);
                        if (l15 == 0) mc_sc(lds, 7 + st)[t] = sum; }
                }
              const int t = tB >> 3, seg = tB & 7; float sacc = 0.f;
#pragma unroll
                for (int k = 0; k < 4; ++k) { const u32x4 qv = *(const LAS u32x4*)(lds + MC_QI + t * MC_QROW + (seg * 32 + k * 8) * 2);
                    const f32x4 n0 = *(const LAS f32x4*)(nvec + seg * 32 + k * 8), n1 = *(const LAS f32x4*)(nvec + seg * 32 + k * 8 + 4);
                    sacc += bflo(qv.x) * n0.x + bfhi(qv.x) * n0.y + bflo(qv.y) * n0.z + bfhi(qv.y) * n0.w + bflo(qv.z) * n1.x + bfhi(qv.z) * n1.y + bflo(qv.w) * n1.z + bfhi(qv.w) * n1.w; }
                sacc += __shfl_xor(sacc, 1); sacc += __shfl_xor(sacc, 2); sacc += __shfl_xor(sacc, 4);
                if (seg == 0) mc_sc(lds, 5)[t] = sacc; }
            __syncthreads();
            const float cd = misc[0];
            f32x16 acc[2];
            { OPQ(tC); const int laneC = tC & 63, r = laneC & 31, hf = laneC >> 5;
            if (tC < 64) { const int t = tC; const float den = mc_sc(lds, 7)[t] + mc_sc(lds, 8)[t] + mc_sc(lds, 9)[t] + mc_sc(lds, 10)[t];
                const float dn = den + mc_sc(lds, 2)[t] * mc_sc(lds, 5)[t]; mc_sc(lds, 6)[t] = 1.0f / fmaxf(fabsf(dn), mc_sc(lds, 4)[t]); }
#pragma unroll
            for (int t2 = 0; t2 < 2; ++t2)
#pragma unroll
                for (int i = 0; i < 16; ++i) acc[t2][i] = 0.f;
            const LAS unsigned char* qbase = lds + MC_QI + r * MC_QROW + hf * 8;
#pragma unroll
            for (int dt = 0; dt < 8; ++dt) { const bf16x8 cl = pack_lo(C[dt]), chh = pack_hi(C[dt]);
#pragma unroll
                for (int t2 = 0; t2 < 2; ++t2) { const LAS unsigned char* qb = qbase + t2 * 32 * MC_QROW + dt * 64;
                    const s16x4 a0l = *(const LAS s16x4*)(qb), a0h = *(const LAS s16x4*)(qb + 16), a1l = *(const LAS s16x4*)(qb + 32), a1h = *(const LAS s16x4*)(qb + 48);
                    acc[t2] = MFMA32(__builtin_shufflevector(a0l, a0h, 0, 1, 2, 3, 4, 5, 6, 7), cl, acc[t2]);
                    acc[t2] = MFMA32(__builtin_shufflevector(a1l, a1h, 0, 1, 2, 3, 4, 5, 6, 7), chh, acc[t2]); } }
#pragma unroll
            for (int t2 = 0; t2 < 2; ++t2)
#pragma unroll
                for (int i = 0; i < 16; ++i) acc[t2][i] *= mc_sc(lds, 2)[32 * t2 + crow(i, hf)];
            bf16x8 vt[4];
            const LAS unsigned char* vbase = lds + MC_VT + (32 * wave + r) * MC_TROW + hf * 16;
#pragma unroll
            for (int ks = 0; ks < 4; ++ks) vt[ks] = *(const LAS bf16x8*)(vbase + ks * 32);
            const LAS unsigned char* pbase = lds + MC_P + r * MC_TROW + hf * 16;
#pragma unroll
            for (int t2 = 0; t2 < 2; ++t2)
#pragma unroll
                for (int ks = 0; ks < 4; ++ks) { const bf16x8 pA = *(const LAS bf16x8*)(pbase + t2 * 32 * MC_TROW + ks * 32); acc[t2] = MFMA32(pA, vt[ks], acc[t2]); }
            asm volatile("" : "+v"(acc[0]), "+v"(acc[1]));
#pragma unroll
            for (int ks = 0; ks < 4; ++ks) {
                const f32x4 w0 = *(const LAS f32x4*)(mc_sc(lds, 3) + 16 * ks + 8 * hf), w1 = *(const LAS f32x4*)(mc_sc(lds, 3) + 16 * ks + 8 * hf + 4);
                const u32x4 vv = __builtin_bit_cast(u32x4, vt[ks]); u32x4 o;
                o.x = pk2(bflo(vv.x) * w0.x, bfhi(vv.x) * w0.y); o.y = pk2(bflo(vv.y) * w0.z, bfhi(vv.y) * w0.w); o.z = pk2(bflo(vv.z) * w1.x, bfhi(vv.z) * w1.y); o.w = pk2(bflo(vv.w) * w1.z, bfhi(vv.w) * w1.w);
                vt[ks] = __builtin_bit_cast(bf16x8, o); }
            const LAS unsigned char* kbase = lds + MC_KT + r * MC_TROW + hf * 16;
#pragma unroll
            for (int dt = 0; dt < 8; ++dt) {
#pragma unroll
                for (int i = 0; i < 16; ++i) C[dt][i] *= cd;
#pragma unroll
                for (int ks = 0; ks < 4; ++ks) { const bf16x8 kA = *(const LAS bf16x8*)(kbase + dt * 32 * MC_TROW + ks * 32); C[dt] = MFMA32(kA, vt[ks], C[dt]); } }
            if (tC < 256) { float sacc = cd * nvec[tC];
#pragma unroll
                for (int k = 0; k < 8; ++k) { const u32x4 kv = *(const LAS u32x4*)(lds + MC_KT + tC * MC_TROW + k * 16);
                    const f32x4 w0 = *(const LAS f32x4*)(mc_sc(lds, 3) + k * 8), w1 = *(const LAS f32x4*)(mc_sc(lds, 3) + k * 8 + 4);
                    sacc += bflo(kv.x) * w0.x + bfhi(kv.x) * w0.y + bflo(kv.y) * w0.z + bfhi(kv.y) * w0.w + bflo(kv.z) * w1.x + bfhi(kv.z) * w1.y + bflo(kv.w) * w1.z + bfhi(kv.w) * w1.w; }
                nvec[tC] = sacc; }
            }
            __syncthreads();
            { OPQ(tD); const int laneD = tD & 63, r = laneD & 31, hf = laneD >> 5;
#pragma unroll
            for (int t2 = 0; t2 < 2; ++t2)
#pragma unroll
                for (int i = 0; i < 16; ++i) *(LAS float*)(lds + MC_QI + (32 * t2 + crow(i, hf)) * MC_STROW + (32 * wave + r) * 4) = acc[t2][i];
            }
            __syncthreads();
            { OPQ(tE); const int t = tE >> 3, seg = tE & 7; const float rden = mc_sc(lds, 6)[t]; float s1 = 0.f, s2 = 0.f;
                const LAS unsigned char* sp = lds + MC_QI + t * MC_STROW + (seg * 32) * 4;
#pragma unroll
                for (int k = 0; k < 8; ++k) { const f32x4 v = *(const LAS f32x4*)(sp + k * 16) * rden;
                    s1 += (v.x + v.y) + (v.z + v.w); s2 += (v.x * v.x + v.y * v.y) + (v.z * v.z + v.w * v.w); }
                s1 += __shfl_xor(s1, 1); s1 += __shfl_xor(s1, 2); s1 += __shfl_xor(s1, 4); s2 += __shfl_xor(s2, 1); s2 += __shfl_xor(s2, 2); s2 += __shfl_xor(s2, 4);
                const float mean = s1 * (1.0f / MD); const float var = fmaxf(s2 * (1.0f / MD) - mean * mean, 0.f); const float rstd = 1.0f / sqrtf(var + LN_EPS);
                const float sc = rden * rstd, sh = -mean * rstd;
                const size_t row = rowbase + t; const int col = hd * MD + seg * 32;
#pragma unroll 1
                for (int k = 0; k < 4; ++k) { const u32x4 xv = *(const u32x4*)(XC + row * 1024 + col + k * 8); const u32x4 zv = *(const u32x4*)(ZM + row * 1024 + col + k * 8);
                    const f32x4 g0 = *(const f32x4*)(mh_norm + col + k * 8), g1 = *(const f32x4*)(mh_norm + col + k * 8 + 4), k0 = *(const f32x4*)(skip + col + k * 8), k1 = *(const f32x4*)(skip + col + k * 8 + 4);
                    const f32x4 h0 = *(const LAS f32x4*)(sp + k * 32) * sc + sh, h1 = *(const LAS f32x4*)(sp + k * 32 + 16) * sc + sh;
                    float y[8];
                    y[0] = (h0.x * g0.x + k0.x * bflo(xv.x)) * silu_f(bflo(zv.x)); y[1] = (h0.y * g0.y + k0.y * bfhi(xv.x)) * silu_f(bfhi(zv.x));
                    y[2] = (h0.z * g0.z + k0.z * bflo(xv.y)) * silu_f(bflo(zv.y)); y[3] = (h0.w * g0.w + k0.w * bfhi(xv.y)) * silu_f(bfhi(zv.y));
                    y[4] = (h1.x * g1.x + k1.x * bflo(xv.z)) * silu_f(bflo(zv.z)); y[5] = (h1.y * g1.y + k1.y * bfhi(xv.z)) * silu_f(bfhi(zv.z));
                    y[6] = (h1.z * g1.z + k1.z * bflo(xv.w)) * silu_f(bflo(zv.w)); y[7] = (h1.w * g1.w + k1.w * bfhi(xv.w)) * silu_f(bfhi(zv.w));
                    u32x4 o; o.x = pk2(y[0], y[1]); o.y = pk2(y[2], y[3]); o.z = pk2(y[4], y[5]); o.w = pk2(y[6], y[7]);
                    *(u32x4*)(QK + row * 2048 + 1024 + col + k * 8) = o; } }
            __syncthreads();
        }
    }
#undef OPQ
}

DI void phase_final(const Args& a, int lane, int wave, int bid, int G) {
    const float* x = a.in[0]; const float* g_post = a.in[3]; float* out = a.out;
    const int gw = bid * NWAVES + wave, NGW = G * NWAVES;
    const f32x4* gr = (const f32x4*)g_post + lane; f32x4 gg[4];
#pragma unroll
    for (int j = 0; j < 4; ++j) gg[j] = gr[64 * j];
    for (int m = gw; m < MTOK; m += NGW) {
        f32x4* yr = (f32x4*)(out + (size_t)m * DM) + lane; const f32x4* xr = (const f32x4*)(x + (size_t)m * DM) + lane; f32x4 v[4], xv[4]; float s = 0.f;
#pragma unroll
        for (int j = 0; j < 4; ++j) { v[j] = yr[64 * j]; xv[j] = xr[64 * j]; s += (v[j].x * v[j].x + v[j].y * v[j].y) + (v[j].z * v[j].z + v[j].w * v[j].w); }
        const float rstd = 1.0f / sqrtf(wave_sum(s) * (1.0f / DM) + RMS_EPS);
#pragma unroll
        for (int j = 0; j < 4; ++j) { f32x4 o; o.x = xv[j].x + v[j].x * rstd * gg[j].x; o.y = xv[j].y + v[j].y * rstd * gg[j].y; o.z = xv[j].z + v[j].z * rstd * gg[j].z; o.w = xv[j].w + v[j].w * rstd * gg[j].w; yr[64 * j] = o; }
    }
}

#define XB_TMO      128
#define XB_XCNT(j)  (256  + 64 * (j))
#define XB_XSUB(j)  (1280 + 64 * (j))
#define XB_XGEN(j)  (2304 + 64 * (j))
#define XB_TOP      3328
#define XB_TOPGEN   3392
#define XCD_BAR_WORDS 3456
#define XB_SPIN_CAP (1u << 18)

__device__ __forceinline__ unsigned xb_ld(unsigned* p)              { return __hip_atomic_load(p, __ATOMIC_RELAXED, __HIP_MEMORY_SCOPE_AGENT); }
__device__ __forceinline__ unsigned xb_add(unsigned* p, unsigned v) { return __hip_atomic_fetch_add(p, v, __ATOMIC_RELAXED, __HIP_MEMORY_SCOPE_AGENT); }
__device__ __forceinline__ unsigned xb_xcc_id() { return (unsigned)__builtin_amdgcn_s_getreg((3 << 11) | 20) & 0xFu; }
#define XB_SPIN(cond, bar) do { unsigned _sp = 0; while (cond) { __builtin_amdgcn_s_sleep(1); \
    if ((++_sp & 255u) == 0u) { if (xb_ld(&(bar)[XB_TMO])) break; if (_sp > XB_SPIN_CAP) { atomicAdd(&(bar)[XB_TMO], 1u); break; } } } } while (0)

struct XcdBarrier {
    unsigned* bar; unsigned x;
    volatile LAS unsigned* st;
};

__device__ __forceinline__ XcdBarrier xcd_barrier_post(unsigned* bar, volatile LAS unsigned* st) {
    XcdBarrier b; b.bar = bar; b.x = xb_xcc_id(); b.st = st;
    if (threadIdx.x == 0) (void)xb_add(&bar[XB_XCNT(b.x)], 1u);
    return b;
}
__device__ __forceinline__ void xcd_barrier_complete(unsigned* bar, unsigned x, unsigned& nloc, unsigned& nx) {
    const unsigned G = gridDim.x * gridDim.y * gridDim.z;
    unsigned sum, cnt, mine, sp = 0u;
    for (;;) {
        sum = 0u; cnt = 0u; mine = 0u;
#pragma unroll
        for (unsigned j = 0; j < 16; ++j) { const unsigned c = xb_ld(&bar[XB_XCNT(j)]); sum += c; cnt += (c > 0u) ? 1u : 0u; mine = (j == x) ? c : mine; }
        if (sum == G) break;
        __builtin_amdgcn_s_sleep(1);
        if ((++sp & 255u) == 0u) { if (xb_ld(&bar[XB_TMO])) break; if (sp > XB_SPIN_CAP) { atomicAdd(&bar[XB_TMO], 1u); break; } }
    }
    nloc = mine > 0u ? mine : 1u; nx = cnt > 0u ? cnt : 1u;
}

__device__ __forceinline__ void xcd_barrier(const XcdBarrier& b) {
    asm volatile("s_waitcnt vmcnt(0)" ::: "memory");
    __syncthreads();
    if (threadIdx.x == 0) {
        unsigned* bar = b.bar;
        __builtin_amdgcn_s_waitcnt(0);
        unsigned nloc = b.st[0], nx = b.st[1];
        if (nloc == 0u) { xcd_barrier_complete(bar, b.x, nloc, nx); b.st[0] = nloc; b.st[1] = nx; }
        const unsigned old = xb_add(&bar[XB_XSUB(b.x)], 1u);
        const unsigned gen = old / nloc;
        if (old + 1u == (gen + 1u) * nloc) {
            __builtin_amdgcn_fence(__ATOMIC_RELEASE, "agent");
            asm volatile("s_waitcnt vmcnt(0)" ::: "memory");
            const unsigned og = xb_add(&bar[XB_TOP], 1u);
            const unsigned tg = og / nx;
            if (og + 1u == (tg + 1u) * nx) xb_add(&bar[XB_TOPGEN], 1u);
            else XB_SPIN(xb_ld(&bar[XB_TOPGEN]) == tg, bar);
            __builtin_amdgcn_fence(__ATOMIC_ACQUIRE, "agent");
            xb_add(&bar[XB_XGEN(b.x)], 1u);
            asm volatile("s_waitcnt vmcnt(0)" ::: "memory");
        } else {
            XB_SPIN(xb_ld(&bar[XB_XGEN(b.x)]) == gen, bar);
            __builtin_amdgcn_fence(__ATOMIC_ACQUIRE, "agent");
            asm volatile("s_waitcnt vmcnt(0)" ::: "memory");
        }
    }
    __syncthreads();
}

constexpr int NPHASE = 12;
#ifndef DUP_PHASE
#define DUP_PHASE -1
#endif
#define DUPSYNC(k) if (DUP_PHASE == (k)) grid.sync()
#ifndef MK_MULTI
#define MK_MULTI 0
#endif
__global__ void __launch_bounds__(NTHR, 2) hymba_fwd(Args args) {
    extern __shared__ __attribute__((aligned(16))) unsigned char lds_raw[];
    LAS unsigned char* lds = (LAS unsigned char*)lds_raw;
    cg::grid_group grid = cg::this_grid();
    const int tid = threadIdx.x, lane = tid & 63, wave = __builtin_amdgcn_readfirstlane(tid >> 6), bid = blockIdx.x, G = gridDim.x;
    const int lo = args.ph_lo, hi = args.ph_hi;
#ifdef ONLY_PHASE
#define IN(k) ((k) == ONLY_PHASE && lo <= (k) && (k) < hi)
#else
#define IN(k) (lo <= (k) && (k) < hi)
#endif
    unsigned char* ws = args.ws;
    volatile LAS unsigned* barst = (volatile LAS unsigned*)(lds + LDS_BARST);
    if (tid < 2) barst[tid] = 0u;
    __syncthreads();
    XcdBarrier xbar = xcd_barrier_post((unsigned*)(ws + WS_CTL) + CW_BAR, barst);
#define SEAM(k) do { if (IN(k) && IN((k) + 1)) { if ((k) == 0) grid.sync(); else xcd_barrier(xbar); } } while (0)
#undef DUPSYNC
    if (IN(0)) { phase_prologue(args, lds, tid, lane, wave, bid, G); if (DUP_PHASE == 0) { xcd_barrier(xbar); phase_prologue(args, lds, tid, lane, wave, bid, G); } } SEAM(0);
    if (IN(1)) {
        pg8::Gemm g{(const pg8::bf16_t*)(ws + WS_XN), (const pg8::bf16_t*)(ws + WS_WINT), MTOK, NIN, DM}; pg8::StaticOrder S; S.init(MTOK, NIN, G, bid);
        pg8::EpiProj E{(pg8::bf16_t*)(ws + WS_QK), (pg8::bf16_t*)(ws + WS_V), (pg8::bf16_t*)(ws + WS_G), (pg8::bf16_t*)(ws + WS_XM), (pg8::bf16_t*)(ws + WS_ZM), QSCALE};
        pg8::gemm_phase<pg8::EpiProj, pg8::StaticOrder, true, true>(lds, g, S, E);
        if (DUP_PHASE == 1) { xcd_barrier(xbar); pg8::gemm_phase<pg8::EpiProj, pg8::StaticOrder, true, true>(lds, g, S, E); }
    } SEAM(1);
    if (IN(2)) { phase_kstat(args, lds, tid, lane, wave, bid, G); if (DUP_PHASE == 2) { xcd_barrier(xbar); phase_kstat(args, lds, tid, lane, wave, bid, G); } } SEAM(2);
    if (IN(3)) { phase_sel(args, lds, tid, lane, wave, bid, G); } SEAM(3);
    if (IN(4)) { phase_att_gather(args, lds, tid, lane, wave, bid, G); if (DUP_PHASE == 4) { xcd_barrier(xbar); phase_att_gather(args, lds, tid, lane, wave, bid, G); } } SEAM(4);
    if (IN(5)) { phase_att_own(args, lds, tid, lane, wave, bid, G); } SEAM(5);
    if (IN(6)) { phase_mpre(args, lds, tid, lane, wave, bid, G); if (DUP_PHASE == 6) { xcd_barrier(xbar); phase_mpre(args, lds, tid, lane, wave, bid, G); } } SEAM(6);
    if (IN(7)) { phase_mstate(args, lds, tid, lane, wave, bid, G); if (DUP_PHASE == 7) { xcd_barrier(xbar); phase_mstate(args, lds, tid, lane, wave, bid, G); } } SEAM(7);
    if (IN(8)) { phase_mcomb(args, tid, bid, G); } SEAM(8);
    if (IN(9)) { phase_mscan(args, lds, tid, lane, wave, bid, G); if (DUP_PHASE == 9) { xcd_barrier(xbar); phase_mscan(args, lds, tid, lane, wave, bid, G); } } SEAM(9);
    if (IN(10)) {
        pg8::Gemm g{(const pg8::bf16_t*)(ws + WS_QK), (const pg8::bf16_t*)(ws + WS_WOUTT), MTOK, DM, MIXW}; pg8::StaticOrder S; S.init(MTOK, DM, G, bid);
        pg8::EpiF32 E{args.out, DM};
        pg8::gemm_phase<pg8::EpiF32, pg8::StaticOrder, true, true>(lds, g, S, E);
        if (DUP_PHASE == 10) { xcd_barrier(xbar); pg8::gemm_phase<pg8::EpiF32, pg8::StaticOrder, true, true>(lds, g, S, E); }
    } SEAM(10);
    if (IN(11)) { phase_final(args, lane, wave, bid, G); }
#undef IN
#undef SEAM
}

extern "C" void kernel_launch(void* const* d_in, const int* in_sizes, int n_in, void* d_out, int out_size, void* d_ws, size_t ws_size, hipStream_t stream) {
    static int grid = 0;
    if (grid == 0) {
        if (n_in != 15 || out_size != MTOK * DM || ws_size < WS_END) { fprintf(stderr, "kernel_launch: unexpected shapes (n_in %d out %d ws %zu)\n", n_in, out_size, ws_size); grid = -1; return; }
        int dev = 0, cus = 0, per_cu = 0;
        if (hipGetDevice(&dev) != hipSuccess || hipDeviceGetAttribute(&cus, hipDeviceAttributeMultiprocessorCount, dev) != hipSuccess) { grid = -1; return; }
        if (hipFuncSetAttribute((const void*)hymba_fwd, hipFuncAttributeMaxDynamicSharedMemorySize, LDS_BYTES) != hipSuccess) { fprintf(stderr, "kernel_launch: hipFuncSetAttribute failed\n"); grid = -1; return; }
        if (hipOccupancyMaxActiveBlocksPerMultiprocessor(&per_cu, (const void*)hymba_fwd, NTHR, LDS_BYTES) != hipSuccess || per_cu < 1) { fprintf(stderr, "kernel_launch: occupancy query says %d\n", per_cu); per_cu = 1; }
        (void)hipGetLastError();
        grid = cus * 1;
        fprintf(stderr, "kernel_launch: grid %d (cus %d, query per_cu %d)\n", grid, cus, per_cu);
    }
    if (grid < 0) return;
    (void)hipMemsetAsync((char*)d_ws + WS_CTL, 0, CTL_ZERO_BYTES, stream);
    Args a{};
    for (int i = 0; i < 15; ++i) a.in[i] = (const float*)d_in[i];
    a.out = (float*)d_out; a.ws = (unsigned char*)d_ws;
#if MK_MULTI
    for (int p = 0; p < NPHASE; ++p) { a.ph_lo = p; a.ph_hi = p + 1; hipLaunchKernelGGL(hymba_fwd, dim3(grid), dim3(NTHR), LDS_BYTES, stream, a); }
#else
    a.ph_lo = 0; a.ph_hi = NPHASE;
    void* kargs[] = {&a};
    hipError_t e = hipLaunchCooperativeKernel((const void*)hymba_fwd, dim3(grid), dim3(NTHR), kargs, LDS_BYTES, stream);
    if (e != hipSuccess) fprintf(stderr, "kernel_launch: cooperative launch failed: %s (grid %d)\n", hipGetErrorString(e), grid);
#endif
}
```

```cpp
#include <hip/hip_runtime.h>
#include <hip/hip_cooperative_groups.h>
#include <cstdio>
#include <cstdint>
namespace cg = cooperative_groups;
namespace pg8 {
#define PG8_LAS __attribute__((address_space(3)))
typedef unsigned short bf16_t;
typedef short bf16x8 __attribute__((ext_vector_type(8)));
typedef float f32x4 __attribute__((ext_vector_type(4)));
typedef unsigned u32x4 __attribute__((ext_vector_type(4)));
constexpr int BM = 256, BK = 64, HALF = 128, HTB = HALF * BK * 2  , STAGE_BYTES = 8 * HTB, NXCD = 8, WGM = 8;

__host__ __device__ __forceinline__ int lds_byte(int r, int c) { const int st = (r >> 4) * 2 + (c >> 5), rr = r & 15, cc = c & 31, ob = rr * 64 + cc * 2; return st * 1024 + (ob ^ (((ob >> 9) & 1) << 5)); }
__host__ __device__ __forceinline__ void stage_rc(int b, int& R, int& C) { const int st = b / 1024, sb = b % 1024, swz = sb ^ (((sb >> 9) & 1) << 5); R = (st >> 1) * 16 + swz / 64; C = (st & 1) * 32 + (swz % 64) / 2; }
__host__ __device__ __forceinline__ int perm32(int rho) { const int n = rho >> 4, i = rho & 15; return 8 * (i >> 2) + 4 * n + (i & 3); }

struct Unit { int pm, pn; };
struct Gemm { const bf16_t* A; const bf16_t* Bt; int M, N, K; };

struct StaticOrder {
    int nM, nN, nwg, G, c;
    __host__ __device__ void init(int M, int N, int G_, int c_) { nM = M / BM; nN = N / BM; nwg = nM * nN; G = G_; c = c_; }
    __host__ __device__ bool next(int i, Unit& u) const {
        const long L = (long)i * G + c; if (L >= nwg) return false;
        int wgid = (int)L; { const int q = nwg / NXCD, r = nwg % NXCD, xcd = wgid % NXCD, off = wgid / NXCD; wgid = (xcd < r ? xcd * (q + 1) : r * (q + 1) + (xcd - r) * q) + off; }
        const int nig = WGM * nN, gid = wgid / nig, fm = gid * WGM, gsz = (nM - fm) < WGM ? (nM - fm) : WGM;
        u.pm = fm + ((wgid % nig) % gsz); u.pn = (wgid % nig) / gsz; return true;
    }
    __device__ __forceinline__ void a_ready(const Unit&) const {}
    __device__ __forceinline__ void done(const Unit&) const {}
};

__device__ __forceinline__ unsigned cvt_pk_bf16(float lo, float hi) { unsigned r; asm volatile("v_cvt_pk_bf16_f32 %0, %1, %2" : "=v"(r) : "v"(lo), "v"(hi)); return r; }
typedef float f32x2 __attribute__((ext_vector_type(2)));
struct EpiProj {
    static constexpr bool PERM = true, AFTER_DRAIN = false;
    bf16_t* QK; bf16_t* V; bf16_t* G; bf16_t* XM; bf16_t* ZM; float qscale;
    __device__ __forceinline__ void operator()(const f32x4 (&acc)[2][2][4][2], const Unit& u, int wr, int wc, int fr, int fq) const {
        const int row0 = u.pm * BM + wr * 64 + fr; const int colt = u.pn * BM; const int t = colt >> 10; const int cgp = colt & 1023;
        bf16_t* base; int ldc; float sc = 1.f;
        if (t == 0) { base = QK; ldc = 2048; sc = qscale; } else if (t == 1) { base = QK + 1024; ldc = 2048; } else if (t == 2) { base = V; ldc = 1024; }
        else if (t == 3) { base = G; ldc = 1024; } else if (t == 4) { base = XM; ldc = 1024; } else { base = ZM; ldc = 1024; }
        const int col0 = cgp + wc * 32 + 8 * fq;
#pragma unroll
        for (int ai = 0; ai < 2; ++ai)
#pragma unroll
            for (int m = 0; m < 4; ++m) { bf16_t* rowp = base + (size_t)(row0 + ai * HALF + m * 16) * ldc + col0;
#pragma unroll
                for (int bj = 0; bj < 2; ++bj) { f32x4 v0 = acc[ai][bj][m][0] * sc, v1 = acc[ai][bj][m][1] * sc;
                    u32x4 w; w.x = cvt_pk_bf16(v0[0], v0[1]); w.y = cvt_pk_bf16(v0[2], v0[3]); w.z = cvt_pk_bf16(v1[0], v1[1]); w.w = cvt_pk_bf16(v1[2], v1[3]);
                    *(u32x4*)(rowp + bj * HALF) = w; } }
    }
};
struct EpiF32 {
    static constexpr bool PERM = false, AFTER_DRAIN = false;
    float* O; int ldc;
    __device__ __forceinline__ void operator()(const f32x4 (&acc)[2][2][4][2], const Unit& u, int wr, int wc, int fr, int fq) const {
        const int col0 = u.pn * BM + wc * 32 + 4 * fq;
#pragma unroll
        for (int ai = 0; ai < 2; ++ai)
#pragma unroll
            for (int m = 0; m < 4; ++m) { const int r = ai * HALF + wr * 64 + m * 16 + fr; const size_t off = (size_t)(u.pm * BM + r) * ldc + col0;
#pragma unroll
                for (int bj = 0; bj < 2; ++bj)
#pragma unroll
                    for (int n = 0; n < 2; ++n) *(f32x4*)(O + off + bj * HALF + n * 16) = acc[ai][bj][m][n]; }
    }
};
template <class Epi, class Sched, bool ALIGN_EPI = false, bool SP2 = false>
__device__ __forceinline__ void gemm_phase(PG8_LAS unsigned char* lds, const Gemm g, const Sched& S, const Epi& E) {
    const int tid = threadIdx.x, wid = __builtin_amdgcn_readfirstlane(tid >> 6), lane = tid & 63, wr = wid >> 2, wc = wid & 3, fr = lane & 15, fq = lane >> 4;
    const int K = g.K, nt = K / BK;
    unsigned voffA[2], voffB[2];
#pragma unroll
    for (int i = 0; i < 2; ++i) { int R, C; stage_rc(tid * 16 + i * 8192, R, C); const int Rb = Epi::PERM ? ((R & ~31) + perm32(R & 31)) : R;
        voffA[i] = (unsigned)(R * K + C) * 2u; voffB[i] = (unsigned)(Rb * K + C) * 2u; }
    const size_t kstep = (size_t)(BK * 2);
    const size_t hstep = (size_t)HALF * K * 2;
    const size_t tstep = 2 * hstep;
    const unsigned ldsw = (unsigned)wid * 1024u;
    const int aoff = lds_byte(wr * 64 + fr, fq * 8), boff = lds_byte(wc * 32 + fr, fq * 8);
#define PG8_SA(b, h) (((b) * 2 + (h)) * HTB)
#define PG8_SB(b, h) ((4 + (b) * 2 + (h)) * HTB)
#define PG8_STAGE(bufoff, gbase, voff) do { _Pragma("unroll") for (int _i = 0; _i < 2; ++_i) \
        __builtin_amdgcn_global_load_lds((const unsigned*)((const char*)(gbase) + (voff)[_i]), (PG8_LAS unsigned*)(lds + (bufoff) + ldsw + _i * 8192), 16, 0, 0); } while (0)
#define PG8_LDA(dst, b, h) do { _Pragma("unroll") for (int m = 0; m < 4; ++m) _Pragma("unroll") for (int k = 0; k < 2; ++k) dst[m][k] = *(const PG8_LAS bf16x8*)(lds + PG8_SA(b, h) + aoff + m * 2048 + k * 1024); } while (0)
#define PG8_LDB(dst, b, h) do { _Pragma("unroll") for (int n = 0; n < 2; ++n) _Pragma("unroll") for (int k = 0; k < 2; ++k) dst[n][k] = *(const PG8_LAS bf16x8*)(lds + PG8_SB(b, h) + boff + n * 2048 + k * 1024); } while (0)
#define PG8_MMA(ai, bj, At, Bt) do { __builtin_amdgcn_s_setprio(1); _Pragma("unroll") for (int m = 0; m < 4; ++m) _Pragma("unroll") for (int n = 0; n < 2; ++n) _Pragma("unroll") for (int k = 0; k < 2; ++k) \
        acc[ai][bj][m][n] = __builtin_amdgcn_mfma_f32_16x16x32_bf16(Bt[n][k], At[m][k], acc[ai][bj][m][n], 0, 0, 0); __builtin_amdgcn_s_setprio(0); } while (0)
#define PG8_WAIT_V(n) asm volatile("s_waitcnt vmcnt(" #n ")" ::: "memory")
#define PG8_WAIT_L(n) asm volatile("s_waitcnt lgkmcnt(" #n ")" ::: "memory")
#define PG8_BAR __builtin_amdgcn_s_barrier()
#define PG8_SCHED __builtin_amdgcn_sched_barrier(0)
    Unit cur, nxt; int ui = 0;
    if (!S.next(0, cur)) return;
    f32x4 acc[2][2][4][2];
#pragma unroll
    for (int a = 0; a < 2; ++a)
#pragma unroll
        for (int b = 0; b < 2; ++b)
#pragma unroll
            for (int m = 0; m < 4; ++m)
#pragma unroll
                for (int n = 0; n < 2; ++n) acc[a][b][m][n] = (f32x4){0.f, 0.f, 0.f, 0.f};
    bf16x8 At[4][2], B0[2][2], B1[2][2];
    const char* cA = (const char*)g.A + (size_t)cur.pm * tstep; const char* cB = (const char*)g.Bt + (size_t)cur.pn * tstep;
    S.a_ready(cur);
    if constexpr (SP2) {
        PG8_STAGE(PG8_SB(0, 0), cB, voffB); PG8_STAGE(PG8_SB(0, 1), cB + hstep, voffB); PG8_STAGE(PG8_SA(0, 0), cA, voffA); PG8_STAGE(PG8_SA(0, 1), cA + hstep, voffA);
        if (wr == 1) PG8_BAR;
        PG8_WAIT_V(2); PG8_BAR;
        PG8_STAGE(PG8_SB(1, 0), cB + kstep, voffB); PG8_STAGE(PG8_SA(1, 0), cA + kstep, voffA); PG8_STAGE(PG8_SB(1, 1), cB + hstep + kstep, voffB);
        PG8_WAIT_V(6); PG8_BAR;
    } else {
        PG8_STAGE(PG8_SB(0, 0), cB, voffB); PG8_STAGE(PG8_SA(0, 0), cA, voffA); PG8_STAGE(PG8_SB(0, 1), cB + hstep, voffB); PG8_STAGE(PG8_SA(0, 1), cA + hstep, voffA);
        if (wr == 1) PG8_BAR;
        PG8_WAIT_V(4); PG8_BAR;
        PG8_STAGE(PG8_SB(1, 0), cB + kstep, voffB); PG8_STAGE(PG8_SA(1, 0), cA + kstep, voffA); PG8_STAGE(PG8_SB(1, 1), cB + hstep + kstep, voffB);
        PG8_WAIT_V(6); PG8_BAR;
    }
    for (;;) {
        const bool has_next = S.next(ui + 1, nxt);
        const char* nA = has_next ? (const char*)g.A + (size_t)nxt.pm * tstep : cA; const char* nB = has_next ? (const char*)g.Bt + (size_t)nxt.pn * tstep : cB;
        for (int t = 0; t < nt; t += 2) {
            const bool last = (t == nt - 2);
            const char* a1 = cA + (size_t)(t + 1) * kstep;
            const char* a2 = last ? nA : cA + (size_t)(t + 2) * kstep; const char* b2 = last ? nB : cB + (size_t)(t + 2) * kstep;
            const char* a3 = a2 + kstep; const char* b3 = b2 + kstep;
            if (last && has_next) S.a_ready(nxt);
            if constexpr (SP2) {
            PG8_LDB(B0, 0, 0); PG8_LDB(B1, 0, 1); PG8_SCHED; PG8_LDA(At, 0, 0); PG8_STAGE(PG8_SA(1, 1), a1 + hstep, voffA);
            PG8_WAIT_V(8); PG8_WAIT_L(0); PG8_BAR; PG8_MMA(0, 0, At, B0); PG8_MMA(0, 1, At, B1); PG8_BAR; PG8_SCHED;
            PG8_LDA(At, 0, 1); PG8_STAGE(PG8_SB(0, 0), b2, voffB); PG8_STAGE(PG8_SB(0, 1), b2 + hstep, voffB); PG8_STAGE(PG8_SA(0, 0), a2, voffA);
            PG8_WAIT_V(8); PG8_WAIT_L(0); PG8_BAR; PG8_MMA(1, 0, At, B0); PG8_MMA(1, 1, At, B1); PG8_BAR; PG8_SCHED;
            PG8_LDB(B0, 1, 0); PG8_LDB(B1, 1, 1); PG8_SCHED; PG8_LDA(At, 1, 0); PG8_STAGE(PG8_SA(0, 1), a2 + hstep, voffA);
            PG8_WAIT_V(8); PG8_WAIT_L(0); PG8_BAR; PG8_MMA(0, 0, At, B0); PG8_MMA(0, 1, At, B1); PG8_BAR; PG8_SCHED;
            PG8_LDA(At, 1, 1); PG8_STAGE(PG8_SB(1, 0), b3, voffB); PG8_STAGE(PG8_SB(1, 1), b3 + hstep, voffB); PG8_STAGE(PG8_SA(1, 0), a3, voffA);
            PG8_WAIT_V(8); PG8_WAIT_L(0); PG8_BAR; PG8_MMA(1, 0, At, B0); PG8_MMA(1, 1, At, B1); PG8_BAR; PG8_SCHED;
            } else {
            PG8_LDB(B0, 0, 0); PG8_SCHED; PG8_LDA(At, 0, 0); PG8_STAGE(PG8_SA(1, 1), a1 + hstep, voffA);
            PG8_WAIT_L(8); PG8_BAR; PG8_WAIT_L(0); PG8_MMA(0, 0, At, B0); PG8_BAR; PG8_SCHED;
            PG8_LDB(B1, 0, 1); PG8_STAGE(PG8_SB(0, 0), b2, voffB);
            PG8_BAR; PG8_WAIT_L(0); PG8_MMA(0, 1, At, B1); PG8_BAR;
            PG8_LDA(At, 0, 1); PG8_STAGE(PG8_SA(0, 0), a2, voffA);
            PG8_BAR; PG8_WAIT_L(0); PG8_MMA(1, 0, At, B0); PG8_BAR; PG8_SCHED;
            PG8_STAGE(PG8_SB(0, 1), b2 + hstep, voffB);
            PG8_WAIT_V(6); PG8_BAR; PG8_MMA(1, 1, At, B1); PG8_BAR;
            PG8_LDB(B0, 1, 0); PG8_SCHED; PG8_LDA(At, 1, 0); PG8_STAGE(PG8_SA(0, 1), a2 + hstep, voffA);
            PG8_WAIT_L(8); PG8_BAR; PG8_WAIT_L(0); PG8_MMA(0, 0, At, B0); PG8_BAR; PG8_SCHED;
            PG8_LDB(B1, 1, 1); PG8_STAGE(PG8_SB(1, 0), b3, voffB);
            PG8_BAR; PG8_WAIT_L(0); PG8_MMA(0, 1, At, B1); PG8_BAR;
            PG8_LDA(At, 1, 1); PG8_STAGE(PG8_SA(1, 0), a3, voffA);
            PG8_BAR; PG8_WAIT_L(0); PG8_MMA(1, 0, At, B0); PG8_BAR; PG8_SCHED;
            PG8_STAGE(PG8_SB(1, 1), b3 + hstep, voffB);
            PG8_WAIT_V(6); PG8_BAR; PG8_MMA(1, 1, At, B1); PG8_BAR;
            }
        }
        if constexpr (ALIGN_EPI) { if (wr == 0) PG8_BAR; }
        if constexpr (!Epi::AFTER_DRAIN) { E(acc, cur, wr, wc, fr, fq); S.done(cur); }
        if (!has_next) break;
#pragma unroll
        for (int a = 0; a < 2; ++a)
#pragma unroll
            for (int b = 0; b < 2; ++b)
#pragma unroll
                for (int m = 0; m < 4; ++m)
#pragma unroll
                    for (int n = 0; n < 2; ++n) acc[a][b][m][n] = (f32x4){0.f, 0.f, 0.f, 0.f};
        cur = nxt; cA = nA; cB = nB; ++ui;
        if constexpr (ALIGN_EPI) { if (wr == 1) PG8_BAR; }
    }
    PG8_WAIT_V(0);
    if constexpr (!ALIGN_EPI) { if (wr == 0) PG8_BAR; }
    PG8_BAR;
    if constexpr (Epi::AFTER_DRAIN) { E.fused(acc, cur, wr, wc, fr, fq, lds, wid, lane); S.done(cur); }
#undef PG8_SA
#undef PG8_SB
#undef PG8_STAGE
#undef PG8_LDA
#undef PG8_LDB
#undef PG8_MMA
#undef PG8_WAIT_V
#undef PG8_WAIT_L
#undef PG8_BAR
#undef PG8_SCHED
}
}

constexpr int NWAVES = 8, NTHR = 512;
constexpr int BATCH = 4, SEQ = 8192, DM = 1024, MTOK = BATCH * SEQ, NIN = 6144, MIXW = 2048;
constexpr int NH = 8, DH = 128, NBLK = SEQ / 256;
constexpr int MH = 4, MD = 256, LCH = 64, NCH = SEQ / LCH;
constexpr float LOG2E = 1.4426950408889634f;
constexpr float QSCALE = 0.08838834764831845f * LOG2E;
constexpr float RMS_EPS = 1e-6f, LN_EPS = 1e-5f;
constexpr int LISTSZ = 256 * 496;
__host__ __device__ constexpr int list_off(int j) { return 256 * (31 * j - (j * (j - 1)) / 2); }

constexpr size_t MiB = 1u << 20;
constexpr size_t WS_CTL = 0, CTL_ZERO_BYTES = 64 * 1024;
constexpr size_t WS_BIASD = 1 * MiB;
constexpr size_t WS_WEFF = 1 * MiB + 64 * 1024;
constexpr size_t WS_KMEAN = 1 * MiB + 128 * 1024;
constexpr size_t WS_KMAX = 1 * MiB + 640 * 1024;
constexpr size_t WS_GLI = 2 * MiB, WS_GLF = 2 * MiB + 512 * 1024;
constexpr size_t WS_SEL = 3 * MiB;
constexpr size_t WS_LPART = 7 * MiB;
constexpr size_t WS_WINT = 10 * MiB;
constexpr size_t WS_WOUTT = 22 * MiB;
constexpr size_t WS_LIST = 26 * MiB;
constexpr size_t WS_XN = 64 * MiB;
constexpr size_t WS_QK = 128 * MiB;
constexpr size_t WS_V = 256 * MiB, WS_G = 320 * MiB, WS_XM = 384 * MiB, WS_ZM = 448 * MiB, WS_END = 512 * MiB;
constexpr size_t WS_NST = 42 * MiB;
constexpr size_t WS_PST = 42 * MiB + 512 * 1024, WS_MIN = 42 * MiB + 516 * 1024;
constexpr size_t WS_CST = WS_V;
constexpr int NSC = 16, SCCH = NCH / NSC;
constexpr int CW_CNT = 1024;
constexpr int CW_BAR = 4096;
constexpr int LDS_BARST = 163840 - 64;

constexpr int LDS_BYTES = 163840;
#define GAS __attribute__((address_space(1)))
#define LAS __attribute__((address_space(3)))
#define DI __device__ __forceinline__
typedef unsigned short bf16;
typedef unsigned u32x4 __attribute__((ext_vector_type(4)));
typedef unsigned u32x2 __attribute__((ext_vector_type(2)));
typedef int i32x4 __attribute__((ext_vector_type(4)));
typedef float f32x4 __attribute__((ext_vector_type(4)));
typedef float f32x16 __attribute__((ext_vector_type(16)));
typedef short bf16x8 __attribute__((ext_vector_type(8)));
typedef short s16x4 __attribute__((ext_vector_type(4)));
typedef float f32x2_t __attribute__((ext_vector_type(2)));
typedef __bf16 bf16x2_t __attribute__((ext_vector_type(2)));
#define MFMA32(a, b, c) __builtin_amdgcn_mfma_f32_32x32x16_bf16((a), (b), (c), 0, 0, 0)
#define MFMA16(a, b, c) __builtin_amdgcn_mfma_f32_16x16x32_bf16((a), (b), (c), 0, 0, 0)

DI float bf2f(unsigned u16) { return __uint_as_float(u16 << 16); }
DI float bflo(unsigned w) { return __uint_as_float(w << 16); }
DI float bfhi(unsigned w) { return __uint_as_float(w & 0xffff0000u); }
DI unsigned pk2(float lo, float hi) { f32x2_t v = {lo, hi}; bf16x2_t b = __builtin_convertvector(v, bf16x2_t); return __builtin_bit_cast(unsigned, b); }
DI unsigned f2bf(float f) { return pk2(f, 0.f) & 0xffffu; }
DI int crow(int reg, int h) { return (reg & 3) + 8 * (reg >> 2) + 4 * h; }
DI float wave_sum(float v) {
#pragma unroll
    for (int o = 1; o < 64; o <<= 1) v += __shfl_xor(v, o);
    return v;
}
DI float wave_max(float v) {
#pragma unroll
    for (int o = 1; o < 64; o <<= 1) v = fmaxf(v, __shfl_xor(v, o));
    return v;
}
DI bf16x8 pack_lo(const f32x16& x) { u32x4 p; p.x = pk2(x[0], x[1]); p.y = pk2(x[2], x[3]); p.z = pk2(x[4], x[5]); p.w = pk2(x[6], x[7]); return __builtin_bit_cast(bf16x8, p); }
DI bf16x8 pack_hi(const f32x16& x) { u32x4 p; p.x = pk2(x[8], x[9]); p.y = pk2(x[10], x[11]); p.z = pk2(x[12], x[13]); p.w = pk2(x[14], x[15]); return __builtin_bit_cast(bf16x8, p); }
DI float silu_f(float v) { return v / (1.0f + __expf(-v)); }

struct Args { const float* in[15]; float* out; unsigned char* ws; int ph_lo, ph_hi; };

DI void p0_transpose_item(const float* W, int K, int N, bf16* WT, LAS float* scr, int item, int lane) {
    const int nblk = N / 32, kb = item / nblk, nb = item % nblk, k0 = 64 * kb, n0 = 32 * nb;
#pragma unroll 8
    for (int i = 0; i < 32; ++i) { const int kk = 2 * i + (lane >> 5); scr[kk * 33 + (lane & 31)] = W[(size_t)(k0 + kk) * N + n0 + (lane & 31)]; }
    asm volatile("s_waitcnt lgkmcnt(0)" ::: "memory");
    const int c = lane & 7;
#pragma unroll
    for (int j = 0; j < 4; ++j) { const int n = (lane >> 3) + 8 * j; const LAS float* s = scr + (8 * c) * 33 + n;
        u32x4 o; o.x = pk2(s[0 * 33], s[1 * 33]); o.y = pk2(s[2 * 33], s[3 * 33]); o.z = pk2(s[4 * 33], s[5 * 33]); o.w = pk2(s[6 * 33], s[7 * 33]);
        *(u32x4*)(WT + (size_t)(n0 + n) * K + k0 + 8 * c) = o; }
    asm volatile("s_waitcnt lgkmcnt(0)" ::: "memory");
}
DI int t5_bucket(int n) {
    if (n < 16) return n;
    int b = 16;
    b += (n >= 22); b += (n >= 30); b += (n >= 40); b += (n >= 54); b += (n >= 73); b += (n >= 99); b += (n >= 134); b += (n >= 182);
    b += (n >= 246); b += (n >= 332); b += (n >= 450); b += (n >= 609); b += (n >= 825); b += (n >= 1117); b += (n >= 1513);
    return b;
}
DI void phase_prologue(const Args& a, LAS unsigned char* lds, int tid, int lane, int wave, int bid, int G) {
    const float* x = a.in[0]; const float* rel_bias = a.in[1]; const float* g_pre = a.in[2]; const float* w_in = a.in[4];
    const float* wq = a.in[7]; const float* wk = a.in[8]; const float* wv = a.in[9]; const float* w_if = a.in[10]; const float* w_out = a.in[14];
    unsigned char* ws = a.ws;
    LAS float* scr = (LAS float*)(lds + wave * 16384);
    const int gw = bid * NWAVES + wave, NGW = G * NWAVES;
    constexpr int I_IN = (DM / 64) * (NIN / 32), I_OUT = (MIXW / 64) * (DM / 32);
    for (int it = gw; it < I_IN + I_OUT; it += NGW) {
        if (it < I_IN) p0_transpose_item(w_in, DM, NIN, (bf16*)(ws + WS_WINT), scr, it, lane);
        else p0_transpose_item(w_out, MIXW, DM, (bf16*)(ws + WS_WOUTT), scr, it - I_IN, lane);
    }
    {
        const f32x4* gr = (const f32x4*)g_pre + lane; f32x4 gg[4];
#pragma unroll
        for (int j = 0; j < 4; ++j) gg[j] = gr[64 * j];
        bf16* XN = (bf16*)(ws + WS_XN);
        for (int m = gw; m < MTOK; m += NGW) {
            const f32x4* xr = (const f32x4*)(x + (size_t)m * DM) + lane; f32x4 v[4]; float s = 0.f;
#pragma unroll
            for (int j = 0; j < 4; ++j) { v[j] = xr[64 * j]; s += (v[j].x * v[j].x + v[j].y * v[j].y) + (v[j].z * v[j].z + v[j].w * v[j].w); }
            const float rstd = 1.0f / sqrtf(wave_sum(s) * (1.0f / DM) + RMS_EPS);
            u32x2* o8 = (u32x2*)(XN + (size_t)m * DM) + lane;
#pragma unroll
            for (int j = 0; j < 4; ++j) { u32x2 o; o.x = pk2(v[j].x * rstd * gg[j].x, v[j].y * rstd * gg[j].y); o.y = pk2(v[j].z * rstd * gg[j].z, v[j].w * rstd * gg[j].w); o8[64 * j] = o; }
        }
    }
    const int gt = bid * NTHR + tid, NGT = G * NTHR;
    float* biasd = (float*)(ws + WS_BIASD);
    for (int idx = gt; idx < NH * 2048; idx += NGT) { const int h = idx >> 11, d = idx & 2047; biasd[idx] = rel_bias[t5_bucket(d) * NH + h] * LOG2E; }
    if (gt < NH) { float m = -1e30f; for (int b = 0; b < 32; ++b) m = fmaxf(m, rel_bias[b * NH + gt] * LOG2E); ((float*)(ws + WS_KMAX + 4096))[gt] = m; }
    float* weff = (float*)(ws + WS_WEFF);
    for (int idx = gt; idx < 2 * 1024 * 8; idx += NGT) {
        const int which = idx >> 13, c = (idx >> 3) & 1023, g = idx & 7, n = c >> 2, i = c & 3; float s = 0.f;
        if (which == 0) { for (int o = 0; o < 4; ++o) s += wq[n * 16 + i * 4 + o] * w_if[(4 * n + o) * 8 + g] + wk[n * 16 + i * 4 + o] * w_if[(1024 + 4 * n + o) * 8 + g]; }
        else { for (int o = 0; o < 4; ++o) s += wv[n * 16 + i * 4 + o] * w_if[(2048 + 4 * n + o) * 8 + g]; }
        weff[idx] = s;
    }
}

DI void phase_kstat(const Args& a, LAS unsigned char* lds, int tid, int lane, int wave, int bid, int G) {
    const bf16* QK = (const bf16*)(a.ws + WS_QK); float* KMEAN = (float*)(a.ws + WS_KMEAN); float* KMAX = (float*)(a.ws + WS_KMAX);
    LAS float* red = (LAS float*)lds; LAS float* wmx = (LAS float*)(lds + 32 * 128 * 4);
    for (int u = bid; u < 32 * NBLK; u += G) {
        const int bh = u >> 5, blk = u & 31, b = bh >> 3, h = bh & 7;
        const bf16* Kb = QK + (size_t)(b * SEQ + blk * 256) * 2048 + 1024 + h * DH;
        const int rg = tid >> 4, ch = tid & 15;
        float cs[8]; float mx = 0.f;
#pragma unroll
        for (int e = 0; e < 8; ++e) cs[e] = 0.f;
#pragma unroll
        for (int rr = 0; rr < 8; ++rr) {
            const u32x4 v = *(const u32x4*)(Kb + (size_t)(rg * 8 + rr) * 2048 + ch * 8);
            const float f0 = bflo(v.x), f1 = bfhi(v.x), f2 = bflo(v.y), f3 = bfhi(v.y), f4 = bflo(v.z), f5 = bfhi(v.z), f6 = bflo(v.w), f7 = bfhi(v.w);
            cs[0] += f0; cs[1] += f1; cs[2] += f2; cs[3] += f3; cs[4] += f4; cs[5] += f5; cs[6] += f6; cs[7] += f7;
            float ss = (f0 * f0 + f1 * f1) + (f2 * f2 + f3 * f3) + (f4 * f4 + f5 * f5) + (f6 * f6 + f7 * f7);
            ss += __shfl_xor(ss, 1); ss += __shfl_xor(ss, 2); ss += __shfl_xor(ss, 4); ss += __shfl_xor(ss, 8);
            mx = fmaxf(mx, ss);
        }
#pragma unroll
        for (int e = 0; e < 8; ++e) red[rg * 128 + ch * 8 + e] = cs[e];
        mx = wave_max(mx); if (lane == 0) wmx[wave] = mx;
        __syncthreads();
        if (tid < 128) { float s = 0.f; for (int r = 0; r < 32; ++r) s += red[r * 128 + tid]; KMEAN[(size_t)(bh * 32 + blk) * 128 + tid] = s * (1.0f / 256.0f); }
        if (tid == 0) { float m = wmx[0]; for (int w = 1; w < 8; ++w) m = fmaxf(m, wmx[w]); KMAX[bh * 32 + blk] = m; }
        __syncthreads();
    }
}

DI void phase_sel(const Args& a, LAS unsigned char* lds, int tid, int lane, int wave, int bid, int G, int dry) {
    const bf16* QK = (const bf16*)(a.ws + WS_QK); const float* KMEAN = (const float*)(a.ws + WS_KMEAN); const float* KMAX = (const float*)(a.ws + WS_KMAX);
    const float* BMAX = (const float*)(a.ws + WS_KMAX + 4096);
    i32x4* SEL = (i32x4*)(a.ws + WS_SEL); unsigned* cnt = (unsigned*)(a.ws + WS_CTL) + CW_CNT + (dry ? 1024 : 0); unsigned* LIST = dry ? (unsigned*)a.out : (unsigned*)(a.ws + WS_LIST);
    LAS float* km = (LAS float*)lds; LAS float* misc = (LAS float*)(lds + 32 * 128 * 4);
    for (int u = bid; u < 32 * NBLK; u += G) {
        const int bh = u >> 5, i = u & 31, b = bh >> 3, h = bh & 7;
        for (int idx = tid; idx < i * 128; idx += NTHR) km[idx] = KMEAN[(size_t)bh * 32 * 128 + idx];
        if (tid < 64) { float v = tid < 32 ? KMAX[bh * 32 + tid] : 0.f; v = wave_max(v); if (tid == 0) misc[0] = sqrtf(v); }
        __syncthreads();
        const float kmaxn = misc[0];
        const int q = tid >> 1, half = tid & 1; const int row = b * SEQ + i * 256 + q;
        const bf16* qp = QK + (size_t)row * 2048 + h * DH + half * 64;
        float qv[64];
#pragma unroll
        for (int c = 0; c < 8; ++c) { const u32x4 v = *(const u32x4*)(qp + c * 8);
            qv[c * 8 + 0] = bflo(v.x); qv[c * 8 + 1] = bfhi(v.x); qv[c * 8 + 2] = bflo(v.y); qv[c * 8 + 3] = bfhi(v.y);
            qv[c * 8 + 4] = bflo(v.z); qv[c * 8 + 5] = bfhi(v.z); qv[c * 8 + 6] = bflo(v.w); qv[c * 8 + 7] = bfhi(v.w); }
        float qn2 = 0.f;
#pragma unroll
        for (int d = 0; d < 64; ++d) qn2 += qv[d] * qv[d];
        qn2 += __shfl_xor(qn2, 1);
        float v0 = -INFINITY, v1 = -INFINITY, v2 = -INFINITY; int i0 = -1, i1 = -1, i2 = -1;
        for (int j = 0; j < i; ++j) {
            const LAS float* kr = km + j * 128 + half * 64; float dot = 0.f;
#pragma unroll
            for (int d = 0; d < 64; d += 4) { const f32x4 kk = *(const LAS f32x4*)(kr + d); dot += qv[d] * kk.x + qv[d + 1] * kk.y + qv[d + 2] * kk.z + qv[d + 3] * kk.w; }
            dot += __shfl_xor(dot, 1);
            if (dot > v0) { v2 = v1; i2 = i1; v1 = v0; i1 = i0; v0 = dot; i0 = j; }
            else if (dot > v1) { v2 = v1; i2 = i1; v1 = dot; i1 = j; }
            else if (dot > v2) { v2 = dot; i2 = j; }
        }
        const float shift = sqrtf(qn2) * kmaxn + BMAX[h];
        LAS int* lcnt = (LAS int*)(lds + 32 * 128 * 4 + 256);
        if (tid < 32) lcnt[tid] = 0;
        __syncthreads();
        int p0 = 0, p1 = 0, p2 = 0;
        if (half == 0) {
            i32x4 s4; s4.x = i0; s4.y = i1; s4.z = i2; s4.w = __float_as_int(shift);
            SEL[(size_t)row * 8 + h] = s4;
            if (i0 >= 0) p0 = __hip_atomic_fetch_add(lcnt + i0, 1, __ATOMIC_RELAXED, __HIP_MEMORY_SCOPE_WORKGROUP);
            if (i1 >= 0) p1 = __hip_atomic_fetch_add(lcnt + i1, 1, __ATOMIC_RELAXED, __HIP_MEMORY_SCOPE_WORKGROUP);
            if (i2 >= 0) p2 = __hip_atomic_fetch_add(lcnt + i2, 1, __ATOMIC_RELAXED, __HIP_MEMORY_SCOPE_WORKGROUP);
        }
        __syncthreads();
        if (tid < i) { const int c = lcnt[tid]; int base = 0; if (c > 0) base = (int)atomicAdd(&cnt[bh * 32 + tid], (unsigned)c); lcnt[tid] = base; }
        __syncthreads();
        if (half == 0) {
            const unsigned qpos = (unsigned)(i * 256 + q);
            if (i0 >= 0) LIST[(size_t)bh * LISTSZ + list_off(i0) + lcnt[i0] + p0] = qpos | (0u << 16);
            if (i1 >= 0) LIST[(size_t)bh * LISTSZ + list_off(i1) + lcnt[i1] + p1] = qpos | (1u << 16);
            if (i2 >= 0) LIST[(size_t)bh * LISTSZ + list_off(i2) + lcnt[i2] + p2] = qpos | (2u << 16);
        }
        __syncthreads();
    }
}

constexpr int ATT_KIMG = 0, ATT_KROW = 272, ATT_VIMG = 69632, ATT_VROW = 320, ATT_BIASD = 151552, ATT_NBIAS = 1536, ATT_PREF = 157696, ATT_LST = 161792, ATT_MISC = 162816;
typedef short v4i16_t __attribute__((ext_vector_type(4)));
DI s16x4 lds_tr16(const LAS unsigned char* p) { return __builtin_bit_cast(s16x4, __builtin_amdgcn_ds_read_tr16_b64_v4i16((LAS v4i16_t*)p)); }
DI void att_fill_kv(LAS unsigned char* lds, const bf16* Kg, const bf16* Vg, int tid, int lane, int wave) {
#pragma unroll
    for (int it = 0; it < 8; ++it) { const int p = it * NTHR + tid, key = p >> 4, ch = p & 15;
        const u32x4 v = *(const u32x4*)(Kg + (size_t)key * 2048 + ch * 8); *(LAS u32x4*)(lds + ATT_KIMG + key * ATT_KROW + ch * 16) = v; }
#pragma unroll
    for (int it = 0; it < 8; ++it) { const int p = it * NTHR + tid, key = p >> 4, ch = p & 15;
        const u32x4 v = *(const u32x4*)(Vg + (size_t)key * 1024 + ch * 8); *(LAS u32x4*)(lds + ATT_VIMG + key * ATT_VROW + ch * 16) = v; }
}
template <bool OWN>
DI void att_tile(LAS unsigned char* lds, const bf16x8 (&qf)[8], int qpos, float shift, int kbase, int kt_end, int wdiag, bool far, float b31,
                 f32x16 (&o)[4], float& lsum, int r, int hf) {
    const LAS float* biasd = (const LAS float*)(lds + ATT_BIASD);
    const int lane16 = (r & 15), grp = (r >> 4);
    for (int kt = 0; kt < kt_end; ++kt) {
        f32x16 x;
#pragma unroll
        for (int i = 0; i < 16; ++i) x[i] = 0.f;
#pragma unroll
        for (int ks = 0; ks < 8; ++ks) { const bf16x8 kf = *(const LAS bf16x8*)(lds + ATT_KIMG + (32 * kt + r) * ATT_KROW + ks * 32 + hf * 16); x = MFMA32(kf, qf[ks], x); }
        if (far) {
#pragma unroll
            for (int i = 0; i < 16; ++i) { const float p = __builtin_amdgcn_exp2f(x[i] + (b31 - shift)); lsum += p; x[i] = p; }
        } else {
#pragma unroll
            for (int i = 0; i < 16; ++i) { const int key = 32 * kt + crow(i, hf); int dist = qpos - (kbase + key); dist = dist < 0 ? 0 : (dist > ATT_NBIAS - 1 ? ATT_NBIAS - 1 : dist);
                float p = __builtin_amdgcn_exp2f(x[i] + biasd[dist] - shift);
                if (OWN) { if (kt == wdiag && crow(i, hf) > r) p = 0.f; }
                lsum += p; x[i] = p; }
        }
        const bf16x8 pa0 = pack_lo(x), pa1 = pack_hi(x);
        const LAS unsigned char* vb = lds + ATT_VIMG + (32 * kt + 4 * hf + ((lane16 >> 2))) * ATT_VROW + (16 * grp + 4 * (lane16 & 3)) * 2;
#pragma unroll
        for (int dt = 0; dt < 4; ++dt) {
            const s16x4 l0 = lds_tr16(vb + dt * 64), h0 = lds_tr16(vb + dt * 64 + 8 * ATT_VROW), l1 = lds_tr16(vb + dt * 64 + 16 * ATT_VROW), h1 = lds_tr16(vb + dt * 64 + 24 * ATT_VROW);
            const bf16x8 vf0 = __builtin_shufflevector(l0, h0, 0, 1, 2, 3, 4, 5, 6, 7), vf1 = __builtin_shufflevector(l1, h1, 0, 1, 2, 3, 4, 5, 6, 7);
            o[dt] = MFMA32(pa0, vf0, o[dt]); o[dt] = MFMA32(pa1, vf1, o[dt]);
        }
    }
}
DI void att_load_biasd(const Args& a, LAS unsigned char* lds, int h, int tid) {
    const float* biasd = (const float*)(a.ws + WS_BIASD) + h * 2048; LAS float* dst = (LAS float*)(lds + ATT_BIASD);
    for (int i = tid; i < ATT_NBIAS; i += NTHR) dst[i] = biasd[i];
}
DI bf16* opart_base(const Args& a, int slot) { return slot == 0 ? (bf16*)a.out : (slot == 1 ? (bf16*)((unsigned char*)a.out + 64 * MiB) : (bf16*)(a.ws + WS_XN)); }

DI void phase_att_gather(const Args& a, LAS unsigned char* lds, int tid, int lane, int wave, int bid, int G) {
    const bf16* QK = (const bf16*)(a.ws + WS_QK); const bf16* Vb = (const bf16*)(a.ws + WS_V);
    const i32x4* SEL = (const i32x4*)(a.ws + WS_SEL); const unsigned* cnt = (const unsigned*)(a.ws + WS_CTL) + CW_CNT; const unsigned* LIST = (const unsigned*)(a.ws + WS_LIST);
    float* LPART = (float*)(a.ws + WS_LPART);
    LAS int* pref = (LAS int*)(lds + ATT_PREF);
    if (tid < 64) {
        int nu[16]; int s = 0;
#pragma unroll
        for (int k = 0; k < 16; ++k) { const int l = tid * 16 + k; int n = 0; if (l < 992) { const int bh = l / 31, j = l % 31; n = (int)((cnt[bh * 32 + j] + 255u) >> 8); } nu[k] = n; s += n; }
        int incl = s;
#pragma unroll
        for (int o = 1; o < 64; o <<= 1) { const int t = __shfl_up(incl, o); if (lane >= o) incl += t; }
        int run = incl - s;
#pragma unroll
        for (int k = 0; k < 16; ++k) { const int l = tid * 16 + k; if (l <= 992) pref[l] = run; run += nu[k]; }
    }
    __syncthreads();
    const int U = pref[992];
    const int r = lane & 31, hf = lane >> 5;
    int cur_h = -1;
    for (int u = bid; u < U; u += G) {
        int lo = 0, hi = 992;
        while (hi - lo > 1) { const int mid = (lo + hi) >> 1; if (pref[mid] <= u) lo = mid; else hi = mid; }
        const int l = lo, bh = l / 31, j = l % 31, chunk = u - pref[l], b = bh >> 3, h = bh & 7;
        const int n = (int)cnt[bh * 32 + j]; const int nrows = min(256, n - chunk * 256);
        if (h != cur_h) { att_load_biasd(a, lds, h, tid); cur_h = h; }
        att_fill_kv(lds, QK + (size_t)(b * SEQ + j * 256) * 2048 + 1024 + h * DH, Vb + (size_t)(b * SEQ + j * 256) * 1024 + h * DH, tid, lane, wave);
        __syncthreads();
        const int nv = min(32, max(0, nrows - 32 * wave));
        const unsigned* lp = LIST + (size_t)bh * LISTSZ + list_off(j) + chunk * 256 + 32 * wave;
        unsigned ent = 0; f32x16 o[4]; float lsum = 0.f;
#pragma unroll
        for (int dt = 0; dt < 4; ++dt)
#pragma unroll
            for (int i = 0; i < 16; ++i) o[dt][i] = 0.f;
        if (nv > 0) {
            ent = lp[r < nv ? r : 0];
            const int qpos = (int)(ent & 0xffffu); const size_t row = (size_t)b * SEQ + qpos;
            const float shift = __int_as_float(SEL[row * 8 + h].w);
            bf16x8 qf[8];
#pragma unroll
            for (int ks = 0; ks < 8; ++ks) qf[ks] = *(const bf16x8*)(QK + row * 2048 + h * DH + ks * 16 + hf * 8);
            const bool far = __all(qpos - (j * 256 + 255) >= 1513);
            const float b31 = *(const LAS float*)(lds + ATT_BIASD + (ATT_NBIAS - 1) * 4);
            att_tile<false>(lds, qf, qpos, shift, j * 256, 8, -1, far, b31, o, lsum, r, hf);
            lsum += __shfl_xor(lsum, 32);
        }
        __syncthreads();
        if (nv > 0) {
            LAS unsigned char* stg = lds + wave * 8192;
#pragma unroll
            for (int dt = 0; dt < 4; ++dt)
#pragma unroll
                for (int i = 0; i < 16; ++i) *(LAS unsigned short*)(stg + crow(i, hf) * 256 + (32 * dt + r) * 2) = (unsigned short)f2bf(o[dt][i]);
#pragma unroll
            for (int it = 0; it < 8; ++it) { const int item = it * 64 + lane, rho = item >> 4, ch = item & 15;
                const unsigned e2 = (unsigned)__shfl((int)ent, rho); const int q2 = (int)(e2 & 0xffffu), slot2 = (int)(e2 >> 16);
                const u32x4 v = *(const LAS u32x4*)(stg + rho * 256 + ch * 16);
                if (rho < nv) *(u32x4*)(opart_base(a, slot2) + (((size_t)b * SEQ + q2) * 8 + h) * 128 + ch * 8) = v; }
            if (hf == 0 && r < nv) { const int q1 = (int)(ent & 0xffffu), slot1 = (int)(ent >> 16); LPART[(size_t)slot1 * MTOK * 8 + ((size_t)b * SEQ + q1) * 8 + h] = lsum; }
        }
        __syncthreads();
    }
}

DI void phase_att_own(const Args& a, LAS unsigned char* lds, int tid, int lane, int wave, int bid, int G, int dry) {
    bf16* QK = (bf16*)(a.ws + WS_QK); const bf16* Vb = (const bf16*)(a.ws + WS_V); const bf16* Gb = (const bf16*)(a.ws + WS_G);
    const i32x4* SEL = (const i32x4*)(a.ws + WS_SEL); const float* LPART = (const float*)(a.ws + WS_LPART);
    const int r = lane & 31, hf = lane >> 5;
    int cur_h = -1;
    for (int u = bid; u < 32 * NBLK; u += G) {
        const int bh = u >> 5, i = u & 31, b = bh >> 3, h = bh & 7;
        if (h != cur_h) { att_load_biasd(a, lds, h, tid); cur_h = h; }
        att_fill_kv(lds, QK + (size_t)(b * SEQ + i * 256) * 2048 + 1024 + h * DH, Vb + (size_t)(b * SEQ + i * 256) * 1024 + h * DH, tid, lane, wave);
        __syncthreads();
        const int qpos = i * 256 + 32 * wave + r; const size_t row = (size_t)b * SEQ + qpos;
        const float shift = __int_as_float(SEL[row * 8 + h].w);
        bf16x8 qf[8];
#pragma unroll
        for (int ks = 0; ks < 8; ++ks) qf[ks] = *(const bf16x8*)(QK + row * 2048 + h * DH + ks * 16 + hf * 8);
        f32x16 o[4]; float lsum = 0.f;
#pragma unroll
        for (int dt = 0; dt < 4; ++dt)
#pragma unroll
            for (int k = 0; k < 16; ++k) o[dt][k] = 0.f;
        att_tile<true>(lds, qf, qpos, shift, i * 256, wave + 1, wave, false, 0.f, o, lsum, r, hf);
        lsum += __shfl_xor(lsum, 32);
        __syncthreads();
        LAS unsigned char* stg = lds + wave * 16384;
        LAS float* lst = (LAS float*)(lds + ATT_LST) + wave * 32;
#pragma unroll
        for (int dt = 0; dt < 4; ++dt)
#pragma unroll
            for (int k = 0; k < 16; ++k) *(LAS float*)(stg + crow(k, hf) * 512 + (32 * dt + r) * 4) = o[dt][k];
        if (hf == 0) lst[r] = lsum;
#pragma unroll
        for (int bt = 0; bt < 2; ++bt) {
            i32x4 s4[4]; u32x4 pv[4][3], gv[4]; float lp[4][3];
#pragma unroll
            for (int k4 = 0; k4 < 4; ++k4) { const int item = (bt * 4 + k4) * 64 + lane, rho = item >> 4; const size_t row2 = (size_t)b * SEQ + i * 256 + 32 * wave + rho; s4[k4] = SEL[row2 * 8 + h]; }
#pragma unroll
            for (int k4 = 0; k4 < 4; ++k4) { const int item = (bt * 4 + k4) * 64 + lane, rho = item >> 4, ch = item & 15; const size_t row2 = (size_t)b * SEQ + i * 256 + 32 * wave + rho;
                gv[k4] = *(const u32x4*)(Gb + row2 * 1024 + h * DH + ch * 8);
#pragma unroll
                for (int k = 0; k < 3; ++k) { pv[k4][k] = *(const u32x4*)(opart_base(a, k) + (row2 * 8 + h) * 128 + ch * 8); lp[k4][k] = LPART[(size_t)k * MTOK * 8 + row2 * 8 + h]; } }
#pragma unroll
            for (int k4 = 0; k4 < 4; ++k4) { const int item = (bt * 4 + k4) * 64 + lane, rho = item >> 4, ch = item & 15; const size_t row2 = (size_t)b * SEQ + i * 256 + 32 * wave + rho;
                const f32x4 a0 = *(const LAS f32x4*)(stg + rho * 512 + ch * 32), a1 = *(const LAS f32x4*)(stg + rho * 512 + ch * 32 + 16);
                float acc[8] = {a0.x, a0.y, a0.z, a0.w, a1.x, a1.y, a1.z, a1.w};
                float l = lst[rho];
#pragma unroll
                for (int k = 0; k < 3; ++k) { const int sk = (k == 0) ? s4[k4].x : (k == 1 ? s4[k4].y : s4[k4].z); const float msk = sk >= 0 ? 1.0f : 0.0f; const u32x4 p = pv[k4][k];
                    if (sk >= 0) { acc[0] += bflo(p.x); acc[1] += bfhi(p.x); acc[2] += bflo(p.y); acc[3] += bfhi(p.y); acc[4] += bflo(p.z); acc[5] += bfhi(p.z); acc[6] += bflo(p.w); acc[7] += bfhi(p.w); l += lp[k4][k]; } (void)msk; }
                const u32x4 g4 = gv[k4];
                const float rl = 1.0f / l;
                u32x4 ov; ov.x = pk2(acc[0] * rl * silu_f(bflo(g4.x)), acc[1] * rl * silu_f(bfhi(g4.x))); ov.y = pk2(acc[2] * rl * silu_f(bflo(g4.y)), acc[3] * rl * silu_f(bfhi(g4.y)));
                ov.z = pk2(acc[4] * rl * silu_f(bflo(g4.z)), acc[5] * rl * silu_f(bfhi(g4.z))); ov.w = pk2(acc[6] * rl * silu_f(bflo(g4.w)), acc[7] * rl * silu_f(bfhi(g4.w)));
                if (!dry) *(u32x4*)(QK + row2 * 2048 + h * DH + ch * 8) = ov; else asm volatile("" :: "v"(ov)); }
        }
        __syncthreads();
    }
}

DI void phase_mpre(const Args& a, LAS unsigned char* lds, int tid, int lane, int wave, int bid, int G) {
    const float* conv_w = a.in[5]; const float* conv_b = a.in[6]; const float* wq = a.in[7]; const float* wk = a.in[8]; const float* wv = a.in[9]; const float* b_if = a.in[11];
    const float* weff = (const float*)(a.ws + WS_WEFF);
    const bf16* XM = (const bf16*)(a.ws + WS_XM);
    bf16* QM = (bf16*)a.out; bf16* KM = (bf16*)((unsigned char*)a.out + 64 * MiB); bf16* VM = (bf16*)(a.ws + WS_XN); bf16* XC = (bf16*)(a.ws + WS_G);
    float* GLI = (float*)(a.ws + WS_GLI); float* GLF = (float*)(a.ws + WS_GLF);
    LAS float* red = (LAS float*)lds;
    const int tk = tid >> 8, n = tid & 255;
    float cw[4][4], cb[4], fq[16], fk[16], fv[16], wc[4][8], wm[4][8];
#pragma unroll
    for (int w = 0; w < 4; ++w) { const f32x4 t = *(const f32x4*)(conv_w + w * 1024 + 4 * n); cw[w][0] = t.x; cw[w][1] = t.y; cw[w][2] = t.z; cw[w][3] = t.w; }
    { const f32x4 t = *(const f32x4*)(conv_b + 4 * n); cb[0] = t.x; cb[1] = t.y; cb[2] = t.z; cb[3] = t.w; }
#pragma unroll
    for (int k = 0; k < 16; ++k) { fq[k] = wq[n * 16 + k]; fk[k] = wk[n * 16 + k] * 0.0625f; fv[k] = wv[n * 16 + k]; }
#pragma unroll
    for (int i = 0; i < 4; ++i)
#pragma unroll
        for (int g = 0; g < 8; ++g) { wc[i][g] = weff[(4 * n + i) * 8 + g]; wm[i][g] = weff[8192 + (4 * n + i) * 8 + g]; }
    for (int blk = bid; blk < MTOK / 16; blk += G) {
        const int mb = 16 * blk + 8 * tk, s0 = mb & (SEQ - 1);
        u32x2 win[11];
#pragma unroll
        for (int j = 0; j < 11; ++j) { u32x2 v; v.x = 0u; v.y = 0u; if (s0 - 3 + j >= 0) v = *(const u32x2*)(XM + (size_t)(mb - 3 + j) * 1024 + 4 * n); win[j] = v; }
#pragma unroll
        for (int k = 0; k < 8; ++k) {
            float xc[4], xm[4];
            xm[0] = bflo(win[k + 3].x); xm[1] = bfhi(win[k + 3].x); xm[2] = bflo(win[k + 3].y); xm[3] = bfhi(win[k + 3].y);
            { float y0 = cb[0], y1 = cb[1], y2 = cb[2], y3 = cb[3];
#pragma unroll
              for (int w = 0; w < 4; ++w) { y0 += bflo(win[k + w].x) * cw[w][0]; y1 += bfhi(win[k + w].x) * cw[w][1]; y2 += bflo(win[k + w].y) * cw[w][2]; y3 += bfhi(win[k + w].y) * cw[w][3]; }
              xc[0] = silu_f(y0); xc[1] = silu_f(y1); xc[2] = silu_f(y2); xc[3] = silu_f(y3); }
            float qo[4], ko[4], vo[4];
#pragma unroll
            for (int o = 0; o < 4; ++o) { float sq = 0.f, sk = 0.f, sv = 0.f;
#pragma unroll
                for (int i = 0; i < 4; ++i) { sq += xc[i] * fq[i * 4 + o]; sk += xc[i] * fk[i * 4 + o]; sv += xm[i] * fv[i * 4 + o]; }
                qo[o] = sq; ko[o] = sk; vo[o] = sv; }
            const size_t off = (size_t)(mb + k) * 1024 + 4 * n;
            { u32x2 o; o.x = pk2(qo[0], qo[1]); o.y = pk2(qo[2], qo[3]); *(u32x2*)(QM + off) = o; }
            { u32x2 o; o.x = pk2(ko[0], ko[1]); o.y = pk2(ko[2], ko[3]); *(u32x2*)(KM + off) = o; }
            { u32x2 o; o.x = pk2(vo[0], vo[1]); o.y = pk2(vo[2], vo[3]); *(u32x2*)(VM + off) = o; }
            { u32x2 o; o.x = pk2(xc[0], xc[1]); o.y = pk2(xc[2], xc[3]); *(u32x2*)(XC + off) = o; }
#pragma unroll
            for (int g = 0; g < 8; ++g) { float sg = 0.f;
#pragma unroll
                for (int i = 0; i < 4; ++i) sg += xc[i] * wc[i][g] + xm[i] * wm[i][g];
                red[((8 * tk + k) * 8 + g) * 256 + n] = sg; }
        }
        __syncthreads();
#pragma unroll 4
        for (int rr = 0; rr < 16; ++rr) { const int row = wave * 16 + rr;
            const f32x4 v = *(const LAS f32x4*)(red + row * 256 + lane * 4); float s = (v.x + v.y) + (v.z + v.w); s = wave_sum(s);
            if (lane == 0) { const int tok = row >> 3, g = row & 7; const int m2 = 16 * blk + tok, s2 = m2 & (SEQ - 1), b2 = m2 >> 13; const float gate = s + b_if[g];
                if (g < 4) GLI[(size_t)(b2 * 4 + g) * SEQ + s2] = gate;
                else GLF[(size_t)(b2 * 4 + g - 4) * SEQ + s2] = fminf(gate, 0.f) - log1pf(__expf(-fabsf(gate))); } }
        __syncthreads();
    }
}

constexpr int MC_QI = 0, MC_QROW = 528, MC_KI = 33792, MC_KT = 67584, MC_TROW = 144, MC_VT = 104448, MC_P = 141312, MC_SC = 150528, MC_NV = 153600, MC_MISC = 154624;
constexpr int MC_STROW = 1040;
DI LAS float* mc_sc(LAS unsigned char* lds, int k) { return (LAS float*)(lds + MC_SC + k * 256); }

DI void phase_mstate(const Args& a, LAS unsigned char* lds, int tid, int lane0, int wave, int bid, int G) {
    const bf16* KM = (const bf16*)((unsigned char*)a.out + 64 * MiB); const bf16* VM = (const bf16*)(a.ws + WS_XN);
    const float* GLI = (const float*)(a.ws + WS_GLI); const float* GLF = (const float*)(a.ws + WS_GLF);
    float* CST = (float*)(a.ws + WS_CST); float* NST = (float*)(a.ws + WS_NST); float* PST = (float*)(a.ws + WS_PST); float* MIN = (float*)(a.ws + WS_MIN);
    LAS float* nvec = (LAS float*)(lds + MC_NV); LAS float* misc = (LAS float*)(lds + MC_MISC);
    LAS float* aggb = (LAS float*)(lds + MC_QI); LAS float* agga = aggb + 128; LAS float* marr = aggb + 256;
#define OPQ(name) int name = tid; asm volatile("" : "+v"(name))
    for (int u = bid; u < BATCH * MH * NSC; u += G) {
        const int bh = u >> 4, sc = u & 15, b = bh >> 2, hd = bh & 3; const int c0 = sc * SCCH, c1 = c0 + SCCH;
        { OPQ(tA); const int laneA = tA & 63;
            for (int c = wave; c < c1; c += NWAVES) {
                const float lf = GLF[(size_t)bh * SEQ + c * LCH + laneA], li = GLI[(size_t)bh * SEQ + c * LCH + laneA];
                float bc = lf;
#pragma unroll
                for (int o = 1; o < 64; o <<= 1) { const float t = __shfl_up(bc, o); if (laneA >= o) bc += t; }
                const float am = wave_max(li - bc); const float bL = __shfl(bc, 63);
                if (laneA == 0) { aggb[c] = bL; agga[c] = am; }
            }
        }
        __syncthreads();
        if (tid == 0) { float m = 0.f; for (int c = 0; c < c1; ++c) { marr[c] = m; m = aggb[c] + fmaxf(m, agga[c]); } }
        __syncthreads();
        if (tid < SCCH) MIN[bh * NCH + c0 + tid] = marr[c0 + tid];
        f32x16 C[8];
#pragma unroll
        for (int dt = 0; dt < 8; ++dt)
#pragma unroll
            for (int i = 0; i < 16; ++i) C[dt][i] = 0.f;
        if (tid < 256) nvec[tid] = 0.f;
        float pprod = 1.f;
        for (int c = c0; c < c1; ++c) {
            const size_t rowbase = (size_t)b * SEQ + (size_t)c * LCH;
            { OPQ(tB); const int laneB = tB & 63;
#pragma unroll
            for (int cc = 0; cc < 4; ++cc) { const int c8 = wave + 8 * cc;
                const u32x4 vk = *(const u32x4*)(KM + (rowbase + laneB) * 1024 + hd * MD + c8 * 8); const u32x4 vv = *(const u32x4*)(VM + (rowbase + laneB) * 1024 + hd * MD + c8 * 8);
                LAS unsigned short* dk = (LAS unsigned short*)(lds + MC_KT + (c8 * 8) * MC_TROW + laneB * 2); LAS unsigned short* dv = (LAS unsigned short*)(lds + MC_VT + (c8 * 8) * MC_TROW + laneB * 2);
                dk[0 * 72] = (unsigned short)(vk.x & 0xffffu); dk[1 * 72] = (unsigned short)(vk.x >> 16); dk[2 * 72] = (unsigned short)(vk.y & 0xffffu); dk[3 * 72] = (unsigned short)(vk.y >> 16);
                dk[4 * 72] = (unsigned short)(vk.z & 0xffffu); dk[5 * 72] = (unsigned short)(vk.z >> 16); dk[6 * 72] = (unsigned short)(vk.w & 0xffffu); dk[7 * 72] = (unsigned short)(vk.w >> 16);
                dv[0 * 72] = (unsigned short)(vv.x & 0xffffu); dv[1 * 72] = (unsigned short)(vv.x >> 16); dv[2 * 72] = (unsigned short)(vv.y & 0xffffu); dv[3 * 72] = (unsigned short)(vv.y >> 16);
                dv[4 * 72] = (unsigned short)(vv.z & 0xffffu); dv[5 * 72] = (unsigned short)(vv.z >> 16); dv[6 * 72] = (unsigned short)(vv.w & 0xffffu); dv[7 * 72] = (unsigned short)(vv.w >> 16); }
            if (wave == 0) {
                const float lf = GLF[(size_t)bh * SEQ + c * LCH + laneB], li = GLI[(size_t)bh * SEQ + c * LCH + laneB];
                float bc = lf;
#pragma unroll
                for (int o = 1; o < 64; o <<= 1) { const float t = __shfl_up(bc, o); if (laneB >= o) bc += t; }
                const float av = li - bc; const float mi = marr[c]; const float Gc = fmaxf(mi, wave_max(av));
                mc_sc(lds, 3)[laneB] = __expf(av - Gc);
                if (laneB == 0) misc[0] = __expf(mi - Gc);
            } }
            __syncthreads();
            const float cd = misc[0]; pprod *= cd;
            { OPQ(tC); const int laneC = tC & 63, r = laneC & 31, hf = laneC >> 5;
            bf16x8 vt[4];
            const LAS unsigned char* vbase = lds + MC_VT + (32 * wave + r) * MC_TROW + hf * 16;
#pragma unroll
            for (int ks = 0; ks < 4; ++ks) { vt[ks] = *(const LAS bf16x8*)(vbase + ks * 32);
                const f32x4 w0 = *(const LAS f32x4*)(mc_sc(lds, 3) + 16 * ks + 8 * hf), w1 = *(const LAS f32x4*)(mc_sc(lds, 3) + 16 * ks + 8 * hf + 4);
                const u32x4 vv = __builtin_bit_cast(u32x4, vt[ks]); u32x4 o;
                o.x = pk2(bflo(vv.x) * w0.x, bfhi(vv.x) * w0.y); o.y = pk2(bflo(vv.y) * w0.z, bfhi(vv.y) * w0.w); o.z = pk2(bflo(vv.z) * w1.x, bfhi(vv.z) * w1.y); o.w = pk2(bflo(vv.w) * w1.z, bfhi(vv.w) * w1.w);
                vt[ks] = __builtin_bit_cast(bf16x8, o); }
            const LAS unsigned char* kbase = lds + MC_KT + r * MC_TROW + hf * 16;
#pragma unroll
            for (int dt = 0; dt < 8; ++dt) {
#pragma unroll
                for (int i = 0; i < 16; ++i) C[dt][i] *= cd;
#pragma unroll
                for (int ks = 0; ks < 4; ++ks) { const bf16x8 kA = *(const LAS bf16x8*)(kbase + dt * 32 * MC_TROW + ks * 32); C[dt] = MFMA32(kA, vt[ks], C[dt]); } }
            if (tC < 256) { float sacc = cd * nvec[tC];
#pragma unroll
                for (int k = 0; k < 8; ++k) { const u32x4 kv = *(const LAS u32x4*)(lds + MC_KT + tC * MC_TROW + k * 16);
                    const f32x4 w0 = *(const LAS f32x4*)(mc_sc(lds, 3) + k * 8), w1 = *(const LAS f32x4*)(mc_sc(lds, 3) + k * 8 + 4);
                    sacc += bflo(kv.x) * w0.x + bfhi(kv.x) * w0.y + bflo(kv.y) * w0.z + bfhi(kv.y) * w0.w + bflo(kv.z) * w1.x + bfhi(kv.z) * w1.y + bflo(kv.w) * w1.z + bfhi(kv.w) * w1.w; }
                nvec[tC] = sacc; }
            }
            __syncthreads();
        }
        { OPQ(tD); const int laneD = tD & 63, r = laneD & 31, hf = laneD >> 5;
            float* cs = CST + (size_t)u * 65536 + 32 * wave + r;
#pragma unroll
            for (int dt = 0; dt < 8; ++dt)
#pragma unroll
                for (int i = 0; i < 16; ++i) cs[(32 * dt + crow(i, hf)) * 256] = C[dt][i];
            if (tD < 256) NST[u * 256 + tD] = nvec[tD];
            if (tD == 0) PST[u] = pprod;
        }
        __syncthreads();
    }
#undef OPQ
}
DI void phase_mcomb(const Args& a, int tid, int bid, int G, int dry) {
    float* CST = (float*)(a.ws + WS_CST); float* NST = (float*)(a.ws + WS_NST); const float* PST = (const float*)(a.ws + WS_PST);
    const int gt = bid * NTHR + tid, NGT = G * NTHR;
    for (int idx = gt; idx < BATCH * MH * 65536; idx += NGT) { const int bh = idx >> 16, e = idx & 65535; float run = 0.f;
#pragma unroll 4
        for (int sc = 0; sc < NSC; ++sc) { float* p = CST + (size_t)(bh * NSC + sc) * 65536 + e; const float tmp = *p; if (!dry) *p = run; else asm volatile("" :: "v"(run)); run = PST[bh * NSC + sc] * run + tmp; } }
    for (int idx = gt; idx < BATCH * MH * 256; idx += NGT) { const int bh = idx >> 8, e = idx & 255; float run = 0.f;
        for (int sc = 0; sc < NSC; ++sc) { float* p = NST + (size_t)(bh * NSC + sc) * 256 + e; const float tmp = *p; if (!dry) *p = run; else asm volatile("" :: "v"(run)); run = PST[bh * NSC + sc] * run + tmp; } }
}
DI void phase_mscan(const Args& a, LAS unsigned char* lds, int tid, int lane0, int wave, int bid, int G) {
    const bf16* QM = (const bf16*)a.out; const bf16* KM = (const bf16*)((unsigned char*)a.out + 64 * MiB); const bf16* VM = (const bf16*)(a.ws + WS_XN); const bf16* XC = (const bf16*)(a.ws + WS_G);
    const bf16* ZM = (const bf16*)(a.ws + WS_ZM); bf16* QK = (bf16*)(a.ws + WS_QK);
    const float* GLI = (const float*)(a.ws + WS_GLI); const float* GLF = (const float*)(a.ws + WS_GLF);
    const float* mh_norm = a.in[12]; const float* skip = a.in[13];
    LAS float* nvec = (LAS float*)(lds + MC_NV); LAS float* misc = (LAS float*)(lds + MC_MISC);
#define OPQ(name) int name = tid; asm volatile("" : "+v"(name))
    const float* CST = (const float*)(a.ws + WS_CST); const float* NST = (const float*)(a.ws + WS_NST); const float* MIN = (const float*)(a.ws + WS_MIN);
    for (int u = bid; u < BATCH * MH * NSC; u += G) {
        const int bh = u >> 4, sc = u & 15, b = bh >> 2, hd = bh & 3;
        f32x16 C[8];
        { OPQ(t0); const int lane_ = t0 & 63, r = lane_ & 31, hf = lane_ >> 5;
            const float* cs = CST + (size_t)u * 65536 + 32 * wave + r;
#pragma unroll
            for (int dt = 0; dt < 8; ++dt)
#pragma unroll
                for (int i = 0; i < 16; ++i) C[dt][i] = cs[(32 * dt + crow(i, hf)) * 256];
            if (t0 < 256) nvec[t0] = NST[u * 256 + t0];
        }
        float mrun = MIN[bh * NCH + sc * SCCH];
        for (int c = sc * SCCH; c < (sc + 1) * SCCH; ++c) {
            const size_t rowbase = (size_t)b * SEQ + (size_t)c * LCH;
            { OPQ(tA); const int laneA = tA & 63;
#pragma unroll
            for (int it = 0; it < 4; ++it) { const int p = it * NTHR + tA, t = p >> 5, ch = p & 31;
                const u32x4 vq = *(const u32x4*)(QM + (rowbase + t) * 1024 + hd * MD + ch * 8); const u32x4 vk = *(const u32x4*)(KM + (rowbase + t) * 1024 + hd * MD + ch * 8);
                *(LAS u32x4*)(lds + MC_QI + t * MC_QROW + ch * 16) = vq; *(LAS u32x4*)(lds + MC_KI + t * MC_QROW + ch * 16) = vk; }
#pragma unroll
            for (int cc = 0; cc < 4; ++cc) { const int c8 = wave + 8 * cc;
                const u32x4 vk = *(const u32x4*)(KM + (rowbase + laneA) * 1024 + hd * MD + c8 * 8); const u32x4 vv = *(const u32x4*)(VM + (rowbase + laneA) * 1024 + hd * MD + c8 * 8);
                LAS unsigned short* dk = (LAS unsigned short*)(lds + MC_KT + (c8 * 8) * MC_TROW + laneA * 2); LAS unsigned short* dv = (LAS unsigned short*)(lds + MC_VT + (c8 * 8) * MC_TROW + laneA * 2);
                dk[0 * 72] = (unsigned short)(vk.x & 0xffffu); dk[1 * 72] = (unsigned short)(vk.x >> 16); dk[2 * 72] = (unsigned short)(vk.y & 0xffffu); dk[3 * 72] = (unsigned short)(vk.y >> 16);
                dk[4 * 72] = (unsigned short)(vk.z & 0xffffu); dk[5 * 72] = (unsigned short)(vk.z >> 16); dk[6 * 72] = (unsigned short)(vk.w & 0xffffu); dk[7 * 72] = (unsigned short)(vk.w >> 16);
                dv[0 * 72] = (unsigned short)(vv.x & 0xffffu); dv[1 * 72] = (unsigned short)(vv.x >> 16); dv[2 * 72] = (unsigned short)(vv.y & 0xffffu); dv[3 * 72] = (unsigned short)(vv.y >> 16);
                dv[4 * 72] = (unsigned short)(vv.z & 0xffffu); dv[5 * 72] = (unsigned short)(vv.z >> 16); dv[6 * 72] = (unsigned short)(vv.w & 0xffffu); dv[7 * 72] = (unsigned short)(vv.w >> 16); }
            if (wave == 0) {
                const float lf = GLF[(size_t)bh * SEQ + c * LCH + laneA], li = GLI[(size_t)bh * SEQ + c * LCH + laneA];
                float bc = lf;
#pragma unroll
                for (int o = 1; o < 64; o <<= 1) { const float t = __shfl_up(bc, o); if (laneA >= o) bc += t; }
                const float av = li - bc; float cm = av;
#pragma unroll
                for (int o = 1; o < 64; o <<= 1) { const float t = __shfl_up(cm, o); if (laneA >= o) cm = fmaxf(cm, t); }
                const float gv = fmaxf(mrun, cm); const float Gc = __shfl(gv, 63), bL = __shfl(bc, 63);
                mc_sc(lds, 0)[laneA] = av; mc_sc(lds, 1)[laneA] = gv; mc_sc(lds, 2)[laneA] = __expf(mrun - gv); mc_sc(lds, 3)[laneA] = __expf(av - Gc); mc_sc(lds, 4)[laneA] = __expf(-(bc + gv));
                if (laneA == 0) misc[0] = __expf(mrun - Gc);
                mrun = bL + Gc;
            } }
            __syncthreads();
            { OPQ(tB); const int laneB = tB & 63, l15 = laneB & 15, l4 = laneB >> 4;
                const int tt = wave >> 1;
#pragma unroll
                for (int sti = 0; sti < 2; ++sti) { const int st = 2 * (wave & 1) + sti;
                    f32x4 acc4 = {0.f, 0.f, 0.f, 0.f};
                    if (st <= tt) {
#pragma unroll
                        for (int ks = 0; ks < 8; ++ks) { const bf16x8 A = *(const LAS bf16x8*)(lds + MC_QI + (16 * tt + l15) * MC_QROW + ks * 64 + l4 * 16);
                            const bf16x8 B = *(const LAS bf16x8*)(lds + MC_KI + (16 * st + l15) * MC_QROW + ks * 64 + l4 * 16); acc4 = MFMA16(A, B, acc4); }
                    }
                    const int sidx = 16 * st + l15; const float as_ = mc_sc(lds, 0)[sidx];
#pragma unroll
                    for (int rg = 0; rg < 4; ++rg) { const int t = 16 * tt + 4 * l4 + rg; float p = 0.f;
                        if (st <= tt && sidx <= t) p = acc4[rg] * __expf(as_ - mc_sc(lds, 1)[t]);
                        *(LAS unsigned short*)(lds + MC_P + t * MC_TROW + sidx * 2) = (unsigned short)f2bf(p);
                        float sum = p; sum += __shfl_xor(sum, 1); sum += __shfl_xor(sum, 2); sum += __shfl_xor(sum, 4); sum += __shfl_xor(sum, 8);
                        if (l15 == 0) mc_sc(lds, 7 + st)[t] = sum; }
                }
              const int t = tB >> 3, seg = tB & 7; float sacc = 0.f;
#pragma unroll
                for (int k = 0; k < 4; ++k) { const u32x4 qv = *(const LAS u32x4*)(lds + MC_QI + t * MC_QROW + (seg * 32 + k * 8) * 2);
                    const f32x4 n0 = *(const LAS f32x4*)(nvec + seg * 32 + k * 8), n1 = *(const LAS f32x4*)(nvec + seg * 32 + k * 8 + 4);
                    sacc += bflo(qv.x) * n0.x + bfhi(qv.x) * n0.y + bflo(qv.y) * n0.z + bfhi(qv.y) * n0.w + bflo(qv.z) * n1.x + bfhi(qv.z) * n1.y + bflo(qv.w) * n1.z + bfhi(qv.w) * n1.w; }
                sacc += __shfl_xor(sacc, 1); sacc += __shfl_xor(sacc, 2); sacc += __shfl_xor(sacc, 4);
                if (seg == 0) mc_sc(lds, 5)[t] = sacc; }
            __syncthreads();
            const float cd = misc[0];
            f32x16 acc[2];
            { OPQ(tC); const int laneC = tC & 63, r = laneC & 31, hf = laneC >> 5;
            if (tC < 64) { const int t = tC; const float den = mc_sc(lds, 7)[t] + mc_sc(lds, 8)[t] + mc_sc(lds, 9)[t] + mc_sc(lds, 10)[t];
                const float dn = den + mc_sc(lds, 2)[t] * mc_sc(lds, 5)[t]; mc_sc(lds, 6)[t] = 1.0f / fmaxf(fabsf(dn), mc_sc(lds, 4)[t]); }
#pragma unroll
            for (int t2 = 0; t2 < 2; ++t2)
#pragma unroll
                for (int i = 0; i < 16; ++i) acc[t2][i] = 0.f;
            const LAS unsigned char* qbase = lds + MC_QI + r * MC_QROW + hf * 8;
#pragma unroll
            for (int dt = 0; dt < 8; ++dt) { const bf16x8 cl = pack_lo(C[dt]), chh = pack_hi(C[dt]);
#pragma unroll
                for (int t2 = 0; t2 < 2; ++t2) { const LAS unsigned char* qb = qbase + t2 * 32 * MC_QROW + dt * 64;
                    const s16x4 a0l = *(const LAS s16x4*)(qb), a0h = *(const LAS s16x4*)(qb + 16), a1l = *(const LAS s16x4*)(qb + 32), a1h = *(const LAS s16x4*)(qb + 48);
                    acc[t2] = MFMA32(__builtin_shufflevector(a0l, a0h, 0, 1, 2, 3, 4, 5, 6, 7), cl, acc[t2]);
                    acc[t2] = MFMA32(__builtin_shufflevector(a1l, a1h, 0, 1, 2, 3, 4, 5, 6, 7), chh, acc[t2]); } }
#pragma unroll
            for (int t2 = 0; t2 < 2; ++t2)
#pragma unroll
                for (int i = 0; i < 16; ++i) acc[t2][i] *= mc_sc(lds, 2)[32 * t2 + crow(i, hf)];
            bf16x8 vt[4];
            const LAS unsigned char* vbase = lds + MC_VT + (32 * wave + r) * MC_TROW + hf * 16;
#pragma unroll
            for (int ks = 0; ks < 4; ++ks) vt[ks] = *(const LAS bf16x8*)(vbase + ks * 32);
            const LAS unsigned char* pbase = lds + MC_P + r * MC_TROW + hf * 16;
#pragma unroll
            for (int t2 = 0; t2 < 2; ++t2)
#pragma unroll
                for (int ks = 0; ks < 4; ++ks) { const bf16x8 pA = *(const LAS bf16x8*)(pbase + t2 * 32 * MC_TROW + ks * 32); acc[t2] = MFMA32(pA, vt[ks], acc[t2]); }
            asm volatile("" : "+v"(acc[0]), "+v"(acc[1]));
#pragma unroll
            for (int ks = 0; ks < 4; ++ks) {
                const f32x4 w0 = *(const LAS f32x4*)(mc_sc(lds, 3) + 16 * ks + 8 * hf), w1 = *(const LAS f32x4*)(mc_sc(lds, 3) + 16 * ks + 8 * hf + 4);
                const u32x4 vv = __builtin_bit_cast(u32x4, vt[ks]); u32x4 o;
                o.x = pk2(bflo(vv.x) * w0.x, bfhi(vv.x) * w0.y); o.y = pk2(bflo(vv.y) * w0.z, bfhi(vv.y) * w0.w); o.z = pk2(bflo(vv.z) * w1.x, bfhi(vv.z) * w1.y); o.w = pk2(bflo(vv.w) * w1.z, bfhi(vv.w) * w1.w);
                vt[ks] = __builtin_bit_cast(bf16x8, o); }
            const LAS unsigned char* kbase = lds + MC_KT + r * MC_TROW + hf * 16;
#pragma unroll
            for (int dt = 0; dt < 8; ++dt) {
#pragma unroll
                for (int i = 0; i < 16; ++i) C[dt][i] *= cd;
#pragma unroll
                for (int ks = 0; ks < 4; ++ks) { const bf16x8 kA = *(const LAS bf16x8*)(kbase + dt * 32 * MC_TROW + ks * 32); C[dt] = MFMA32(kA, vt[ks], C[dt]); } }
            if (tC < 256) { float sacc = cd * nvec[tC];
#pragma unroll
                for (int k = 0; k < 8; ++k) { const u32x4 kv = *(const LAS u32x4*)(lds + MC_KT + tC * MC_TROW + k * 16);
                    const f32x4 w0 = *(const LAS f32x4*)(mc_sc(lds, 3) + k * 8), w1 = *(const LAS f32x4*)(mc_sc(lds, 3) + k * 8 + 4);
                    sacc += bflo(kv.x) * w0.x + bfhi(kv.x) * w0.y + bflo(kv.y) * w0.z + bfhi(kv.y) * w0.w + bflo(kv.z) * w1.x + bfhi(kv.z) * w1.y + bflo(kv.w) * w1.z + bfhi(kv.w) * w1.w; }
                nvec[tC] = sacc; }
            }
            __syncthreads();
            { OPQ(tD); const int laneD = tD & 63, r = laneD & 31, hf = laneD >> 5;
              const int t = tD >> 3, seg = tD & 7; const size_t row = rowbase + t; const int col = hd * MD + seg * 32;
              u32x4 xv[4], zv[4];
#pragma unroll
              for (int k = 0; k < 4; ++k) { xv[k] = *(const u32x4*)(XC + row * 1024 + col + k * 8); zv[k] = *(const u32x4*)(ZM + row * 1024 + col + k * 8); }
#pragma unroll
              for (int t2 = 0; t2 < 2; ++t2)
#pragma unroll
                for (int i = 0; i < 16; ++i) *(LAS float*)(lds + MC_QI + (32 * t2 + crow(i, hf)) * MC_STROW + (32 * wave + r) * 4) = acc[t2][i];
              __syncthreads();
              const float rden = mc_sc(lds, 6)[t]; float s1 = 0.f, s2 = 0.f;
              const LAS unsigned char* sp = lds + MC_QI + t * MC_STROW + (seg * 32) * 4;
#pragma unroll
              for (int k = 0; k < 8; ++k) { const f32x4 v = *(const LAS f32x4*)(sp + k * 16) * rden;
                  s1 += (v.x + v.y) + (v.z + v.w); s2 += (v.x * v.x + v.y * v.y) + (v.z * v.z + v.w * v.w); }
              s1 += __shfl_xor(s1, 1); s1 += __shfl_xor(s1, 2); s1 += __shfl_xor(s1, 4); s2 += __shfl_xor(s2, 1); s2 += __shfl_xor(s2, 2); s2 += __shfl_xor(s2, 4);
              const float mean = s1 * (1.0f / MD); const float var = fmaxf(s2 * (1.0f / MD) - mean * mean, 0.f); const float rstd = 1.0f / sqrtf(var + LN_EPS);
              const float sc = rden * rstd, sh = -mean * rstd;
#pragma unroll
              for (int k = 0; k < 4; ++k) {
                  const f32x4 g0 = *(const f32x4*)(mh_norm + col + k * 8), g1 = *(const f32x4*)(mh_norm + col + k * 8 + 4), k0 = *(const f32x4*)(skip + col + k * 8), k1 = *(const f32x4*)(skip + col + k * 8 + 4);
                  const f32x4 h0 = *(const LAS f32x4*)(sp + k * 32) * sc + sh, h1 = *(const LAS f32x4*)(sp + k * 32 + 16) * sc + sh;
                  float y[8];
                  y[0] = (h0.x * g0.x + k0.x * bflo(xv[k].x)) * silu_f(bflo(zv[k].x)); y[1] = (h0.y * g0.y + k0.y * bfhi(xv[k].x)) * silu_f(bfhi(zv[k].x));
                  y[2] = (h0.z * g0.z + k0.z * bflo(xv[k].y)) * silu_f(bflo(zv[k].y)); y[3] = (h0.w * g0.w + k0.w * bfhi(xv[k].y)) * silu_f(bfhi(zv[k].y));
                  y[4] = (h1.x * g1.x + k1.x * bflo(xv[k].z)) * silu_f(bflo(zv[k].z)); y[5] = (h1.y * g1.y + k1.y * bfhi(xv[k].z)) * silu_f(bfhi(zv[k].z));
                  y[6] = (h1.z * g1.z + k1.z * bflo(xv[k].w)) * silu_f(bflo(zv[k].w)); y[7] = (h1.w * g1.w + k1.w * bfhi(xv[k].w)) * silu_f(bfhi(zv[k].w));
                  u32x4 o; o.x = pk2(y[0], y[1]); o.y = pk2(y[2], y[3]); o.z = pk2(y[4], y[5]); o.w = pk2(y[6], y[7]);
                  *(u32x4*)(QK + row * 2048 + 1024 + col + k * 8) = o; } }
            __syncthreads();
        }
    }
#undef OPQ
}

DI void phase_final(const Args& a, int lane, int wave, int bid, int G, int dry) {
    const float* x = a.in[0]; const float* g_post = a.in[3]; float* out = a.out;
    const int gw = bid * NWAVES + wave, NGW = G * NWAVES;
    const f32x4* gr = (const f32x4*)g_post + lane; f32x4 gg[4];
#pragma unroll
    for (int j = 0; j < 4; ++j) gg[j] = gr[64 * j];
    for (int m = gw; m < MTOK; m += NGW) {
        f32x4* yr = (f32x4*)(out + (size_t)m * DM) + lane; const f32x4* xr = (const f32x4*)(x + (size_t)m * DM) + lane; f32x4 v[4], xv[4]; float s = 0.f;
#pragma unroll
        for (int j = 0; j < 4; ++j) { v[j] = yr[64 * j]; xv[j] = xr[64 * j]; s += (v[j].x * v[j].x + v[j].y * v[j].y) + (v[j].z * v[j].z + v[j].w * v[j].w); }
        const float rstd = 1.0f / sqrtf(wave_sum(s) * (1.0f / DM) + RMS_EPS);
#pragma unroll
        for (int j = 0; j < 4; ++j) { f32x4 o; o.x = xv[j].x + v[j].x * rstd * gg[j].x; o.y = xv[j].y + v[j].y * rstd * gg[j].y; o.z = xv[j].z + v[j].z * rstd * gg[j].z; o.w = xv[j].w + v[j].w * rstd * gg[j].w; if (!dry) yr[64 * j] = o; else asm volatile("" :: "v"(o)); }
    }
}

#define XB_TMO      128
#define XB_XCNT(j)  (256  + 64 * (j))
#define XB_XSUB(j)  (1280 + 64 * (j))
#define XB_XGEN(j)  (2304 + 64 * (j))
#define XB_TOP      3328
#define XB_TOPGEN   3392
#define XCD_BAR_WORDS 3456
#define XB_SPIN_CAP (1u << 18)

__device__ __forceinline__ unsigned xb_ld(unsigned* p)              { return __hip_atomic_load(p, __ATOMIC_RELAXED, __HIP_MEMORY_SCOPE_AGENT); }
__device__ __forceinline__ unsigned xb_add(unsigned* p, unsigned v) { return __hip_atomic_fetch_add(p, v, __ATOMIC_RELAXED, __HIP_MEMORY_SCOPE_AGENT); }
__device__ __forceinline__ unsigned xb_xcc_id() { return (unsigned)__builtin_amdgcn_s_getreg((3 << 11) | 20) & 0xFu; }
#define XB_SPIN(cond, bar) do { unsigned _sp = 0; while (cond) { __builtin_amdgcn_s_sleep(1); \
    if ((++_sp & 255u) == 0u) { if (xb_ld(&(bar)[XB_TMO])) break; if (_sp > XB_SPIN_CAP) { atomicAdd(&(bar)[XB_TMO], 1u); break; } } } } while (0)

struct XcdBarrier {
    unsigned* bar; unsigned x;
    volatile LAS unsigned* st;
};

__device__ __forceinline__ XcdBarrier xcd_barrier_post(unsigned* bar, volatile LAS unsigned* st) {
    XcdBarrier b; b.bar = bar; b.x = xb_xcc_id(); b.st = st;
    if (threadIdx.x == 0) (void)xb_add(&bar[XB_XCNT(b.x)], 1u);
    return b;
}
__device__ __forceinline__ void xcd_barrier_complete(unsigned* bar, unsigned x, unsigned& nloc, unsigned& nx) {
    const unsigned G = gridDim.x * gridDim.y * gridDim.z;
    unsigned sum, cnt, mine, sp = 0u;
    for (;;) {
        sum = 0u; cnt = 0u; mine = 0u;
#pragma unroll
        for (unsigned j = 0; j < 16; ++j) { const unsigned c = xb_ld(&bar[XB_XCNT(j)]); sum += c; cnt += (c > 0u) ? 1u : 0u; mine = (j == x) ? c : mine; }
        if (sum == G) break;
        __builtin_amdgcn_s_sleep(1);
        if ((++sp & 255u) == 0u) { if (xb_ld(&bar[XB_TMO])) break; if (sp > XB_SPIN_CAP) { atomicAdd(&bar[XB_TMO], 1u); break; } }
    }
    nloc = mine > 0u ? mine : 1u; nx = cnt > 0u ? cnt : 1u;
}

__device__ __forceinline__ void xcd_barrier(const XcdBarrier& b) {
    asm volatile("s_waitcnt vmcnt(0)" ::: "memory");
    __syncthreads();
    if (threadIdx.x == 0) {
        unsigned* bar = b.bar;
        __builtin_amdgcn_s_waitcnt(0);
        unsigned nloc = b.st[0], nx = b.st[1];
        if (nloc == 0u) { xcd_barrier_complete(bar, b.x, nloc, nx); b.st[0] = nloc; b.st[1] = nx; }
        const unsigned old = xb_add(&bar[XB_XSUB(b.x)], 1u);
        const unsigned gen = old / nloc;
        if (old + 1u == (gen + 1u) * nloc) {
            __builtin_amdgcn_fence(__ATOMIC_RELEASE, "agent");
            asm volatile("s_waitcnt vmcnt(0)" ::: "memory");
            const unsigned og = xb_add(&bar[XB_TOP], 1u);
            const unsigned tg = og / nx;
            if (og + 1u == (tg + 1u) * nx) xb_add(&bar[XB_TOPGEN], 1u);
            else XB_SPIN(xb_ld(&bar[XB_TOPGEN]) == tg, bar);
            __builtin_amdgcn_fence(__ATOMIC_ACQUIRE, "agent");
            xb_add(&bar[XB_XGEN(b.x)], 1u);
            asm volatile("s_waitcnt vmcnt(0)" ::: "memory");
        } else {
            XB_SPIN(xb_ld(&bar[XB_XGEN(b.x)]) == gen, bar);
            __builtin_amdgcn_fence(__ATOMIC_ACQUIRE, "agent");
            asm volatile("s_waitcnt vmcnt(0)" ::: "memory");
        }
    }
    __syncthreads();
}

constexpr int NPHASE = 12;
#ifndef DUP_PHASE
#define DUP_PHASE -1
#endif
#define NREP(k) (DUP_PHASE == (k) ? 2 : 1)
#ifndef MK_MULTI
#define MK_MULTI 0
#endif
__global__ void __launch_bounds__(NTHR, 2) hymba_fwd(Args args) {
    extern __shared__ __attribute__((aligned(16))) unsigned char lds_raw[];
    LAS unsigned char* lds = (LAS unsigned char*)lds_raw;
    cg::grid_group grid = cg::this_grid();
    const int tid = threadIdx.x, lane = tid & 63, wave = __builtin_amdgcn_readfirstlane(tid >> 6), bid = blockIdx.x, G = gridDim.x;
    const int lo = args.ph_lo, hi = args.ph_hi;
#ifdef ONLY_PHASE
#define IN(k) ((k) == ONLY_PHASE && lo <= (k) && (k) < hi)
#else
#define IN(k) (lo <= (k) && (k) < hi)
#endif
    unsigned char* ws = args.ws;
    volatile LAS unsigned* barst = (volatile LAS unsigned*)(lds + LDS_BARST);
    if (tid < 2) barst[tid] = 0u;
    __syncthreads();
    XcdBarrier xbar = xcd_barrier_post((unsigned*)(ws + WS_CTL) + CW_BAR, barst);
#define SEAM(k) do { if (IN(k) && IN((k) + 1)) { if ((k) == 0) grid.sync(); else xcd_barrier(xbar); } } while (0)
#undef DUPSYNC
    if (IN(0)) { for (int rep = 0; rep < NREP(0); ++rep) { if (rep) xcd_barrier(xbar); phase_prologue(args, lds, tid, lane, wave, bid, G); } } SEAM(0);
    if (IN(1)) {
        pg8::Gemm g{(const pg8::bf16_t*)(ws + WS_XN), (const pg8::bf16_t*)(ws + WS_WINT), MTOK, NIN, DM}; pg8::StaticOrder S; S.init(MTOK, NIN, G, bid);
        pg8::EpiProj E{(pg8::bf16_t*)(ws + WS_QK), (pg8::bf16_t*)(ws + WS_V), (pg8::bf16_t*)(ws + WS_G), (pg8::bf16_t*)(ws + WS_XM), (pg8::bf16_t*)(ws + WS_ZM), QSCALE};
        for (int rep = 0; rep < NREP(1); ++rep) { if (rep) xcd_barrier(xbar); pg8::gemm_phase<pg8::EpiProj, pg8::StaticOrder, true, true>(lds, g, S, E); }
    } SEAM(1);
    if (IN(2)) { for (int rep = 0; rep < NREP(2); ++rep) { if (rep) xcd_barrier(xbar); phase_kstat(args, lds, tid, lane, wave, bid, G); } } SEAM(2);
    if (IN(3)) { for (int rep = 0; rep < NREP(3); ++rep) { if (rep) xcd_barrier(xbar); phase_sel(args, lds, tid, lane, wave, bid, G, rep); } } SEAM(3);
    if (IN(4)) { for (int rep = 0; rep < NREP(4); ++rep) { if (rep) xcd_barrier(xbar); phase_att_gather(args, lds, tid, lane, wave, bid, G); } } SEAM(4);
    if (IN(5)) { for (int rep = 0; rep < NREP(5); ++rep) { if (rep) xcd_barrier(xbar); phase_att_own(args, lds, tid, lane, wave, bid, G, rep); } } SEAM(5);
    if (IN(6)) { for (int rep = 0; rep < NREP(6); ++rep) { if (rep) xcd_barrier(xbar); phase_mpre(args, lds, tid, lane, wave, bid, G); } } SEAM(6);
    if (IN(7)) { for (int rep = 0; rep < NREP(7); ++rep) { if (rep) xcd_barrier(xbar); phase_mstate(args, lds, tid, lane, wave, bid, G); } } SEAM(7);
    if (IN(8)) { for (int rep = 0; rep < NREP(8); ++rep) { if (rep) xcd_barrier(xbar); phase_mcomb(args, tid, bid, G, rep); } } SEAM(8);
    if (IN(9)) { for (int rep = 0; rep < NREP(9); ++rep) { if (rep) xcd_barrier(xbar); phase_mscan(args, lds, tid, lane, wave, bid, G); } } SEAM(9);
    if (IN(10)) {
        pg8::Gemm g{(const pg8::bf16_t*)(ws + WS_QK), (const pg8::bf16_t*)(ws + WS_WOUTT), MTOK, DM, MIXW}; pg8::StaticOrder S; S.init(MTOK, DM, G, bid);
        pg8::EpiF32 E{args.out, DM};
        for (int rep = 0; rep < NREP(10); ++rep) { if (rep) xcd_barrier(xbar); pg8::gemm_phase<pg8::EpiF32, pg8::StaticOrder, true, true>(lds, g, S, E); }
    } SEAM(10);
    if (IN(11)) { for (int rep = 0; rep < NREP(11); ++rep) { if (rep) xcd_barrier(xbar); phase_final(args, lane, wave, bid, G, rep); } }
#undef IN
#undef SEAM
}

extern "C" void kernel_launch(void* const* d_in, const int* in_sizes, int n_in, void* d_out, int out_size, void* d_ws, size_t ws_size, hipStream_t stream) {
    static int grid = 0;
    if (grid == 0) {
        if (n_in != 15 || out_size != MTOK * DM || ws_size < WS_END) { fprintf(stderr, "kernel_launch: unexpected shapes (n_in %d out %d ws %zu)\n", n_in, out_size, ws_size); grid = -1; return; }
        int dev = 0, cus = 0, per_cu = 0;
        if (hipGetDevice(&dev) != hipSuccess || hipDeviceGetAttribute(&cus, hipDeviceAttributeMultiprocessorCount, dev) != hipSuccess) { grid = -1; return; }
        if (hipFuncSetAttribute((const void*)hymba_fwd, hipFuncAttributeMaxDynamicSharedMemorySize, LDS_BYTES) != hipSuccess) { fprintf(stderr, "kernel_launch: hipFuncSetAttribute failed\n"); grid = -1; return; }
        if (hipOccupancyMaxActiveBlocksPerMultiprocessor(&per_cu, (const void*)hymba_fwd, NTHR, LDS_BYTES) != hipSuccess || per_cu < 1) { fprintf(stderr, "kernel_launch: occupancy query says %d\n", per_cu); per_cu = 1; }
        (void)hipGetLastError();
        grid = cus * 1;
        fprintf(stderr, "kernel_launch: grid %d (cus %d, query per_cu %d)\n", grid, cus, per_cu);
    }
    if (grid < 0) return;
    (void)hipMemsetAsync((char*)d_ws + WS_CTL, 0, CTL_ZERO_BYTES, stream);
    Args a{};
    for (int i = 0; i < 15; ++i) a.in[i] = (const float*)d_in[i];
    a.out = (float*)d_out; a.ws = (unsigned char*)d_ws;
#if MK_MULTI
    for (int p = 0; p < NPHASE; ++p) { a.ph_lo = p; a.ph_hi = p + 1; hipLaunchKernelGGL(hymba_fwd, dim3(grid), dim3(NTHR), LDS_BYTES, stream, a); }
#else
    a.ph_lo = 0; a.ph_hi = NPHASE;
    void* kargs[] = {&a};
    hipError_t e = hipLaunchCooperativeKernel((const void*)hymba_fwd, dim3(grid), dim3(NTHR), kargs, LDS_BYTES, stream);
    if (e != hipSuccess) fprintf(stderr, "kernel_launch: cooperative launch failed: %s (grid %d)\n", hipGetErrorString(e), grid);
#endif
}
```

```cpp
#include <hip/hip_runtime.h>
#include <hip/hip_cooperative_groups.h>
#include <cstdio>
#include <cstdint>
namespace cg = cooperative_groups;
namespace pg8 {
#define PG8_LAS __attribute__((address_space(3)))
typedef unsigned short bf16_t;
typedef short bf16x8 __attribute__((ext_vector_type(8)));
typedef float f32x4 __attribute__((ext_vector_type(4)));
typedef unsigned u32x4 __attribute__((ext_vector_type(4)));
constexpr int BM = 256, BK = 64, HALF = 128, HTB = HALF * BK * 2  , STAGE_BYTES = 8 * HTB, NXCD = 8, WGM = 8;

__host__ __device__ __forceinline__ int lds_byte(int r, int c) { const int st = (r >> 4) * 2 + (c >> 5), rr = r & 15, cc = c & 31, ob = rr * 64 + cc * 2; return st * 1024 + (ob ^ (((ob >> 9) & 1) << 5)); }
__host__ __device__ __forceinline__ void stage_rc(int b, int& R, int& C) { const int st = b / 1024, sb = b % 1024, swz = sb ^ (((sb >> 9) & 1) << 5); R = (st >> 1) * 16 + swz / 64; C = (st & 1) * 32 + (swz % 64) / 2; }
__host__ __device__ __forceinline__ int perm32(int rho) { const int n = rho >> 4, i = rho & 15; return 8 * (i >> 2) + 4 * n + (i & 3); }

struct Unit { int pm, pn; };
struct Gemm { const bf16_t* A; const bf16_t* Bt; int M, N, K; };

struct StaticOrder {
    int nM, nN, nwg, G, c;
    __host__ __device__ void init(int M, int N, int G_, int c_) { nM = M / BM; nN = N / BM; nwg = nM * nN; G = G_; c = c_; }
    __host__ __device__ bool next(int i, Unit& u) const {
        const long L = (long)i * G + c; if (L >= nwg) return false;
        int wgid = (int)L; { const int q = nwg / NXCD, r = nwg % NXCD, xcd = wgid % NXCD, off = wgid / NXCD; wgid = (xcd < r ? xcd * (q + 1) : r * (q + 1) + (xcd - r) * q) + off; }
        const int nig = WGM * nN, gid = wgid / nig, fm = gid * WGM, gsz = (nM - fm) < WGM ? (nM - fm) : WGM;
        u.pm = fm + ((wgid % nig) % gsz); u.pn = (wgid % nig) / gsz; return true;
    }
    __device__ __forceinline__ void a_ready(const Unit&) const {}
    __device__ __forceinline__ void done(const Unit&) const {}
};

__device__ __forceinline__ unsigned cvt_pk_bf16(float lo, float hi) { unsigned r; asm volatile("v_cvt_pk_bf16_f32 %0, %1, %2" : "=v"(r) : "v"(lo), "v"(hi)); return r; }
typedef float f32x2 __attribute__((ext_vector_type(2)));
struct EpiProj {
    static constexpr bool PERM = true, AFTER_DRAIN = false;
    bf16_t* QK; bf16_t* V; bf16_t* G; bf16_t* XM; bf16_t* ZM; float qscale;
    __device__ __forceinline__ void operator()(const f32x4 (&acc)[2][2][4][2], const Unit& u, int wr, int wc, int fr, int fq) const {
        const int row0 = u.pm * BM + wr * 64 + fr; const int colt = u.pn * BM; const int t = colt >> 10; const int cgp = colt & 1023;
        bf16_t* base; int ldc; float sc = 1.f;
        if (t == 0) { base = QK; ldc = 2048; sc = qscale; } else if (t == 1) { base = QK + 1024; ldc = 2048; } else if (t == 2) { base = V; ldc = 1024; }
        else if (t == 3) { base = G; ldc = 1024; } else if (t == 4) { base = XM; ldc = 1024; } else { base = ZM; ldc = 1024; }
        const int col0 = cgp + wc * 32 + 8 * fq;
#pragma unroll
        for (int ai = 0; ai < 2; ++ai)
#pragma unroll
            for (int m = 0; m < 4; ++m) { bf16_t* rowp = base + (size_t)(row0 + ai * HALF + m * 16) * ldc + col0;
#pragma unroll
                for (int bj = 0; bj < 2; ++bj) { f32x4 v0 = acc[ai][bj][m][0] * sc, v1 = acc[ai][bj][m][1] * sc;
                    u32x4 w; w.x = cvt_pk_bf16(v0[0], v0[1]); w.y = cvt_pk_bf16(v0[2], v0[3]); w.z = cvt_pk_bf16(v1[0], v1[1]); w.w = cvt_pk_bf16(v1[2], v1[3]);
                    *(u32x4*)(rowp + bj * HALF) = w; } }
    }
};
struct EpiF32 {
    static constexpr bool PERM = false, AFTER_DRAIN = false;
    float* O; int ldc;
    __device__ __forceinline__ void operator()(const f32x4 (&acc)[2][2][4][2], const Unit& u, int wr, int wc, int fr, int fq) const {
        const int col0 = u.pn * BM + wc * 32 + 4 * fq;
#pragma unroll
        for (int ai = 0; ai < 2; ++ai)
#pragma unroll
            for (int m = 0; m < 4; ++m) { const int r = ai * HALF + wr * 64 + m * 16 + fr; const size_t off = (size_t)(u.pm * BM + r) * ldc + col0;
#pragma unroll
                for (int bj = 0; bj < 2; ++bj)
#pragma unroll
                    for (int n = 0; n < 2; ++n) *(f32x4*)(O + off + bj * HALF + n * 16) = acc[ai][bj][m][n]; }
    }
};
template <class Epi, class Sched, bool ALIGN_EPI = false, bool SP2 = false>
__device__ __forceinline__ void gemm_phase(PG8_LAS unsigned char* lds, const Gemm g, const Sched& S, const Epi& E) {
    const int tid = threadIdx.x, wid = __builtin_amdgcn_readfirstlane(tid >> 6), lane = tid & 63, wr = wid >> 2, wc = wid & 3, fr = lane & 15, fq = lane >> 4;
    const int K = g.K, nt = K / BK;
    unsigned voffA[2], voffB[2];
#pragma unroll
    for (int i = 0; i < 2; ++i) { int R, C; stage_rc(tid * 16 + i * 8192, R, C); const int Rb = Epi::PERM ? ((R & ~31) + perm32(R & 31)) : R;
        voffA[i] = (unsigned)(R * K + C) * 2u; voffB[i] = (unsigned)(Rb * K + C) * 2u; }
    const size_t kstep = (size_t)(BK * 2);
    const size_t hstep = (size_t)HALF * K * 2;
    const size_t tstep = 2 * hstep;
    const unsigned ldsw = (unsigned)wid * 1024u;
    const int aoff = lds_byte(wr * 64 + fr, fq * 8), boff = lds_byte(wc * 32 + fr, fq * 8);
#define PG8_SA(b, h) (((b) * 2 + (h)) * HTB)
#define PG8_SB(b, h) ((4 + (b) * 2 + (h)) * HTB)
#define PG8_STAGE(bufoff, gbase, voff) do { _Pragma("unroll") for (int _i = 0; _i < 2; ++_i) \
        __builtin_amdgcn_global_load_lds((const unsigned*)((const char*)(gbase) + (voff)[_i]), (PG8_LAS unsigned*)(lds + (bufoff) + ldsw + _i * 8192), 16, 0, 0); } while (0)
#define PG8_LDA(dst, b, h) do { _Pragma("unroll") for (int m = 0; m < 4; ++m) _Pragma("unroll") for (int k = 0; k < 2; ++k) dst[m][k] = *(const PG8_LAS bf16x8*)(lds + PG8_SA(b, h) + aoff + m * 2048 + k * 1024); } while (0)
#define PG8_LDB(dst, b, h) do { _Pragma("unroll") for (int n = 0; n < 2; ++n) _Pragma("unroll") for (int k = 0; k < 2; ++k) dst[n][k] = *(const PG8_LAS bf16x8*)(lds + PG8_SB(b, h) + boff + n * 2048 + k * 1024); } while (0)
#define PG8_MMA(ai, bj, At, Bt) do { __builtin_amdgcn_s_setprio(1); _Pragma("unroll") for (int m = 0; m < 4; ++m) _Pragma("unroll") for (int n = 0; n < 2; ++n) _Pragma("unroll") for (int k = 0; k < 2; ++k) \
        acc[ai][bj][m][n] = __builtin_amdgcn_mfma_f32_16x16x32_bf16(Bt[n][k], At[m][k], acc[ai][bj][m][n], 0, 0, 0); __builtin_amdgcn_s_setprio(0); } while (0)
#define PG8_WAIT_V(n) asm volatile("s_waitcnt vmcnt(" #n ")" ::: "memory")
#define PG8_WAIT_L(n) asm volatile("s_waitcnt lgkmcnt(" #n ")" ::: "memory")
#define PG8_BAR __builtin_amdgcn_s_barrier()
#define PG8_SCHED __builtin_amdgcn_sched_barrier(0)
    Unit cur, nxt; int ui = 0;
    if (!S.next(0, cur)) return;
    f32x4 acc[2][2][4][2];
#pragma unroll
    for (int a = 0; a < 2; ++a)
#pragma unroll
        for (int b = 0; b < 2; ++b)
#pragma unroll
            for (int m = 0; m < 4; ++m)
#pragma unroll
                for (int n = 0; n < 2; ++n) acc[a][b][m][n] = (f32x4){0.f, 0.f, 0.f, 0.f};
    bf16x8 At[4][2], B0[2][2], B1[2][2];
    const char* cA = (const char*)g.A + (size_t)cur.pm * tstep; const char* cB = (const char*)g.Bt + (size_t)cur.pn * tstep;
    S.a_ready(cur);
    if constexpr (SP2) {
        PG8_STAGE(PG8_SB(0, 0), cB, voffB); PG8_STAGE(PG8_SB(0, 1), cB + hstep, voffB); PG8_STAGE(PG8_SA(0, 0), cA, voffA); PG8_STAGE(PG8_SA(0, 1), cA + hstep, voffA);
        if (wr == 1) PG8_BAR;
        PG8_WAIT_V(2); PG8_BAR;
        PG8_STAGE(PG8_SB(1, 0), cB + kstep, voffB); PG8_STAGE(PG8_SA(1, 0), cA + kstep, voffA); PG8_STAGE(PG8_SB(1, 1), cB + hstep + kstep, voffB);
        PG8_WAIT_V(6); PG8_BAR;
    } else {
        PG8_STAGE(PG8_SB(0, 0), cB, voffB); PG8_STAGE(PG8_SA(0, 0), cA, voffA); PG8_STAGE(PG8_SB(0, 1), cB + hstep, voffB); PG8_STAGE(PG8_SA(0, 1), cA + hstep, voffA);
        if (wr == 1) PG8_BAR;
        PG8_WAIT_V(4); PG8_BAR;
        PG8_STAGE(PG8_SB(1, 0), cB + kstep, voffB); PG8_STAGE(PG8_SA(1, 0), cA + kstep, voffA); PG8_STAGE(PG8_SB(1, 1), cB + hstep + kstep, voffB);
        PG8_WAIT_V(6); PG8_BAR;
    }
    for (;;) {
        const bool has_next = S.next(ui + 1, nxt);
        const char* nA = has_next ? (const char*)g.A + (size_t)nxt.pm * tstep : cA; const char* nB = has_next ? (const char*)g.Bt + (size_t)nxt.pn * tstep : cB;
        for (int t = 0; t < nt; t += 2) {
            const bool last = (t == nt - 2);
            const char* a1 = cA + (size_t)(t + 1) * kstep;
            const char* a2 = last ? nA : cA + (size_t)(t + 2) * kstep; const char* b2 = last ? nB : cB + (size_t)(t + 2) * kstep;
            const char* a3 = a2 + kstep; const char* b3 = b2 + kstep;
            if (last && has_next) S.a_ready(nxt);
            if constexpr (SP2) {
            PG8_LDB(B0, 0, 0); PG8_LDB(B1, 0, 1); PG8_SCHED; PG8_LDA(At, 0, 0); PG8_STAGE(PG8_SA(1, 1), a1 + hstep, voffA);
            PG8_WAIT_V(8); PG8_WAIT_L(0); PG8_BAR; PG8_MMA(0, 0, At, B0); PG8_MMA(0, 1, At, B1); PG8_BAR; PG8_SCHED;
            PG8_LDA(At, 0, 1); PG8_STAGE(PG8_SB(0, 0), b2, voffB); PG8_STAGE(PG8_SB(0, 1), b2 + hstep, voffB); PG8_STAGE(PG8_SA(0, 0), a2, voffA);
            PG8_WAIT_V(8); PG8_WAIT_L(0); PG8_BAR; PG8_MMA(1, 0, At, B0); PG8_MMA(1, 1, At, B1); PG8_BAR; PG8_SCHED;
            PG8_LDB(B0, 1, 0); PG8_LDB(B1, 1, 1); PG8_SCHED; PG8_LDA(At, 1, 0); PG8_STAGE(PG8_SA(0, 1), a2 + hstep, voffA);
            PG8_WAIT_V(8); PG8_WAIT_L(0); PG8_BAR; PG8_MMA(0, 0, At, B0); PG8_MMA(0, 1, At, B1); PG8_BAR; PG8_SCHED;
            PG8_LDA(At, 1, 1); PG8_STAGE(PG8_SB(1, 0), b3, voffB); PG8_STAGE(PG8_SB(1, 1), b3 + hstep, voffB); PG8_STAGE(PG8_SA(1, 0), a3, voffA);
            PG8_WAIT_V(8); PG8_WAIT_L(0); PG8_BAR; PG8_MMA(1, 0, At, B0); PG8_MMA(1, 1, At, B1); PG8_BAR; PG8_SCHED;
            } else {
            PG8_LDB(B0, 0, 0); PG8_SCHED; PG8_LDA(At, 0, 0); PG8_STAGE(PG8_SA(1, 1), a1 + hstep, voffA);
            PG8_WAIT_L(8); PG8_BAR; PG8_WAIT_L(0); PG8_MMA(0, 0, At, B0); PG8_BAR; PG8_SCHED;
            PG8_LDB(B1, 0, 1); PG8_STAGE(PG8_SB(0, 0), b2, voffB);
            PG8_BAR; PG8_WAIT_L(0); PG8_MMA(0, 1, At, B1); PG8_BAR;
            PG8_LDA(At, 0, 1); PG8_STAGE(PG8_SA(0, 0), a2, voffA);
            PG8_BAR; PG8_WAIT_L(0); PG8_MMA(1, 0, At, B0); PG8_BAR; PG8_SCHED;
            PG8_STAGE(PG8_SB(0, 1), b2 + hstep, voffB);
            PG8_WAIT_V(6); PG8_BAR; PG8_MMA(1, 1, At, B1); PG8_BAR;
            PG8_LDB(B0, 1, 0); PG8_SCHED; PG8_LDA(At, 1, 0); PG8_STAGE(PG8_SA(0, 1), a2 + hstep, voffA);
            PG8_WAIT_L(8); PG8_BAR; PG8_WAIT_L(0); PG8_MMA(0, 0, At, B0); PG8_BAR; PG8_SCHED;
            PG8_LDB(B1, 1, 1); PG8_STAGE(PG8_SB(1, 0), b3, voffB);
            PG8_BAR; PG8_WAIT_L(0); PG8_MMA(0, 1, At, B1); PG8_BAR;
            PG8_LDA(At, 1, 1); PG8_STAGE(PG8_SA(1, 0), a3, voffA);
            PG8_BAR; PG8_WAIT_L(0); PG8_MMA(1, 0, At, B0); PG8_BAR; PG8_SCHED;
            PG8_STAGE(PG8_SB(1, 1), b3 + hstep, voffB);
            PG8_WAIT_V(6); PG8_BAR; PG8_MMA(1, 1, At, B1); PG8_BAR;
            }
        }
        if constexpr (ALIGN_EPI) { if (wr == 0) PG8_BAR; }
        if constexpr (!Epi::AFTER_DRAIN) { E(acc, cur, wr, wc, fr, fq); S.done(cur); }
        if (!has_next) break;
#pragma unroll
        for (int a = 0; a < 2; ++a)
#pragma unroll
            for (int b = 0; b < 2; ++b)
#pragma unroll
                for (int m = 0; m < 4; ++m)
#pragma unroll
                    for (int n = 0; n < 2; ++n) acc[a][b][m][n] = (f32x4){0.f, 0.f, 0.f, 0.f};
        cur = nxt; cA = nA; cB = nB; ++ui;
        if constexpr (ALIGN_EPI) { if (wr == 1) PG8_BAR; }
    }
    PG8_WAIT_V(0);
    if constexpr (!ALIGN_EPI) { if (wr == 0) PG8_BAR; }
    PG8_BAR;
    if constexpr (Epi::AFTER_DRAIN) { E.fused(acc, cur, wr, wc, fr, fq, lds, wid, lane); S.done(cur); }
#undef PG8_SA
#undef PG8_SB
#undef PG8_STAGE
#undef PG8_LDA
#undef PG8_LDB
#undef PG8_MMA
#undef PG8_WAIT_V
#undef PG8_WAIT_L
#undef PG8_BAR
#undef PG8_SCHED
}
}

constexpr int NWAVES = 8, NTHR = 512;
constexpr int BATCH = 4, SEQ = 8192, DM = 1024, MTOK = BATCH * SEQ, NIN = 6144, MIXW = 2048;
constexpr int NH = 8, DH = 128, NBLK = SEQ / 256;
constexpr int MH = 4, MD = 256, LCH = 64, NCH = SEQ / LCH;
constexpr float LOG2E = 1.4426950408889634f;
constexpr float QSCALE = 0.08838834764831845f * LOG2E;
constexpr float RMS_EPS = 1e-6f, LN_EPS = 1e-5f;
constexpr int LISTSZ = 256 * 496;
__host__ __device__ constexpr int list_off(int j) { return 256 * (31 * j - (j * (j - 1)) / 2); }

constexpr size_t MiB = 1u << 20;
constexpr size_t WS_CTL = 0, CTL_ZERO_BYTES = 64 * 1024;
constexpr size_t WS_BIASD = 1 * MiB;
constexpr size_t WS_WEFF = 1 * MiB + 64 * 1024;
constexpr size_t WS_KMEAN = 1 * MiB + 128 * 1024;
constexpr size_t WS_KMAX = 1 * MiB + 640 * 1024;
constexpr size_t WS_GLI = 2 * MiB, WS_GLF = 2 * MiB + 512 * 1024;
constexpr size_t WS_SEL = 3 * MiB;
constexpr size_t WS_LPART = 7 * MiB;
constexpr size_t WS_WINT = 10 * MiB;
constexpr size_t WS_WOUTT = 22 * MiB;
constexpr size_t WS_LIST = 26 * MiB;
constexpr size_t WS_XN = 64 * MiB;
constexpr size_t WS_QK = 128 * MiB;
constexpr size_t WS_V = 256 * MiB, WS_G = 320 * MiB, WS_XM = 384 * MiB, WS_ZM = 448 * MiB, WS_END = 512 * MiB;
constexpr size_t WS_NST = 42 * MiB;
constexpr size_t WS_PST = 42 * MiB + 512 * 1024, WS_MIN = 42 * MiB + 516 * 1024;
constexpr size_t WS_CST = WS_V;
constexpr int NSC = 16, SCCH = NCH / NSC;
constexpr int CW_CNT = 1024;
constexpr int CW_BAR = 4096;
constexpr int LDS_BARST = 163840 - 64;

constexpr int LDS_BYTES = 163840;
#define GAS __attribute__((address_space(1)))
#define LAS __attribute__((address_space(3)))
#define DI __device__ __forceinline__
typedef unsigned short bf16;
typedef unsigned u32x4 __attribute__((ext_vector_type(4)));
typedef unsigned u32x2 __attribute__((ext_vector_type(2)));
typedef int i32x4 __attribute__((ext_vector_type(4)));
typedef float f32x4 __attribute__((ext_vector_type(4)));
typedef float f32x16 __attribute__((ext_vector_type(16)));
typedef short bf16x8 __attribute__((ext_vector_type(8)));
typedef short s16x4 __attribute__((ext_vector_type(4)));
typedef float f32x2_t __attribute__((ext_vector_type(2)));
typedef __bf16 bf16x2_t __attribute__((ext_vector_type(2)));
#define MFMA32(a, b, c) __builtin_amdgcn_mfma_f32_32x32x16_bf16((a), (b), (c), 0, 0, 0)
#define MFMA16(a, b, c) __builtin_amdgcn_mfma_f32_16x16x32_bf16((a), (b), (c), 0, 0, 0)

DI float bf2f(unsigned u16) { return __uint_as_float(u16 << 16); }
DI float bflo(unsigned w) { return __uint_as_float(w << 16); }
DI float bfhi(unsigned w) { return __uint_as_float(w & 0xffff0000u); }
DI unsigned pk2(float lo, float hi) { f32x2_t v = {lo, hi}; bf16x2_t b = __builtin_convertvector(v, bf16x2_t); return __builtin_bit_cast(unsigned, b); }
DI unsigned f2bf(float f) { return pk2(f, 0.f) & 0xffffu; }
DI int crow(int reg, int h) { return (reg & 3) + 8 * (reg >> 2) + 4 * h; }
DI float wave_sum(float v) {
#pragma unroll
    for (int o = 1; o < 64; o <<= 1) v += __shfl_xor(v, o);
    return v;
}
DI float wave_max(float v) {
#pragma unroll
    for (int o = 1; o < 64; o <<= 1) v = fmaxf(v, __shfl_xor(v, o));
    return v;
}
DI bf16x8 pack_lo(const f32x16& x) { u32x4 p; p.x = pk2(x[0], x[1]); p.y = pk2(x[2], x[3]); p.z = pk2(x[4], x[5]); p.w = pk2(x[6], x[7]); return __builtin_bit_cast(bf16x8, p); }
DI bf16x8 pack_hi(const f32x16& x) { u32x4 p; p.x = pk2(x[8], x[9]); p.y = pk2(x[10], x[11]); p.z = pk2(x[12], x[13]); p.w = pk2(x[14], x[15]); return __builtin_bit_cast(bf16x8, p); }
DI float frcp(float x) { return __builtin_amdgcn_rcpf(x); }
DI float frsq(float x) { return __builtin_amdgcn_rsqf(x); }
DI float silu_f(float v) { return v * frcp(1.0f + __builtin_amdgcn_exp2f(-LOG2E * v)); }

struct Args { const float* in[15]; float* out; unsigned char* ws; int ph_lo, ph_hi; };

DI void p0_transpose_item(const float* W, int K, int N, bf16* WT, LAS float* scr, int item, int lane) {
    const int nblk = N / 32, kb = item / nblk, nb = item % nblk, k0 = 64 * kb, n0 = 32 * nb;
#pragma unroll 8
    for (int i = 0; i < 32; ++i) { const int kk = 2 * i + (lane >> 5); scr[kk * 33 + (lane & 31)] = W[(size_t)(k0 + kk) * N + n0 + (lane & 31)]; }
    asm volatile("s_waitcnt lgkmcnt(0)" ::: "memory");
    const int c = lane & 7;
#pragma unroll
    for (int j = 0; j < 4; ++j) { const int n = (lane >> 3) + 8 * j; const LAS float* s = scr + (8 * c) * 33 + n;
        u32x4 o; o.x = pk2(s[0 * 33], s[1 * 33]); o.y = pk2(s[2 * 33], s[3 * 33]); o.z = pk2(s[4 * 33], s[5 * 33]); o.w = pk2(s[6 * 33], s[7 * 33]);
        *(u32x4*)(WT + (size_t)(n0 + n) * K + k0 + 8 * c) = o; }
    asm volatile("s_waitcnt lgkmcnt(0)" ::: "memory");
}
DI int t5_bucket(int n) {
    if (n < 16) return n;
    int b = 16;
    b += (n >= 22); b += (n >= 30); b += (n >= 40); b += (n >= 54); b += (n >= 73); b += (n >= 99); b += (n >= 134); b += (n >= 182);
    b += (n >= 246); b += (n >= 332); b += (n >= 450); b += (n >= 609); b += (n >= 825); b += (n >= 1117); b += (n >= 1513);
    return b;
}
DI void phase_prologue(const Args& a, LAS unsigned char* lds, int tid, int lane, int wave, int bid, int G) {
    const float* x = a.in[0]; const float* rel_bias = a.in[1]; const float* g_pre = a.in[2]; const float* w_in = a.in[4];
    const float* wq = a.in[7]; const float* wk = a.in[8]; const float* wv = a.in[9]; const float* w_if = a.in[10]; const float* w_out = a.in[14];
    unsigned char* ws = a.ws;
    LAS float* scr = (LAS float*)(lds + wave * 16384);
    const int gw = bid * NWAVES + wave, NGW = G * NWAVES;
    constexpr int I_IN = (DM / 64) * (NIN / 32), I_OUT = (MIXW / 64) * (DM / 32);
    for (int it = gw; it < I_IN + I_OUT; it += NGW) {
        if (it < I_IN) p0_transpose_item(w_in, DM, NIN, (bf16*)(ws + WS_WINT), scr, it, lane);
        else p0_transpose_item(w_out, MIXW, DM, (bf16*)(ws + WS_WOUTT), scr, it - I_IN, lane);
    }
    {
        const f32x4* gr = (const f32x4*)g_pre + lane; f32x4 gg[4];
#pragma unroll
        for (int j = 0; j < 4; ++j) gg[j] = gr[64 * j];
        bf16* XN = (bf16*)(ws + WS_XN);
        for (int m = gw; m < MTOK; m += NGW) {
            const f32x4* xr = (const f32x4*)(x + (size_t)m * DM) + lane; f32x4 v[4]; float s = 0.f;
#pragma unroll
            for (int j = 0; j < 4; ++j) { v[j] = xr[64 * j]; s += (v[j].x * v[j].x + v[j].y * v[j].y) + (v[j].z * v[j].z + v[j].w * v[j].w); }
            const float rstd = 1.0f / sqrtf(wave_sum(s) * (1.0f / DM) + RMS_EPS);
            u32x2* o8 = (u32x2*)(XN + (size_t)m * DM) + lane;
#pragma unroll
            for (int j = 0; j < 4; ++j) { u32x2 o; o.x = pk2(v[j].x * rstd * gg[j].x, v[j].y * rstd * gg[j].y); o.y = pk2(v[j].z * rstd * gg[j].z, v[j].w * rstd * gg[j].w); o8[64 * j] = o; }
        }
    }
    const int gt = bid * NTHR + tid, NGT = G * NTHR;
    float* biasd = (float*)(ws + WS_BIASD);
    for (int idx = gt; idx < NH * 2048; idx += NGT) { const int h = idx >> 11, d = idx & 2047; biasd[idx] = rel_bias[t5_bucket(d) * NH + h] * LOG2E; }
    if (gt < NH) { float m = -1e30f; for (int b = 0; b < 32; ++b) m = fmaxf(m, rel_bias[b * NH + gt] * LOG2E); ((float*)(ws + WS_KMAX + 4096))[gt] = m; }
    float* weff = (float*)(ws + WS_WEFF);
    for (int idx = gt; idx < 2 * 1024 * 8; idx += NGT) {
        const int which = idx >> 13, c = (idx >> 3) & 1023, g = idx & 7, n = c >> 2, i = c & 3; float s = 0.f;
        if (which == 0) { for (int o = 0; o < 4; ++o) s += wq[n * 16 + i * 4 + o] * w_if[(4 * n + o) * 8 + g] + wk[n * 16 + i * 4 + o] * w_if[(1024 + 4 * n + o) * 8 + g]; }
        else { for (int o = 0; o < 4; ++o) s += wv[n * 16 + i * 4 + o] * w_if[(2048 + 4 * n + o) * 8 + g]; }
        weff[idx] = s;
    }
}

DI void phase_kstat(const Args& a, LAS unsigned char* lds, int tid, int lane, int wave, int bid, int G) {
    const bf16* QK = (const bf16*)(a.ws + WS_QK); float* KMEAN = (float*)(a.ws + WS_KMEAN); float* KMAX = (float*)(a.ws + WS_KMAX);
    LAS float* red = (LAS float*)lds; LAS float* wmx = (LAS float*)(lds + 32 * 128 * 4);
    for (int u = bid; u < 32 * NBLK; u += G) {
        const int bh = u >> 5, blk = u & 31, b = bh >> 3, h = bh & 7;
        const bf16* Kb = QK + (size_t)(b * SEQ + blk * 256) * 2048 + 1024 + h * DH;
        const int rg = tid >> 4, ch = tid & 15;
        float cs[8]; float mx = 0.f;
#pragma unroll
        for (int e = 0; e < 8; ++e) cs[e] = 0.f;
#pragma unroll
        for (int rr = 0; rr < 8; ++rr) {
            const u32x4 v = *(const u32x4*)(Kb + (size_t)(rg * 8 + rr) * 2048 + ch * 8);
            const float f0 = bflo(v.x), f1 = bfhi(v.x), f2 = bflo(v.y), f3 = bfhi(v.y), f4 = bflo(v.z), f5 = bfhi(v.z), f6 = bflo(v.w), f7 = bfhi(v.w);
            cs[0] += f0; cs[1] += f1; cs[2] += f2; cs[3] += f3; cs[4] += f4; cs[5] += f5; cs[6] += f6; cs[7] += f7;
            float ss = (f0 * f0 + f1 * f1) + (f2 * f2 + f3 * f3) + (f4 * f4 + f5 * f5) + (f6 * f6 + f7 * f7);
            ss += __shfl_xor(ss, 1); ss += __shfl_xor(ss, 2); ss += __shfl_xor(ss, 4); ss += __shfl_xor(ss, 8);
            mx = fmaxf(mx, ss);
        }
#pragma unroll
        for (int e = 0; e < 8; ++e) red[rg * 128 + ch * 8 + e] = cs[e];
        mx = wave_max(mx); if (lane == 0) wmx[wave] = mx;
        __syncthreads();
        if (tid < 128) { float s = 0.f; for (int r = 0; r < 32; ++r) s += red[r * 128 + tid]; KMEAN[(size_t)(bh * 32 + blk) * 128 + tid] = s * (1.0f / 256.0f); }
        if (tid == 0) { float m = wmx[0]; for (int w = 1; w < 8; ++w) m = fmaxf(m, wmx[w]); KMAX[bh * 32 + blk] = m; }
        __syncthreads();
    }
}

DI void phase_sel(const Args& a, LAS unsigned char* lds, int tid, int lane, int wave, int bid, int G, int dry) {
    const bf16* QK = (const bf16*)(a.ws + WS_QK); const float* KMEAN = (const float*)(a.ws + WS_KMEAN); const float* KMAX = (const float*)(a.ws + WS_KMAX);
    const float* BMAX = (const float*)(a.ws + WS_KMAX + 4096);
    i32x4* SEL = (i32x4*)(a.ws + WS_SEL); unsigned* cnt = (unsigned*)(a.ws + WS_CTL) + CW_CNT + (dry ? 1024 : 0); unsigned* LIST = dry ? (unsigned*)a.out : (unsigned*)(a.ws + WS_LIST);
    LAS float* km = (LAS float*)lds; LAS float* misc = (LAS float*)(lds + 32 * 128 * 4);
    for (int u = bid; u < 32 * NBLK; u += G) {
        const int bh = u >> 5, i = u & 31, b = bh >> 3, h = bh & 7;
        for (int idx = tid; idx < i * 128; idx += NTHR) km[idx] = KMEAN[(size_t)bh * 32 * 128 + idx];
        if (tid < 64) { float v = tid < 32 ? KMAX[bh * 32 + tid] : 0.f; v = wave_max(v); if (tid == 0) misc[0] = sqrtf(v); }
        __syncthreads();
        const float kmaxn = misc[0];
        const int q = tid >> 1, half = tid & 1; const int row = b * SEQ + i * 256 + q;
        const bf16* qp = QK + (size_t)row * 2048 + h * DH + half * 64;
        float qv[64];
#pragma unroll
        for (int c = 0; c < 8; ++c) { const u32x4 v = *(const u32x4*)(qp + c * 8);
            qv[c * 8 + 0] = bflo(v.x); qv[c * 8 + 1] = bfhi(v.x); qv[c * 8 + 2] = bflo(v.y); qv[c * 8 + 3] = bfhi(v.y);
            qv[c * 8 + 4] = bflo(v.z); qv[c * 8 + 5] = bfhi(v.z); qv[c * 8 + 6] = bflo(v.w); qv[c * 8 + 7] = bfhi(v.w); }
        float qn2 = 0.f;
#pragma unroll
        for (int d = 0; d < 64; ++d) qn2 += qv[d] * qv[d];
        qn2 += __shfl_xor(qn2, 1);
        float v0 = -INFINITY, v1 = -INFINITY, v2 = -INFINITY; int i0 = -1, i1 = -1, i2 = -1;
        for (int j = 0; j < i; ++j) {
            const LAS float* kr = km + j * 128 + half * 64; float dot = 0.f;
#pragma unroll
            for (int d = 0; d < 64; d += 4) { const f32x4 kk = *(const LAS f32x4*)(kr + d); dot += qv[d] * kk.x + qv[d + 1] * kk.y + qv[d + 2] * kk.z + qv[d + 3] * kk.w; }
            dot += __shfl_xor(dot, 1);
            if (dot > v0) { v2 = v1; i2 = i1; v1 = v0; i1 = i0; v0 = dot; i0 = j; }
            else if (dot > v1) { v2 = v1; i2 = i1; v1 = dot; i1 = j; }
            else if (dot > v2) { v2 = dot; i2 = j; }
        }
        const float shift = sqrtf(qn2) * kmaxn + BMAX[h];
        LAS int* lcnt = (LAS int*)(lds + 32 * 128 * 4 + 256);
        if (tid < 32) lcnt[tid] = 0;
        __syncthreads();
        int p0 = 0, p1 = 0, p2 = 0;
        if (half == 0) {
            i32x4 s4; s4.x = i0; s4.y = i1; s4.z = i2; s4.w = __float_as_int(shift);
            SEL[((size_t)(b * NH + h)) * SEQ + (size_t)(i * 256 + q)] = s4;
            if (i0 >= 0) p0 = __hip_atomic_fetch_add(lcnt + i0, 1, __ATOMIC_RELAXED, __HIP_MEMORY_SCOPE_WORKGROUP);
            if (i1 >= 0) p1 = __hip_atomic_fetch_add(lcnt + i1, 1, __ATOMIC_RELAXED, __HIP_MEMORY_SCOPE_WORKGROUP);
            if (i2 >= 0) p2 = __hip_atomic_fetch_add(lcnt + i2, 1, __ATOMIC_RELAXED, __HIP_MEMORY_SCOPE_WORKGROUP);
        }
        __syncthreads();
        if (tid < i) { const int c = lcnt[tid]; int base = 0; if (c > 0) base = (int)atomicAdd(&cnt[bh * 32 + tid], (unsigned)c); lcnt[tid] = base; }
        __syncthreads();
        if (half == 0) {
            const unsigned qpos = (unsigned)(i * 256 + q);
            if (i0 >= 0) LIST[(size_t)bh * LISTSZ + list_off(i0) + lcnt[i0] + p0] = qpos | (0u << 16);
            if (i1 >= 0) LIST[(size_t)bh * LISTSZ + list_off(i1) + lcnt[i1] + p1] = qpos | (1u << 16);
            if (i2 >= 0) LIST[(size_t)bh * LISTSZ + list_off(i2) + lcnt[i2] + p2] = qpos | (2u << 16);
        }
        __syncthreads();
    }
}

#ifndef PROBE_VAR
#define PROBE_VAR 0
#endif
constexpr int ATT_KIMG = 0, ATT_KROW = 272, ATT_VIMG = 69632, ATT_VROW = 320, ATT_BIASD = 151552, ATT_NBIAS = 1536, ATT_PREF = 157696, ATT_LST = 161792, ATT_MISC = 162816;
typedef short v4i16_t __attribute__((ext_vector_type(4)));
DI s16x4 lds_tr16(const LAS unsigned char* p) { return __builtin_bit_cast(s16x4, __builtin_amdgcn_ds_read_tr16_b64_v4i16((LAS v4i16_t*)p)); }
DI void att_fill_kv(LAS unsigned char* lds, const bf16* Kg, const bf16* Vg, int tid, int lane, int wave) {
    u32x4 kv[8], vv[8];
#pragma unroll
    for (int it = 0; it < 8; ++it) { const int p = it * NTHR + tid, key = p >> 4, ch = p & 15; kv[it] = *(const u32x4*)(Kg + (size_t)key * 2048 + ch * 8); }
#pragma unroll
    for (int it = 0; it < 8; ++it) { const int p = it * NTHR + tid, key = p >> 4, ch = p & 15; vv[it] = *(const u32x4*)(Vg + (size_t)key * 1024 + ch * 8); }
    __builtin_amdgcn_sched_barrier(0);
#pragma unroll
    for (int it = 0; it < 8; ++it) { const int p = it * NTHR + tid, key = p >> 4, ch = p & 15; *(LAS u32x4*)(lds + ATT_KIMG + key * ATT_KROW + ch * 16) = kv[it]; }
#pragma unroll
    for (int it = 0; it < 8; ++it) { const int p = it * NTHR + tid, key = p >> 4, ch = p & 15; *(LAS u32x4*)(lds + ATT_VIMG + key * ATT_VROW + ch * 16) = vv[it]; }
}
template <bool OWN>
DI void att_tile(LAS unsigned char* lds, const bf16x8 (&qf)[8], int qpos, float shift, int kbase, int kt_end, int wdiag, bool far, float b31,
                 f32x16 (&o)[4], float& lsum, int r, int hf) {
    const LAS float* biasd = (const LAS float*)(lds + ATT_BIASD);
    const int lane16 = (r & 15), grp = (r >> 4);
    const LAS unsigned char* kp = lds + ATT_KIMG + r * ATT_KROW + hf * 16;
    const LAS unsigned char* vp = lds + ATT_VIMG + (4 * hf + (lane16 >> 2)) * ATT_VROW + (16 * grp + 4 * (lane16 & 3)) * 2;
    bf16x8 ka[4];
#pragma unroll
    for (int ks = 0; ks < 4; ++ks) ka[ks] = *(const LAS bf16x8*)(kp + ks * 32);
    for (int kt = 0; kt < kt_end; ++kt) {
        const LAS unsigned char* kc = kp + kt * (32 * ATT_KROW);
        bf16x8 kb[4];
#pragma unroll
        for (int ks = 0; ks < 4; ++ks) kb[ks] = *(const LAS bf16x8*)(kc + (4 + ks) * 32);
        float bv[16];
        if (!far) {
#pragma unroll
            for (int i = 0; i < 16; ++i) { const int key = 32 * kt + crow(i, hf); int dist = qpos - (kbase + key); dist = dist < 0 ? 0 : (dist > ATT_NBIAS - 1 ? ATT_NBIAS - 1 : dist); bv[i] = biasd[dist]; }
        } else {
#pragma unroll
            for (int i = 0; i < 16; ++i) bv[i] = b31;
        }
        __builtin_amdgcn_sched_barrier(0);
        f32x16 x;
#pragma unroll
        for (int i = 0; i < 16; ++i) x[i] = 0.f;
#pragma unroll
        for (int ks = 0; ks < 4; ++ks) x = MFMA32(ka[ks], qf[ks], x);
#pragma unroll
        for (int ks = 0; ks < 4; ++ks) x = MFMA32(kb[ks], qf[4 + ks], x);
        __builtin_amdgcn_sched_barrier(0);
        const LAS unsigned char* vb = vp + kt * (32 * ATT_VROW);
        s16x4 vl[2][4];
#pragma unroll
        for (int dt = 0; dt < 2; ++dt) { vl[dt][0] = lds_tr16(vb + dt * 64); vl[dt][1] = lds_tr16(vb + dt * 64 + 8 * ATT_VROW); vl[dt][2] = lds_tr16(vb + dt * 64 + 16 * ATT_VROW); vl[dt][3] = lds_tr16(vb + dt * 64 + 24 * ATT_VROW); }
        __builtin_amdgcn_sched_barrier(0);
#pragma unroll
        for (int i = 0; i < 16; ++i) { float p = __builtin_amdgcn_exp2f(x[i] + (bv[i] - shift));
            if (OWN) { if (kt == wdiag && crow(i, hf) > r) p = 0.f; }
            lsum += p; x[i] = p; }
        const bf16x8 pa0 = pack_lo(x), pa1 = pack_hi(x);
        __builtin_amdgcn_sched_barrier(0);
        s16x4 vh[2][4];
#pragma unroll
        for (int dt = 0; dt < 2; ++dt) { vh[dt][0] = lds_tr16(vb + (2 + dt) * 64); vh[dt][1] = lds_tr16(vb + (2 + dt) * 64 + 8 * ATT_VROW); vh[dt][2] = lds_tr16(vb + (2 + dt) * 64 + 16 * ATT_VROW); vh[dt][3] = lds_tr16(vb + (2 + dt) * 64 + 24 * ATT_VROW); }
#pragma unroll
        for (int dt = 0; dt < 2; ++dt) {
            o[dt] = MFMA32(__builtin_shufflevector(vl[dt][0], vl[dt][1], 0, 1, 2, 3, 4, 5, 6, 7), pa0, o[dt]);
            o[dt] = MFMA32(__builtin_shufflevector(vl[dt][2], vl[dt][3], 0, 1, 2, 3, 4, 5, 6, 7), pa1, o[dt]); }
        __builtin_amdgcn_sched_barrier(0);
        if (kt + 1 < kt_end) {
#pragma unroll
            for (int ks = 0; ks < 4; ++ks) ka[ks] = *(const LAS bf16x8*)(kc + 32 * ATT_KROW + ks * 32); }
#pragma unroll
        for (int dt = 0; dt < 2; ++dt) {
            o[2 + dt] = MFMA32(__builtin_shufflevector(vh[dt][0], vh[dt][1], 0, 1, 2, 3, 4, 5, 6, 7), pa0, o[2 + dt]);
            o[2 + dt] = MFMA32(__builtin_shufflevector(vh[dt][2], vh[dt][3], 0, 1, 2, 3, 4, 5, 6, 7), pa1, o[2 + dt]); }
    }
}
DI void att_load_biasd(const Args& a, LAS unsigned char* lds, int h, int tid) {
    const float* biasd = (const float*)(a.ws + WS_BIASD) + h * 2048; LAS float* dst = (LAS float*)(lds + ATT_BIASD);
    for (int i = tid; i < ATT_NBIAS; i += NTHR) dst[i] = biasd[i];
}
DI size_t hmrow(int b, int h, int s) { return ((size_t)(b * NH + h)) * SEQ + (size_t)s; }
DI bf16* opart_base(const Args& a, int slot) { return slot == 0 ? (bf16*)a.out : (slot == 1 ? (bf16*)((unsigned char*)a.out + 64 * MiB) : (bf16*)(a.ws + WS_XN)); }

constexpr int ATT_RU = 512, ATT_NT = ATT_RU / 256;
DI void att_swap(unsigned& a, unsigned& b) { const auto r = __builtin_amdgcn_permlane32_swap(a, b, false, false); a = r[0]; b = r[1]; }
DI void att_g_load(const Args& a, const unsigned* lp, int nv, int b, int h, int r, int hf, unsigned& ent, float& shift, bf16x8 (&qf)[8]) {
    const bf16* QK = (const bf16*)(a.ws + WS_QK); const i32x4* SEL = (const i32x4*)(a.ws + WS_SEL);
    ent = lp[r < nv ? r : 0];
    const int qpos = (int)(ent & 0xffffu); const size_t row = (size_t)b * SEQ + qpos;
    shift = __int_as_float(SEL[hmrow(b, h, qpos)].w);
#pragma unroll
    for (int ks = 0; ks < 8; ++ks) qf[ks] = *(const bf16x8*)(QK + row * 2048 + h * DH + ks * 16 + hf * 8);
}
DI void att_g_tile(const Args& a, LAS unsigned char* lds, int nv, int b, int h, int j, int r, int hf, unsigned ent, float shift, const bf16x8 (&qf)[8], int mode) {
    float* LPART = (float*)(a.ws + WS_LPART);
    f32x16 o[4]; float lsum = 0.f;
#pragma unroll
    for (int dt = 0; dt < 4; ++dt)
#pragma unroll
        for (int i = 0; i < 16; ++i) o[dt][i] = 0.f;
    const int qpos = (int)(ent & 0xffffu), slot = (int)(ent >> 16);
    const bool far = __all(qpos - (j * 256 + 255) >= 1513);
    const float b31 = *(const LAS float*)(lds + ATT_BIASD + (ATT_NBIAS - 1) * 4);
    if (mode != 3) att_tile<false>(lds, qf, qpos, shift, j * 256, 8, -1, far, b31, o, lsum, r, hf);
    lsum += __shfl_xor(lsum, 32);
    if (mode == 4) { asm volatile("" :: "v"(o[0]), "v"(o[1]), "v"(o[2]), "v"(o[3]), "v"(lsum)); return; }
    bf16* dst = opart_base(a, slot) + hmrow(b, h, qpos) * 128;
#pragma unroll
    for (int dt = 0; dt < 4; ++dt)
#pragma unroll
        for (int gg = 0; gg < 2; ++gg) {
            unsigned ax = pk2(o[dt][8 * gg + 0], o[dt][8 * gg + 1]), ay = pk2(o[dt][8 * gg + 2], o[dt][8 * gg + 3]), bx = pk2(o[dt][8 * gg + 4], o[dt][8 * gg + 5]), by = pk2(o[dt][8 * gg + 6], o[dt][8 * gg + 7]);
            att_swap(ax, bx); att_swap(ay, by);
            u32x4 v; v.x = ax; v.y = ay; v.z = bx; v.w = by;
            if (r < nv) *(u32x4*)(dst + (4 * dt + 2 * gg + hf) * 8) = v; }
    if (hf == 0 && r < nv) LPART[(size_t)slot * MTOK * 8 + hmrow(b, h, qpos)] = lsum;
}
DI void phase_att_gather(const Args& a, LAS unsigned char* lds, int tid, int lane, int wave, int bid, int G, int dry) {
    const bf16* QK = (const bf16*)(a.ws + WS_QK); const bf16* Vb = (const bf16*)(a.ws + WS_V);
    const unsigned* cnt = (const unsigned*)(a.ws + WS_CTL) + CW_CNT; const unsigned* LIST = (const unsigned*)(a.ws + WS_LIST);
    LAS int* pref = (LAS int*)(lds + ATT_PREF);
    if (tid < 64) {
        int nu[16]; int s = 0;
#pragma unroll
        for (int k = 0; k < 16; ++k) { const int l = tid * 16 + k; int n = 0; if (l < 992) { const int bh = l / 31, j = l % 31; n = (int)((cnt[bh * 32 + j] + (unsigned)(ATT_RU - 1)) / (unsigned)ATT_RU); } nu[k] = n; s += n; }
        int incl = s;
#pragma unroll
        for (int o = 1; o < 64; o <<= 1) { const int t = __shfl_up(incl, o); if (lane >= o) incl += t; }
        int run = incl - s;
#pragma unroll
        for (int k = 0; k < 16; ++k) { const int l = tid * 16 + k; if (l <= 992) pref[l] = run; run += nu[k]; }
    }
    __syncthreads();
    const int U = pref[992];
    const int r = lane & 31, hf = lane >> 5;
    int cur_h = -1;
    for (int u = bid; u < U; u += G) {
        int lo = 0, hi = 992;
        while (hi - lo > 1) { const int mid = (lo + hi) >> 1; if (pref[mid] <= u) lo = mid; else hi = mid; }
        const int l = lo, bh = l / 31, j = l % 31, chunk = u - pref[l], b = bh >> 3, h = bh & 7;
        const int n = (int)cnt[bh * 32 + j]; const int nrows = min(ATT_RU, n - chunk * ATT_RU);
        const unsigned* lp = LIST + (size_t)bh * LISTSZ + list_off(j) + chunk * ATT_RU;
        const int nv0 = min(32, max(0, nrows - 32 * wave)), nv1 = min(32, max(0, nrows - 32 * (8 + wave)));
        unsigned entA = 0; float shA = 0.f; bf16x8 qfA[8];
        const bool skipall = (PROBE_VAR == 5 && dry);
        if (nv0 > 0 && !skipall) att_g_load(a, lp + 32 * wave, nv0, b, h, r, hf, entA, shA, qfA);
        if (h != cur_h) { att_load_biasd(a, lds, h, tid); cur_h = h; }
        att_fill_kv(lds, QK + (size_t)(b * SEQ + j * 256) * 2048 + 1024 + h * DH, Vb + (size_t)(b * SEQ + j * 256) * 1024 + h * DH, tid, lane, wave);
        __syncthreads();
        if (nv0 > 0 && !skipall) {
            att_g_tile(a, lds, nv0, b, h, j, r, hf, entA, shA, qfA, dry ? PROBE_VAR : 0);
            if (nv1 > 0) { att_g_load(a, lp + 32 * (8 + wave), nv1, b, h, r, hf, entA, shA, qfA); att_g_tile(a, lds, nv1, b, h, j, r, hf, entA, shA, qfA, dry ? PROBE_VAR : 0); }
        }
        __syncthreads();
    }
}

DI void phase_att_own(const Args& a, LAS unsigned char* lds, int tid, int lane, int wave, int bid, int G, int dry) {
    bf16* QK = (bf16*)(a.ws + WS_QK); const bf16* Vb = (const bf16*)(a.ws + WS_V); const bf16* Gb = (const bf16*)(a.ws + WS_G);
    const i32x4* SEL = (const i32x4*)(a.ws + WS_SEL); const float* LPART = (const float*)(a.ws + WS_LPART);
    int cur_h = -1;
    for (int u = bid; u < 32 * NBLK; u += G) {
        const int bh = u >> 5, i = u & 31, b = bh >> 3, h = bh & 7;
        const int r0 = lane & 31, hf0 = lane >> 5; const int qpos0 = i * 256 + 32 * wave + r0; const size_t row0 = (size_t)b * SEQ + qpos0;
        const float shift = __int_as_float(SEL[hmrow(b, h, qpos0)].w);
        bf16x8 qf[8];
#pragma unroll
        for (int ks = 0; ks < 8; ++ks) qf[ks] = *(const bf16x8*)(QK + row0 * 2048 + h * DH + ks * 16 + hf0 * 8);
        if (h != cur_h) { att_load_biasd(a, lds, h, tid); cur_h = h; }
        att_fill_kv(lds, QK + (size_t)(b * SEQ + i * 256) * 2048 + 1024 + h * DH, Vb + (size_t)(b * SEQ + i * 256) * 1024 + h * DH, tid, lane, wave);
        __syncthreads();
        f32x16 o[4]; float lsum = 0.f;
#pragma unroll
        for (int dt = 0; dt < 4; ++dt)
#pragma unroll
            for (int k = 0; k < 16; ++k) o[dt][k] = 0.f;
        if (!(PROBE_VAR == 2 && dry)) att_tile<true>(lds, qf, qpos0, shift, i * 256, wave + 1, wave, false, 0.f, o, lsum, r0, hf0);
        lsum += __shfl_xor(lsum, 32);
        int l2_ = lane; asm volatile("" : "+v"(l2_));
        const int r = l2_ & 31, hf = l2_ >> 5; const int qpos = i * 256 + 32 * wave + r; const size_t row = (size_t)b * SEQ + qpos;
        const i32x4 s4 = SEL[hmrow(b, h, qpos)];
        if (PROBE_VAR == 1 && dry) { asm volatile("" :: "v"(o[0]), "v"(o[1]), "v"(o[2]), "v"(o[3]), "v"(lsum)); __syncthreads(); continue; }
        float l = lsum;
        const unsigned mk0 = s4.x >= 0 ? 0xffffffffu : 0u, mk1 = s4.y >= 0 ? 0xffffffffu : 0u, mk2 = s4.z >= 0 ? 0xffffffffu : 0u;
#pragma unroll
        for (int k = 0; k < 3; ++k) { const unsigned mk = (k == 0) ? mk0 : (k == 1 ? mk1 : mk2); const float lp = LPART[(size_t)k * MTOK * 8 + hmrow(b, h, qpos)]; l += __uint_as_float(__float_as_uint(lp) & mk); }
        const float rl = frcp(l);
#pragma unroll
        for (int dt = 0; dt < 4; ++dt) {
            u32x4 pv[2][3], gv[2];
#pragma unroll
            for (int gg = 0; gg < 2; ++gg) { const int c = 4 * dt + 2 * gg + hf;
                gv[gg] = *(const u32x4*)(Gb + row * 1024 + h * DH + c * 8);
#pragma unroll
                for (int k = 0; k < 3; ++k) pv[gg][k] = *(const u32x4*)(opart_base(a, k) + hmrow(b, h, qpos) * 128 + c * 8); }
#pragma unroll
            for (int gg = 0; gg < 2; ++gg) { const int c = 4 * dt + 2 * gg + hf;
                unsigned w[8];
#pragma unroll
                for (int k = 0; k < 8; ++k) w[k] = __float_as_uint(o[dt][8 * gg + k]);
#pragma unroll
                for (int k = 0; k < 4; ++k) att_swap(w[k], w[4 + k]);
                float acc[8];
#pragma unroll
                for (int k = 0; k < 8; ++k) acc[k] = __uint_as_float(w[k]);
#pragma unroll
                for (int k = 0; k < 3; ++k) { const unsigned mk = (k == 0) ? mk0 : (k == 1 ? mk1 : mk2); u32x4 p = pv[gg][k]; p.x &= mk; p.y &= mk; p.z &= mk; p.w &= mk;
                    acc[0] += bflo(p.x); acc[1] += bfhi(p.x); acc[2] += bflo(p.y); acc[3] += bfhi(p.y); acc[4] += bflo(p.z); acc[5] += bfhi(p.z); acc[6] += bflo(p.w); acc[7] += bfhi(p.w); }
                const u32x4 g4 = gv[gg];
                u32x4 ov; ov.x = pk2(acc[0] * rl * silu_f(bflo(g4.x)), acc[1] * rl * silu_f(bfhi(g4.x))); ov.y = pk2(acc[2] * rl * silu_f(bflo(g4.y)), acc[3] * rl * silu_f(bfhi(g4.y)));
                ov.z = pk2(acc[4] * rl * silu_f(bflo(g4.z)), acc[5] * rl * silu_f(bfhi(g4.z))); ov.w = pk2(acc[6] * rl * silu_f(bflo(g4.w)), acc[7] * rl * silu_f(bfhi(g4.w)));
                if (!dry) *(u32x4*)(QK + row * 2048 + h * DH + c * 8) = ov; else asm volatile("" :: "v"(ov)); }
        }
        __syncthreads();
    }
}

DI void phase_mgate(const Args& a, LAS unsigned char* lds, int tid, int lane, int wave, int bid, int G) {
    const float* conv_w = a.in[5]; const float* conv_b = a.in[6]; const float* b_if = a.in[11];
    const float* weff = (const float*)(a.ws + WS_WEFF);
    const bf16* XM = (const bf16*)(a.ws + WS_XM);
    float* GLI = (float*)(a.ws + WS_GLI); float* GLF = (float*)(a.ws + WS_GLF);
    LAS float* red = (LAS float*)lds;
    const int tk = tid >> 8, n = tid & 255;
    float cw[4][4], cb[4], wc[4][8], wm[4][8];
#pragma unroll
    for (int w = 0; w < 4; ++w) { const f32x4 t = *(const f32x4*)(conv_w + w * 1024 + 4 * n); cw[w][0] = t.x; cw[w][1] = t.y; cw[w][2] = t.z; cw[w][3] = t.w; }
    { const f32x4 t = *(const f32x4*)(conv_b + 4 * n); cb[0] = t.x; cb[1] = t.y; cb[2] = t.z; cb[3] = t.w; }
#pragma unroll
    for (int i = 0; i < 4; ++i)
#pragma unroll
        for (int g = 0; g < 8; ++g) { wc[i][g] = weff[(4 * n + i) * 8 + g]; wm[i][g] = weff[8192 + (4 * n + i) * 8 + g]; }
    for (int blk = bid; blk < MTOK / 16; blk += G) {
        const int mb = 16 * blk + 8 * tk, s0 = mb & (SEQ - 1);
        u32x2 win[11];
#pragma unroll
        for (int j = 0; j < 11; ++j) { u32x2 v = *(const u32x2*)(XM + (ptrdiff_t)(mb - 3 + j) * 1024 + 4 * n); const unsigned mk = (s0 - 3 + j >= 0) ? 0xffffffffu : 0u; v.x &= mk; v.y &= mk; win[j] = v; }
#pragma unroll
        for (int k = 0; k < 8; ++k) {
            float xc[4], xm[4];
            xm[0] = bflo(win[k + 3].x); xm[1] = bfhi(win[k + 3].x); xm[2] = bflo(win[k + 3].y); xm[3] = bfhi(win[k + 3].y);
            { float y0 = cb[0], y1 = cb[1], y2 = cb[2], y3 = cb[3];
#pragma unroll
              for (int w = 0; w < 4; ++w) { y0 += bflo(win[k + w].x) * cw[w][0]; y1 += bfhi(win[k + w].x) * cw[w][1]; y2 += bflo(win[k + w].y) * cw[w][2]; y3 += bfhi(win[k + w].y) * cw[w][3]; }
              xc[0] = silu_f(y0); xc[1] = silu_f(y1); xc[2] = silu_f(y2); xc[3] = silu_f(y3); }
#pragma unroll
            for (int g = 0; g < 8; ++g) { float sg = 0.f;
#pragma unroll
                for (int i = 0; i < 4; ++i) sg += xc[i] * wc[i][g] + xm[i] * wm[i][g];
                red[((8 * tk + k) * 8 + g) * 256 + n] = sg; }
        }
        __syncthreads();
#pragma unroll 4
        for (int rr = 0; rr < 16; ++rr) { const int row = wave * 16 + rr;
            const f32x4 v = *(const LAS f32x4*)(red + row * 256 + lane * 4); float s = (v.x + v.y) + (v.z + v.w); s = wave_sum(s);
            if (lane == 0) { const int tok = row >> 3, g = row & 7; const int m2 = 16 * blk + tok, s2 = m2 & (SEQ - 1), b2 = m2 >> 13; const float gate = s + b_if[g];
                if (g < 4) GLI[(size_t)(b2 * 4 + g) * SEQ + s2] = gate;
                else GLF[(size_t)(b2 * 4 + g - 4) * SEQ + s2] = fminf(gate, 0.f) - log1pf(__expf(-fabsf(gate))); } }
        __syncthreads();
    }
}

constexpr int MC_QI = 0, MC_QROW = 528, MC_KI = 33792, MC_KT = 67584, MC_TROW = 144, MC_VT = 104448, MC_P = 141312, MC_SC = 150528, MC_NV = 153600, MC_MISC = 154624;
constexpr int MC_STROW = 1040;
DI LAS float* mc_sc(LAS unsigned char* lds, int k) { return (LAS float*)(lds + MC_SC + k * 256); }

template <bool FULL>
DI void mfill(const Args& a, LAS unsigned char* lds, size_t rowbase, int spos0, int hd, int tk, int n64, u32x2 (&xcp)[8]) {
    const float* conv_w = a.in[5]; const float* conv_b = a.in[6]; const float* wq = a.in[7]; const float* wk = a.in[8]; const float* wv = a.in[9];
    const bf16* XM = (const bf16*)(a.ws + WS_XM);
    const int ch = hd * MD + 4 * n64, ng = hd * 64 + n64;
    const bf16* xp = XM + (rowbase + 8 * tk) * 1024 + ch;
    u32x2 win[11];
#pragma unroll
    for (int j = 0; j < 11; ++j) { u32x2 v = *(const u32x2*)(xp + (ptrdiff_t)(j - 3) * 1024); const unsigned mk = (spos0 + 8 * tk - 3 + j >= 0) ? 0xffffffffu : 0u; v.x &= mk; v.y &= mk; win[j] = v; }
    __builtin_amdgcn_sched_barrier(0);
    { float fw[16];
#pragma unroll
      for (int q4 = 0; q4 < 4; ++q4) { const f32x4 t = *(const f32x4*)(wv + ng * 16 + q4 * 4); fw[q4 * 4 + 0] = t.x; fw[q4 * 4 + 1] = t.y; fw[q4 * 4 + 2] = t.z; fw[q4 * 4 + 3] = t.w; }
      unsigned tw[4][4]; float prev[4];
#pragma unroll
      for (int k = 0; k < 8; ++k) { float o[4]; const float x0 = bflo(win[k + 3].x), x1 = bfhi(win[k + 3].x), x2 = bflo(win[k + 3].y), x3 = bfhi(win[k + 3].y);
#pragma unroll
          for (int oo = 0; oo < 4; ++oo) o[oo] = x0 * fw[oo] + x1 * fw[4 + oo] + x2 * fw[8 + oo] + x3 * fw[12 + oo];
          if ((k & 1) == 0) { prev[0] = o[0]; prev[1] = o[1]; prev[2] = o[2]; prev[3] = o[3]; }
          else { tw[0][k >> 1] = pk2(prev[0], o[0]); tw[1][k >> 1] = pk2(prev[1], o[1]); tw[2][k >> 1] = pk2(prev[2], o[2]); tw[3][k >> 1] = pk2(prev[3], o[3]); } }
#pragma unroll
      for (int oo = 0; oo < 4; ++oo) { u32x4 w4; w4.x = tw[oo][0]; w4.y = tw[oo][1]; w4.z = tw[oo][2]; w4.w = tw[oo][3]; *(LAS u32x4*)(lds + MC_VT + (4 * n64 + oo) * MC_TROW + 16 * tk) = w4; } }
    { float cw[4][4], cb[4];
#pragma unroll
      for (int w = 0; w < 4; ++w) { const f32x4 t = *(const f32x4*)(conv_w + w * 1024 + ch); cw[w][0] = t.x; cw[w][1] = t.y; cw[w][2] = t.z; cw[w][3] = t.w; }
      { const f32x4 t = *(const f32x4*)(conv_b + ch); cb[0] = t.x; cb[1] = t.y; cb[2] = t.z; cb[3] = t.w; }
#pragma unroll
      for (int k = 0; k < 8; ++k) { float y0 = cb[0], y1 = cb[1], y2 = cb[2], y3 = cb[3];
#pragma unroll
          for (int w = 0; w < 4; ++w) { y0 += bflo(win[k + w].x) * cw[w][0]; y1 += bfhi(win[k + w].x) * cw[w][1]; y2 += bflo(win[k + w].y) * cw[w][2]; y3 += bfhi(win[k + w].y) * cw[w][3]; }
          u32x2 p; p.x = pk2(silu_f(y0), silu_f(y1)); p.y = pk2(silu_f(y2), silu_f(y3)); xcp[k] = p; } }
    asm volatile("" : "+v"(xcp[0]), "+v"(xcp[1]), "+v"(xcp[2]), "+v"(xcp[3]), "+v"(xcp[4]), "+v"(xcp[5]), "+v"(xcp[6]), "+v"(xcp[7]));
    { float fw[16];
#pragma unroll
      for (int q4 = 0; q4 < 4; ++q4) { const f32x4 t = *(const f32x4*)(wk + ng * 16 + q4 * 4); fw[q4 * 4 + 0] = t.x * 0.0625f; fw[q4 * 4 + 1] = t.y * 0.0625f; fw[q4 * 4 + 2] = t.z * 0.0625f; fw[q4 * 4 + 3] = t.w * 0.0625f; }
      unsigned tw[4][4]; float prev[4];
#pragma unroll
      for (int k = 0; k < 8; ++k) { float o[4]; const float x0 = bflo(xcp[k].x), x1 = bfhi(xcp[k].x), x2 = bflo(xcp[k].y), x3 = bfhi(xcp[k].y);
#pragma unroll
          for (int oo = 0; oo < 4; ++oo) o[oo] = x0 * fw[oo] + x1 * fw[4 + oo] + x2 * fw[8 + oo] + x3 * fw[12 + oo];
          if (FULL) { u32x2 p; p.x = pk2(o[0], o[1]); p.y = pk2(o[2], o[3]); *(LAS u32x2*)(lds + MC_KI + (8 * tk + k) * MC_QROW + 8 * n64) = p; }
          if ((k & 1) == 0) { prev[0] = o[0]; prev[1] = o[1]; prev[2] = o[2]; prev[3] = o[3]; }
          else { tw[0][k >> 1] = pk2(prev[0], o[0]); tw[1][k >> 1] = pk2(prev[1], o[1]); tw[2][k >> 1] = pk2(prev[2], o[2]); tw[3][k >> 1] = pk2(prev[3], o[3]); } }
#pragma unroll
      for (int oo = 0; oo < 4; ++oo) { u32x4 w4; w4.x = tw[oo][0]; w4.y = tw[oo][1]; w4.z = tw[oo][2]; w4.w = tw[oo][3]; *(LAS u32x4*)(lds + MC_KT + (4 * n64 + oo) * MC_TROW + 16 * tk) = w4; } }
    if (FULL) { float fw[16];
#pragma unroll
      for (int q4 = 0; q4 < 4; ++q4) { const f32x4 t = *(const f32x4*)(wq + ng * 16 + q4 * 4); fw[q4 * 4 + 0] = t.x; fw[q4 * 4 + 1] = t.y; fw[q4 * 4 + 2] = t.z; fw[q4 * 4 + 3] = t.w; }
#pragma unroll
      for (int k = 0; k < 8; ++k) { float o[4]; const float x0 = bflo(xcp[k].x), x1 = bfhi(xcp[k].x), x2 = bflo(xcp[k].y), x3 = bfhi(xcp[k].y);
#pragma unroll
          for (int oo = 0; oo < 4; ++oo) o[oo] = x0 * fw[oo] + x1 * fw[4 + oo] + x2 * fw[8 + oo] + x3 * fw[12 + oo];
          u32x2 p; p.x = pk2(o[0], o[1]); p.y = pk2(o[2], o[3]); *(LAS u32x2*)(lds + MC_QI + (8 * tk + k) * MC_QROW + 8 * n64) = p; } }
}

DI void phase_mstate(const Args& a, LAS unsigned char* lds, int tid, int lane0, int wave, int bid, int G) {
    const float* GLI = (const float*)(a.ws + WS_GLI); const float* GLF = (const float*)(a.ws + WS_GLF);
    float* CST = (float*)(a.ws + WS_CST); float* NST = (float*)(a.ws + WS_NST); float* PST = (float*)(a.ws + WS_PST); float* MIN = (float*)(a.ws + WS_MIN);
    LAS float* nvec = (LAS float*)(lds + MC_NV); LAS float* misc = (LAS float*)(lds + MC_MISC);
    LAS float* aggb = (LAS float*)(lds + MC_QI); LAS float* agga = aggb + 128; LAS float* marr = aggb + 256;
#define OPQ(name) int name = tid; asm volatile("" : "+v"(name))
    for (int u = bid; u < BATCH * MH * NSC; u += G) {
        const int bh = u >> 4, sc = u & 15, b = bh >> 2, hd = bh & 3; const int c0 = sc * SCCH, c1 = c0 + SCCH;
        { OPQ(tA); const int laneA = tA & 63;
            for (int c = wave; c < c1; c += NWAVES) {
                const float lf = GLF[(size_t)bh * SEQ + c * LCH + laneA], li = GLI[(size_t)bh * SEQ + c * LCH + laneA];
                float bc = lf;
#pragma unroll
                for (int o = 1; o < 64; o <<= 1) { const float t = __shfl_up(bc, o); if (laneA >= o) bc += t; }
                const float am = wave_max(li - bc); const float bL = __shfl(bc, 63);
                if (laneA == 0) { aggb[c] = bL; agga[c] = am; }
            }
        }
        __syncthreads();
        if (tid == 0) { float m = 0.f; for (int c = 0; c < c1; ++c) { marr[c] = m; m = aggb[c] + fmaxf(m, agga[c]); } }
        __syncthreads();
        if (tid < SCCH) MIN[bh * NCH + c0 + tid] = marr[c0 + tid];
        f32x16 C[8];
#pragma unroll
        for (int dt = 0; dt < 8; ++dt)
#pragma unroll
            for (int i = 0; i < 16; ++i) C[dt][i] = 0.f;
        if (tid < 256) nvec[tid] = 0.f;
        float pprod = 1.f;
        for (int c = c0; c < c1; ++c) {
            const size_t rowbase = (size_t)b * SEQ + (size_t)c * LCH;
            { OPQ(tB); const int laneB = tB & 63;
            { u32x2 dummy[8]; mfill<false>(a, lds, rowbase, c * LCH, hd, wave, laneB, dummy); }
            if (wave == 0) {
                const float lf = GLF[(size_t)bh * SEQ + c * LCH + laneB], li = GLI[(size_t)bh * SEQ + c * LCH + laneB];
                float bc = lf;
#pragma unroll
                for (int o = 1; o < 64; o <<= 1) { const float t = __shfl_up(bc, o); if (laneB >= o) bc += t; }
                const float av = li - bc; const float mi = marr[c]; const float Gc = fmaxf(mi, wave_max(av));
                mc_sc(lds, 3)[laneB] = __expf(av - Gc);
                if (laneB == 0) misc[0] = __expf(mi - Gc);
            } }
            __syncthreads();
            const float cd = misc[0]; pprod *= cd;
            { OPQ(tC); const int laneC = tC & 63, r = laneC & 31, hf = laneC >> 5;
            bf16x8 vt[4];
            const LAS unsigned char* vbase = lds + MC_VT + (32 * wave + r) * MC_TROW + hf * 16;
#pragma unroll
            for (int ks = 0; ks < 4; ++ks) { vt[ks] = *(const LAS bf16x8*)(vbase + ks * 32);
                const f32x4 w0 = *(const LAS f32x4*)(mc_sc(lds, 3) + 16 * ks + 8 * hf), w1 = *(const LAS f32x4*)(mc_sc(lds, 3) + 16 * ks + 8 * hf + 4);
                const u32x4 vv = __builtin_bit_cast(u32x4, vt[ks]); u32x4 o;
                o.x = pk2(bflo(vv.x) * w0.x, bfhi(vv.x) * w0.y); o.y = pk2(bflo(vv.y) * w0.z, bfhi(vv.y) * w0.w); o.z = pk2(bflo(vv.z) * w1.x, bfhi(vv.z) * w1.y); o.w = pk2(bflo(vv.w) * w1.z, bfhi(vv.w) * w1.w);
                vt[ks] = __builtin_bit_cast(bf16x8, o); }
            const LAS unsigned char* kbase = lds + MC_KT + r * MC_TROW + hf * 16;
#pragma unroll
            for (int dt = 0; dt < 8; ++dt) {
#pragma unroll
                for (int i = 0; i < 16; ++i) C[dt][i] *= cd;
#pragma unroll
                for (int ks = 0; ks < 4; ++ks) { const bf16x8 kA = *(const LAS bf16x8*)(kbase + dt * 32 * MC_TROW + ks * 32); C[dt] = MFMA32(kA, vt[ks], C[dt]); } }
            if (tC < 256) { float sacc = cd * nvec[tC];
#pragma unroll
                for (int k = 0; k < 8; ++k) { const u32x4 kv = *(const LAS u32x4*)(lds + MC_KT + tC * MC_TROW + k * 16);
                    const f32x4 w0 = *(const LAS f32x4*)(mc_sc(lds, 3) + k * 8), w1 = *(const LAS f32x4*)(mc_sc(lds, 3) + k * 8 + 4);
                    sacc += bflo(kv.x) * w0.x + bfhi(kv.x) * w0.y + bflo(kv.y) * w0.z + bfhi(kv.y) * w0.w + bflo(kv.z) * w1.x + bfhi(kv.z) * w1.y + bflo(kv.w) * w1.z + bfhi(kv.w) * w1.w; }
                nvec[tC] = sacc; }
            }
            __syncthreads();
        }
        { OPQ(tD); const int laneD = tD & 63, r = laneD & 31, hf = laneD >> 5;
            float* cs = CST + (size_t)u * 65536 + 32 * wave + r;
#pragma unroll
            for (int dt = 0; dt < 8; ++dt)
#pragma unroll
                for (int i = 0; i < 16; ++i) cs[(32 * dt + crow(i, hf)) * 256] = C[dt][i];
            if (tD < 256) NST[u * 256 + tD] = nvec[tD];
            if (tD == 0) PST[u] = pprod;
        }
        __syncthreads();
    }
#undef OPQ
}
DI void phase_mcomb(const Args& a, int tid, int bid, int G, int dry) {
    float* CST = (float*)(a.ws + WS_CST); float* NST = (float*)(a.ws + WS_NST); const float* PST = (const float*)(a.ws + WS_PST);
    const int gt = bid * NTHR + tid, NGT = G * NTHR;
    for (int idx = gt; idx < BATCH * MH * 65536; idx += NGT) { const int bh = idx >> 16, e = idx & 65535; float run = 0.f;
#pragma unroll 4
        for (int sc = 0; sc < NSC; ++sc) { float* p = CST + (size_t)(bh * NSC + sc) * 65536 + e; const float tmp = *p; if (!dry) *p = run; else asm volatile("" :: "v"(run)); run = PST[bh * NSC + sc] * run + tmp; } }
    for (int idx = gt; idx < BATCH * MH * 256; idx += NGT) { const int bh = idx >> 8, e = idx & 255; float run = 0.f;
        for (int sc = 0; sc < NSC; ++sc) { float* p = NST + (size_t)(bh * NSC + sc) * 256 + e; const float tmp = *p; if (!dry) *p = run; else asm volatile("" :: "v"(run)); run = PST[bh * NSC + sc] * run + tmp; } }
}
DI void phase_mscan(const Args& a, LAS unsigned char* lds, int tid, int lane0, int wave, int bid, int G) {
    const bf16* ZM = (const bf16*)(a.ws + WS_ZM); bf16* QK = (bf16*)(a.ws + WS_QK);
    const float* GLI = (const float*)(a.ws + WS_GLI); const float* GLF = (const float*)(a.ws + WS_GLF);
    const float* mh_norm = a.in[12]; const float* skip = a.in[13];
    LAS float* nvec = (LAS float*)(lds + MC_NV); LAS float* misc = (LAS float*)(lds + MC_MISC);
#define OPQ(name) int name = tid; asm volatile("" : "+v"(name))
    const float* CST = (const float*)(a.ws + WS_CST); const float* NST = (const float*)(a.ws + WS_NST); const float* MIN = (const float*)(a.ws + WS_MIN);
    for (int u = bid; u < BATCH * MH * NSC; u += G) {
        const int bh = u >> 4, sc = u & 15, b = bh >> 2, hd = bh & 3;
        f32x16 C[8];
        { OPQ(t0); const int lane_ = t0 & 63, r = lane_ & 31, hf = lane_ >> 5;
            const float* cs = CST + (size_t)u * 65536 + 32 * wave + r;
#pragma unroll
            for (int dt = 0; dt < 8; ++dt)
#pragma unroll
                for (int i = 0; i < 16; ++i) C[dt][i] = cs[(32 * dt + crow(i, hf)) * 256];
            if (t0 < 256) nvec[t0] = NST[u * 256 + t0];
        }
        float mrun = MIN[bh * NCH + sc * SCCH];
        for (int c = sc * SCCH; c < (sc + 1) * SCCH; ++c) {
            const size_t rowbase = (size_t)b * SEQ + (size_t)c * LCH;
            u32x2 xcp[8];
            { OPQ(tA); const int laneA = tA & 63;
            mfill<true>(a, lds, rowbase, c * LCH, hd, wave, laneA, xcp);
            if (wave == 0) {
                const float lf = GLF[(size_t)bh * SEQ + c * LCH + laneA], li = GLI[(size_t)bh * SEQ + c * LCH + laneA];
                float bc = lf;
#pragma unroll
                for (int o = 1; o < 64; o <<= 1) { const float t = __shfl_up(bc, o); if (laneA >= o) bc += t; }
                const float av = li - bc; float cm = av;
#pragma unroll
                for (int o = 1; o < 64; o <<= 1) { const float t = __shfl_up(cm, o); if (laneA >= o) cm = fmaxf(cm, t); }
                const float gv = fmaxf(mrun, cm); const float Gc = __shfl(gv, 63), bL = __shfl(bc, 63);
                mc_sc(lds, 0)[laneA] = av; mc_sc(lds, 1)[laneA] = gv; mc_sc(lds, 2)[laneA] = __expf(mrun - gv); mc_sc(lds, 3)[laneA] = __expf(av - Gc); mc_sc(lds, 4)[laneA] = __expf(-(bc + gv));
                if (laneA == 0) misc[0] = __expf(mrun - Gc);
                mrun = bL + Gc;
            } }
            __syncthreads();
            { OPQ(tB); const int laneB = tB & 63, l15 = laneB & 15, l4 = laneB >> 4;
                const int tt = wave >> 1;
#pragma unroll
                for (int sti = 0; sti < 2; ++sti) { const int st = 2 * (wave & 1) + sti;
                    f32x4 acc4 = {0.f, 0.f, 0.f, 0.f};
                    if (st <= tt) {
#pragma unroll
                        for (int ks = 0; ks < 8; ++ks) { const bf16x8 A = *(const LAS bf16x8*)(lds + MC_QI + (16 * tt + l15) * MC_QROW + ks * 64 + l4 * 16);
                            const bf16x8 B = *(const LAS bf16x8*)(lds + MC_KI + (16 * st + l15) * MC_QROW + ks * 64 + l4 * 16); acc4 = MFMA16(A, B, acc4); }
                    }
                    const int sidx = 16 * st + l15; const float as_ = mc_sc(lds, 0)[sidx];
#pragma unroll
                    for (int rg = 0; rg < 4; ++rg) { const int t = 16 * tt + 4 * l4 + rg; float p = 0.f;
                        if (st <= tt && sidx <= t) p = acc4[rg] * __expf(as_ - mc_sc(lds, 1)[t]);
                        *(LAS unsigned short*)(lds + MC_P + t * MC_TROW + sidx * 2) = (unsigned short)f2bf(p);
                        float sum = p; sum += __shfl_xor(sum, 1); sum += __shfl_xor(sum, 2); sum += __shfl_xor(sum, 4); sum += __shfl_xor(sum, 8);
                        if (l15 == 0) mc_sc(lds, 7 + st)[t] = sum; }
                }
              const int t = tB >> 3, seg = tB & 7; float sacc = 0.f;
#pragma unroll
                for (int k = 0; k < 4; ++k) { const u32x4 qv = *(const LAS u32x4*)(lds + MC_QI + t * MC_QROW + (seg * 32 + k * 8) * 2);
                    const f32x4 n0 = *(const LAS f32x4*)(nvec + seg * 32 + k * 8), n1 = *(const LAS f32x4*)(nvec + seg * 32 + k * 8 + 4);
                    sacc += bflo(qv.x) * n0.x + bfhi(qv.x) * n0.y + bflo(qv.y) * n0.z + bfhi(qv.y) * n0.w + bflo(qv.z) * n1.x + bfhi(qv.z) * n1.y + bflo(qv.w) * n1.z + bfhi(qv.w) * n1.w; }
                sacc += __shfl_xor(sacc, 1); sacc += __shfl_xor(sacc, 2); sacc += __shfl_xor(sacc, 4);
                if (seg == 0) mc_sc(lds, 5)[t] = sacc; }
            __syncthreads();
            const float cd = misc[0];
            f32x16 acc[2];
            { OPQ(tC); const int laneC = tC & 63, r = laneC & 31, hf = laneC >> 5;
            if (tC < 64) { const int t = tC; const float den = mc_sc(lds, 7)[t] + mc_sc(lds, 8)[t] + mc_sc(lds, 9)[t] + mc_sc(lds, 10)[t];
                const float dn = den + mc_sc(lds, 2)[t] * mc_sc(lds, 5)[t]; mc_sc(lds, 6)[t] = frcp(fmaxf(fabsf(dn), mc_sc(lds, 4)[t])); }
#pragma unroll
            for (int t2 = 0; t2 < 2; ++t2)
#pragma unroll
                for (int i = 0; i < 16; ++i) acc[t2][i] = 0.f;
            const LAS unsigned char* qbase = lds + MC_QI + r * MC_QROW + hf * 8;
#pragma unroll
            for (int dt = 0; dt < 8; ++dt) { const bf16x8 cl = pack_lo(C[dt]), chh = pack_hi(C[dt]);
#pragma unroll
                for (int t2 = 0; t2 < 2; ++t2) { const LAS unsigned char* qb = qbase + t2 * 32 * MC_QROW + dt * 64;
                    const s16x4 a0l = *(const LAS s16x4*)(qb), a0h = *(const LAS s16x4*)(qb + 16), a1l = *(const LAS s16x4*)(qb + 32), a1h = *(const LAS s16x4*)(qb + 48);
                    acc[t2] = MFMA32(__builtin_shufflevector(a0l, a0h, 0, 1, 2, 3, 4, 5, 6, 7), cl, acc[t2]);
                    acc[t2] = MFMA32(__builtin_shufflevector(a1l, a1h, 0, 1, 2, 3, 4, 5, 6, 7), chh, acc[t2]); } }
#pragma unroll
            for (int t2 = 0; t2 < 2; ++t2)
#pragma unroll
                for (int i = 0; i < 16; ++i) acc[t2][i] *= mc_sc(lds, 2)[32 * t2 + crow(i, hf)];
            bf16x8 vt[4];
            const LAS unsigned char* vbase = lds + MC_VT + (32 * wave + r) * MC_TROW + hf * 16;
#pragma unroll
            for (int ks = 0; ks < 4; ++ks) vt[ks] = *(const LAS bf16x8*)(vbase + ks * 32);
            const LAS unsigned char* pbase = lds + MC_P + r * MC_TROW + hf * 16;
#pragma unroll
            for (int t2 = 0; t2 < 2; ++t2)
#pragma unroll
                for (int ks = 0; ks < 4; ++ks) { const bf16x8 pA = *(const LAS bf16x8*)(pbase + t2 * 32 * MC_TROW + ks * 32); acc[t2] = MFMA32(pA, vt[ks], acc[t2]); }
            asm volatile("" : "+v"(acc[0]), "+v"(acc[1]));
#pragma unroll
            for (int ks = 0; ks < 4; ++ks) {
                const f32x4 w0 = *(const LAS f32x4*)(mc_sc(lds, 3) + 16 * ks + 8 * hf), w1 = *(const LAS f32x4*)(mc_sc(lds, 3) + 16 * ks + 8 * hf + 4);
                const u32x4 vv = __builtin_bit_cast(u32x4, vt[ks]); u32x4 o;
                o.x = pk2(bflo(vv.x) * w0.x, bfhi(vv.x) * w0.y); o.y = pk2(bflo(vv.y) * w0.z, bfhi(vv.y) * w0.w); o.z = pk2(bflo(vv.z) * w1.x, bfhi(vv.z) * w1.y); o.w = pk2(bflo(vv.w) * w1.z, bfhi(vv.w) * w1.w);
                vt[ks] = __builtin_bit_cast(bf16x8, o); }
            const LAS unsigned char* kbase = lds + MC_KT + r * MC_TROW + hf * 16;
#pragma unroll
            for (int dt = 0; dt < 8; ++dt) {
#pragma unroll
                for (int i = 0; i < 16; ++i) C[dt][i] *= cd;
#pragma unroll
                for (int ks = 0; ks < 4; ++ks) { const bf16x8 kA = *(const LAS bf16x8*)(kbase + dt * 32 * MC_TROW + ks * 32); C[dt] = MFMA32(kA, vt[ks], C[dt]); } }
            if (tC < 256) { float sacc = cd * nvec[tC];
#pragma unroll
                for (int k = 0; k < 8; ++k) { const u32x4 kv = *(const LAS u32x4*)(lds + MC_KT + tC * MC_TROW + k * 16);
                    const f32x4 w0 = *(const LAS f32x4*)(mc_sc(lds, 3) + k * 8), w1 = *(const LAS f32x4*)(mc_sc(lds, 3) + k * 8 + 4);
                    sacc += bflo(kv.x) * w0.x + bfhi(kv.x) * w0.y + bflo(kv.y) * w0.z + bfhi(kv.y) * w0.w + bflo(kv.z) * w1.x + bfhi(kv.z) * w1.y + bflo(kv.w) * w1.z + bfhi(kv.w) * w1.w; }
                nvec[tC] = sacc; }
            }
            __syncthreads();
            { OPQ(tD); const int laneD = tD & 63, r = laneD & 31, hf = laneD >> 5;
              u32x2 zr[8];
#pragma unroll
              for (int k = 0; k < 8; ++k) zr[k] = *(const u32x2*)(ZM + (rowbase + 8 * wave + k) * 1024 + hd * MD + 4 * laneD);
              const f32x4 mhn = *(const f32x4*)(mh_norm + hd * MD + 4 * laneD), skp = *(const f32x4*)(skip + hd * MD + 4 * laneD);
#pragma unroll
              for (int t2 = 0; t2 < 2; ++t2)
#pragma unroll
                for (int i = 0; i < 16; ++i) *(LAS float*)(lds + MC_QI + (32 * t2 + crow(i, hf)) * MC_STROW + (32 * wave + r) * 4) = acc[t2][i];
              __syncthreads();
#pragma unroll
              for (int k = 0; k < 8; ++k) { const int t = 8 * wave + k; const float rden = mc_sc(lds, 6)[t];
                  const f32x4 h4 = *(const LAS f32x4*)(lds + MC_QI + t * MC_STROW + 16 * laneD) * rden;
                  const float s1 = wave_sum((h4.x + h4.y) + (h4.z + h4.w)), s2 = wave_sum((h4.x * h4.x + h4.y * h4.y) + (h4.z * h4.z + h4.w * h4.w));
                  const float mean = s1 * (1.0f / MD); const float var = fmaxf(s2 * (1.0f / MD) - mean * mean, 0.f); const float rstd = frsq(var + LN_EPS);
                  const float y0 = ((h4.x - mean) * rstd * mhn.x + skp.x * bflo(xcp[k].x)) * silu_f(bflo(zr[k].x)), y1 = ((h4.y - mean) * rstd * mhn.y + skp.y * bfhi(xcp[k].x)) * silu_f(bfhi(zr[k].x));
                  const float y2 = ((h4.z - mean) * rstd * mhn.z + skp.z * bflo(xcp[k].y)) * silu_f(bflo(zr[k].y)), y3 = ((h4.w - mean) * rstd * mhn.w + skp.w * bfhi(xcp[k].y)) * silu_f(bfhi(zr[k].y));
                  u32x2 o; o.x = pk2(y0, y1); o.y = pk2(y2, y3);
                  *(u32x2*)(QK + (rowbase + t) * 2048 + 1024 + hd * MD + 4 * laneD) = o; } }
            __syncthreads();
        }
    }
#undef OPQ
}

DI void phase_final(const Args& a, int lane, int wave, int bid, int G, int dry) {
    const float* x = a.in[0]; const float* g_post = a.in[3]; float* out = a.out;
    const int gw = bid * NWAVES + wave, NGW = G * NWAVES;
    const f32x4* gr = (const f32x4*)g_post + lane; f32x4 gg[4];
#pragma unroll
    for (int j = 0; j < 4; ++j) gg[j] = gr[64 * j];
    for (int m = gw; m < MTOK; m += NGW) {
        f32x4* yr = (f32x4*)(out + (size_t)m * DM) + lane; const f32x4* xr = (const f32x4*)(x + (size_t)m * DM) + lane; f32x4 v[4], xv[4]; float s = 0.f;
#pragma unroll
        for (int j = 0; j < 4; ++j) { v[j] = yr[64 * j]; xv[j] = xr[64 * j]; s += (v[j].x * v[j].x + v[j].y * v[j].y) + (v[j].z * v[j].z + v[j].w * v[j].w); }
        const float rstd = 1.0f / sqrtf(wave_sum(s) * (1.0f / DM) + RMS_EPS);
#pragma unroll
        for (int j = 0; j < 4; ++j) { f32x4 o; o.x = xv[j].x + v[j].x * rstd * gg[j].x; o.y = xv[j].y + v[j].y * rstd * gg[j].y; o.z = xv[j].z + v[j].z * rstd * gg[j].z; o.w = xv[j].w + v[j].w * rstd * gg[j].w; if (!dry) yr[64 * j] = o; else asm volatile("" :: "v"(o)); }
    }
}

#define XB_TMO      128
#define XB_XCNT(j)  (256  + 64 * (j))
#define XB_XSUB(j)  (1280 + 64 * (j))
#define XB_XGEN(j)  (2304 + 64 * (j))
#define XB_TOP      3328
#define XB_TOPGEN   3392
#define XCD_BAR_WORDS 3456
#define XB_SPIN_CAP (1u << 18)

__device__ __forceinline__ unsigned xb_ld(unsigned* p)              { return __hip_atomic_load(p, __ATOMIC_RELAXED, __HIP_MEMORY_SCOPE_AGENT); }
__device__ __forceinline__ unsigned xb_add(unsigned* p, unsigned v) { return __hip_atomic_fetch_add(p, v, __ATOMIC_RELAXED, __HIP_MEMORY_SCOPE_AGENT); }
__device__ __forceinline__ unsigned xb_xcc_id() { return (unsigned)__builtin_amdgcn_s_getreg((3 << 11) | 20) & 0xFu; }
#define XB_SPIN(cond, bar) do { unsigned _sp = 0; while (cond) { __builtin_amdgcn_s_sleep(1); \
    if ((++_sp & 255u) == 0u) { if (xb_ld(&(bar)[XB_TMO])) break; if (_sp > XB_SPIN_CAP) { atomicAdd(&(bar)[XB_TMO], 1u); break; } } } } while (0)

struct XcdBarrier {
    unsigned* bar; unsigned x;
    volatile LAS unsigned* st;
};

__device__ __forceinline__ XcdBarrier xcd_barrier_post(unsigned* bar, volatile LAS unsigned* st) {
    XcdBarrier b; b.bar = bar; b.x = xb_xcc_id(); b.st = st;
    if (threadIdx.x == 0) (void)xb_add(&bar[XB_XCNT(b.x)], 1u);
    return b;
}
__device__ __forceinline__ void xcd_barrier_complete(unsigned* bar, unsigned x, unsigned& nloc, unsigned& nx) {
    const unsigned G = gridDim.x * gridDim.y * gridDim.z;
    unsigned sum, cnt, mine, sp = 0u;
    for (;;) {
        sum = 0u; cnt = 0u; mine = 0u;
#pragma unroll
        for (unsigned j = 0; j < 16; ++j) { const unsigned c = xb_ld(&bar[XB_XCNT(j)]); sum += c; cnt += (c > 0u) ? 1u : 0u; mine = (j == x) ? c : mine; }
        if (sum == G) break;
        __builtin_amdgcn_s_sleep(1);
        if ((++sp & 255u) == 0u) { if (xb_ld(&bar[XB_TMO])) break; if (sp > XB_SPIN_CAP) { atomicAdd(&bar[XB_TMO], 1u); break; } }
    }
    nloc = mine > 0u ? mine : 1u; nx = cnt > 0u ? cnt : 1u;
}

__device__ __forceinline__ void xcd_barrier(const XcdBarrier& b) {
    asm volatile("s_waitcnt vmcnt(0)" ::: "memory");
    __syncthreads();
    if (threadIdx.x == 0) {
        unsigned* bar = b.bar;
        __builtin_amdgcn_s_waitcnt(0);
        unsigned nloc = b.st[0], nx = b.st[1];
        if (nloc == 0u) { xcd_barrier_complete(bar, b.x, nloc, nx); b.st[0] = nloc; b.st[1] = nx; }
        const unsigned old = xb_add(&bar[XB_XSUB(b.x)], 1u);
        const unsigned gen = old / nloc;
        if (old + 1u == (gen + 1u) * nloc) {
            __builtin_amdgcn_fence(__ATOMIC_RELEASE, "agent");
            asm volatile("s_waitcnt vmcnt(0)" ::: "memory");
            const unsigned og = xb_add(&bar[XB_TOP], 1u);
            const unsigned tg = og / nx;
            if (og + 1u == (tg + 1u) * nx) xb_add(&bar[XB_TOPGEN], 1u);
            else XB_SPIN(xb_ld(&bar[XB_TOPGEN]) == tg, bar);
            __builtin_amdgcn_fence(__ATOMIC_ACQUIRE, "agent");
            xb_add(&bar[XB_XGEN(b.x)], 1u);
            asm volatile("s_waitcnt vmcnt(0)" ::: "memory");
        } else {
            XB_SPIN(xb_ld(&bar[XB_XGEN(b.x)]) == gen, bar);
            __builtin_amdgcn_fence(__ATOMIC_ACQUIRE, "agent");
            asm volatile("s_waitcnt vmcnt(0)" ::: "memory");
        }
    }
    __syncthreads();
}

constexpr int NPHASE = 12;
#ifndef DUP_PHASE
#define DUP_PHASE -1
#endif
#define NREP(k) (DUP_PHASE == (k) ? 2 : 1)
#ifndef MK_MULTI
#define MK_MULTI 0
#endif
__global__ void __launch_bounds__(NTHR, 2) hymba_fwd(Args args) {
    extern __shared__ __attribute__((aligned(16))) unsigned char lds_raw[];
    LAS unsigned char* lds = (LAS unsigned char*)lds_raw;
    cg::grid_group grid = cg::this_grid();
    const int tid = threadIdx.x, lane = tid & 63, wave = __builtin_amdgcn_readfirstlane(tid >> 6), bid = blockIdx.x, G = gridDim.x;
    const int lo = args.ph_lo, hi = args.ph_hi;
#ifdef ONLY_PHASE
#define IN(k) ((k) == ONLY_PHASE && lo <= (k) && (k) < hi)
#else
#define IN(k) (lo <= (k) && (k) < hi)
#endif
    unsigned char* ws = args.ws;
    volatile LAS unsigned* barst = (volatile LAS unsigned*)(lds + LDS_BARST);
    if (tid < 2) barst[tid] = 0u;
    __syncthreads();
    XcdBarrier xbar = xcd_barrier_post((unsigned*)(ws + WS_CTL) + CW_BAR, barst);
#define SEAM(k) do { if (IN(k) && IN((k) + 1)) { if ((k) == 0) grid.sync(); else xcd_barrier(xbar); } } while (0)
#undef DUPSYNC
    if (IN(0)) { for (int rep = 0; rep < NREP(0); ++rep) { if (rep) xcd_barrier(xbar); int t_ = tid; asm volatile("" : "+v"(t_)); phase_prologue(args, lds, t_, t_ & 63, wave, bid, G); } } SEAM(0);
    if (IN(1)) {
        pg8::Gemm g{(const pg8::bf16_t*)(ws + WS_XN), (const pg8::bf16_t*)(ws + WS_WINT), MTOK, NIN, DM}; pg8::StaticOrder S; S.init(MTOK, NIN, G, bid);
        pg8::EpiProj E{(pg8::bf16_t*)(ws + WS_QK), (pg8::bf16_t*)(ws + WS_V), (pg8::bf16_t*)(ws + WS_G), (pg8::bf16_t*)(ws + WS_XM), (pg8::bf16_t*)(ws + WS_ZM), QSCALE};
        for (int rep = 0; rep < NREP(1); ++rep) { if (rep) xcd_barrier(xbar); pg8::gemm_phase<pg8::EpiProj, pg8::StaticOrder, true, true>(lds, g, S, E); }
    } SEAM(1);
    if (IN(2)) { for (int rep = 0; rep < NREP(2); ++rep) { if (rep) xcd_barrier(xbar); int t_ = tid; asm volatile("" : "+v"(t_)); phase_kstat(args, lds, t_, t_ & 63, wave, bid, G); } } SEAM(2);
    if (IN(3)) { for (int rep = 0; rep < NREP(3); ++rep) { if (rep) xcd_barrier(xbar); int t_ = tid; asm volatile("" : "+v"(t_)); phase_sel(args, lds, t_, t_ & 63, wave, bid, G, rep); } } SEAM(3);
    if (IN(4)) { for (int rep = 0; rep < NREP(4); ++rep) { if (rep) xcd_barrier(xbar); int t_ = tid; asm volatile("" : "+v"(t_)); phase_att_gather(args, lds, t_, t_ & 63, wave, bid, G, rep); } } SEAM(4);
    if (IN(5)) { for (int rep = 0; rep < NREP(5); ++rep) { if (rep) xcd_barrier(xbar); int t_ = tid; asm volatile("" : "+v"(t_)); phase_att_own(args, lds, t_, t_ & 63, wave, bid, G, rep); } } SEAM(5);
    if (IN(6)) { for (int rep = 0; rep < NREP(6); ++rep) { if (rep) xcd_barrier(xbar); int t_ = tid; asm volatile("" : "+v"(t_)); phase_mgate(args, lds, t_, t_ & 63, wave, bid, G); } } SEAM(6);
    if (IN(7)) { for (int rep = 0; rep < NREP(7); ++rep) { if (rep) xcd_barrier(xbar); int t_ = tid; asm volatile("" : "+v"(t_)); phase_mstate(args, lds, t_, t_ & 63, wave, bid, G); } } SEAM(7);
    if (IN(8)) { for (int rep = 0; rep < NREP(8); ++rep) { if (rep) xcd_barrier(xbar); phase_mcomb(args, tid, bid, G, rep); } } SEAM(8);
    if (IN(9)) { for (int rep = 0; rep < NREP(9); ++rep) { if (rep) xcd_barrier(xbar); int t_ = tid; asm volatile("" : "+v"(t_)); phase_mscan(args, lds, t_, t_ & 63, wave, bid, G); } } SEAM(9);
    if (IN(10)) {
        pg8::Gemm g{(const pg8::bf16_t*)(ws + WS_QK), (const pg8::bf16_t*)(ws + WS_WOUTT), MTOK, DM, MIXW}; pg8::StaticOrder S; S.init(MTOK, DM, G, bid);
        pg8::EpiF32 E{args.out, DM};
        for (int rep = 0; rep < NREP(10); ++rep) { if (rep) xcd_barrier(xbar); pg8::gemm_phase<pg8::EpiF32, pg8::StaticOrder, true, true>(lds, g, S, E); }
    } SEAM(10);
    if (IN(11)) { for (int rep = 0; rep < NREP(11); ++rep) { if (rep) xcd_barrier(xbar); phase_final(args, lane, wave, bid, G, rep); } }
#undef IN
#undef SEAM
}

extern "C" void kernel_launch(void* const* d_in, const int* in_sizes, int n_in, void* d_out, int out_size, void* d_ws, size_t ws_size, hipStream_t stream) {
    static int grid = 0;
    if (grid == 0) {
        if (n_in != 15 || out_size != MTOK * DM || ws_size < WS_END) { fprintf(stderr, "kernel_launch: unexpected shapes (n_in %d out %d ws %zu)\n", n_in, out_size, ws_size); grid = -1; return; }
        int dev = 0, cus = 0, per_cu = 0;
        if (hipGetDevice(&dev) != hipSuccess || hipDeviceGetAttribute(&cus, hipDeviceAttributeMultiprocessorCount, dev) != hipSuccess) { grid = -1; return; }
        if (hipFuncSetAttribute((const void*)hymba_fwd, hipFuncAttributeMaxDynamicSharedMemorySize, LDS_BYTES) != hipSuccess) { fprintf(stderr, "kernel_launch: hipFuncSetAttribute failed\n"); grid = -1; return; }
        if (hipOccupancyMaxActiveBlocksPerMultiprocessor(&per_cu, (const void*)hymba_fwd, NTHR, LDS_BYTES) != hipSuccess || per_cu < 1) { fprintf(stderr, "kernel_launch: occupancy query says %d\n", per_cu); per_cu = 1; }
        (void)hipGetLastError();
        grid = cus * 1;
        fprintf(stderr, "kernel_launch: grid %d (cus %d, query per_cu %d)\n", grid, cus, per_cu);
    }
    if (grid < 0) return;
    (void)hipMemsetAsync((char*)d_ws + WS_CTL, 0, CTL_ZERO_BYTES, stream);
    Args a{};
    for (int i = 0; i < 15; ++i) a.in[i] = (const float*)d_in[i];
    a.out = (float*)d_out; a.ws = (unsigned char*)d_ws;
#if MK_MULTI
    for (int p = 0; p < NPHASE; ++p) { a.ph_lo = p; a.ph_hi = p + 1; hipLaunchKernelGGL(hymba_fwd, dim3(grid), dim3(NTHR), LDS_BYTES, stream, a); }
#else
    a.ph_lo = 0; a.ph_hi = NPHASE;
    void* kargs[] = {&a};
    hipError_t e = hipLaunchCooperativeKernel((const void*)hymba_fwd, dim3(grid), dim3(NTHR), kargs, LDS_BYTES, stream);
    if (e != hipSuccess) fprintf(stderr, "kernel_launch: cooperative launch failed: %s (grid %d)\n", hipGetErrorString(e), grid);
#endif
}
```

```cpp
#include <hip/hip_runtime.h>
#include <hip/hip_cooperative_groups.h>
#include <cstdio>
#include <cstdint>
namespace cg = cooperative_groups;
namespace pg8 {
#define PG8_LAS __attribute__((address_space(3)))
typedef unsigned short bf16_t;
typedef short bf16x8 __attribute__((ext_vector_type(8)));
typedef float f32x4 __attribute__((ext_vector_type(4)));
typedef unsigned u32x4 __attribute__((ext_vector_type(4)));
constexpr int BM = 256, BK = 64, HALF = 128, HTB = HALF * BK * 2  , STAGE_BYTES = 8 * HTB, NXCD = 8, WGM = 8;

__host__ __device__ __forceinline__ int lds_byte(int r, int c) { const int st = (r >> 4) * 2 + (c >> 5), rr = r & 15, cc = c & 31, ob = rr * 64 + cc * 2; return st * 1024 + (ob ^ (((ob >> 9) & 1) << 5)); }
__host__ __device__ __forceinline__ void stage_rc(int b, int& R, int& C) { const int st = b / 1024, sb = b % 1024, swz = sb ^ (((sb >> 9) & 1) << 5); R = (st >> 1) * 16 + swz / 64; C = (st & 1) * 32 + (swz % 64) / 2; }
__host__ __device__ __forceinline__ int perm32(int rho) { const int n = rho >> 4, i = rho & 15; return 8 * (i >> 2) + 4 * n + (i & 3); }

struct Unit { int pm, pn; };
struct Gemm { const bf16_t* A; const bf16_t* Bt; int M, N, K; };

struct StaticOrder {
    int nM, nN, nwg, G, c;
    __host__ __device__ void init(int M, int N, int G_, int c_) { nM = M / BM; nN = N / BM; nwg = nM * nN; G = G_; c = c_; }
    __host__ __device__ bool next(int i, Unit& u) const {
        const long L = (long)i * G + c; if (L >= nwg) return false;
        int wgid = (int)L; { const int q = nwg / NXCD, r = nwg % NXCD, xcd = wgid % NXCD, off = wgid / NXCD; wgid = (xcd < r ? xcd * (q + 1) : r * (q + 1) + (xcd - r) * q) + off; }
        const int nig = WGM * nN, gid = wgid / nig, fm = gid * WGM, gsz = (nM - fm) < WGM ? (nM - fm) : WGM;
        u.pm = fm + ((wgid % nig) % gsz); u.pn = (wgid % nig) / gsz; return true;
    }
    __device__ __forceinline__ void a_ready(const Unit&) const {}
    __device__ __forceinline__ void done(const Unit&) const {}
};

__device__ __forceinline__ unsigned cvt_pk_bf16(float lo, float hi) { unsigned r; asm volatile("v_cvt_pk_bf16_f32 %0, %1, %2" : "=v"(r) : "v"(lo), "v"(hi)); return r; }
typedef float f32x2 __attribute__((ext_vector_type(2)));
struct EpiProj {
    static constexpr bool PERM = true, AFTER_DRAIN = false;
    bf16_t* QK; bf16_t* V; bf16_t* G; bf16_t* XM; bf16_t* ZM; float qscale; float* KMEAN; float* KABS;
    __device__ __forceinline__ void operator()(const f32x4 (&acc)[2][2][4][2], const Unit& u, int wr, int wc, int fr, int fq) const {
        const int row0 = u.pm * BM + wr * 64 + fr; const int colt = u.pn * BM; const int t = colt >> 10; const int cgp = colt & 1023;
        bf16_t* base; int ldc; float sc = 1.f;
        if (t == 0) { base = QK; ldc = 2048; sc = qscale; } else if (t == 1) { base = QK + 1024; ldc = 2048; } else if (t == 2) { base = V; ldc = 1024; }
        else if (t == 3) { base = G; ldc = 1024; } else if (t == 4) { base = XM; ldc = 1024; } else { base = ZM; ldc = 1024; }
        const int col0 = cgp + wc * 32 + 8 * fq;
#pragma unroll
        for (int ai = 0; ai < 2; ++ai)
#pragma unroll
            for (int m = 0; m < 4; ++m) { bf16_t* rowp = base + (size_t)(row0 + ai * HALF + m * 16) * ldc + col0;
#pragma unroll
                for (int bj = 0; bj < 2; ++bj) { f32x4 v0 = acc[ai][bj][m][0] * sc, v1 = acc[ai][bj][m][1] * sc;
                    u32x4 w; w.x = cvt_pk_bf16(v0[0], v0[1]); w.y = cvt_pk_bf16(v0[2], v0[3]); w.z = cvt_pk_bf16(v1[0], v1[1]); w.w = cvt_pk_bf16(v1[2], v1[3]);
                    *(u32x4*)(rowp + bj * HALF) = w; } }
        if (t == 1) {
            const int b = u.pm >> 5, blk = u.pm & 31;
#pragma unroll
            for (int bj = 0; bj < 2; ++bj)
#pragma unroll
                for (int n = 0; n < 2; ++n) { f32x4 s = {0.f, 0.f, 0.f, 0.f}, mx = {0.f, 0.f, 0.f, 0.f};
#pragma unroll
                    for (int ai = 0; ai < 2; ++ai)
#pragma unroll
                        for (int m = 0; m < 4; ++m) { const f32x4 v = acc[ai][bj][m][n]; s += v; mx[0] = fmaxf(mx[0], fabsf(v[0])); mx[1] = fmaxf(mx[1], fabsf(v[1])); mx[2] = fmaxf(mx[2], fabsf(v[2])); mx[3] = fmaxf(mx[3], fabsf(v[3])); }
#pragma unroll
                    for (int o = 1; o < 16; o <<= 1)
#pragma unroll
                        for (int e = 0; e < 4; ++e) { s[e] += __shfl_xor(s[e], o); mx[e] = fmaxf(mx[e], __shfl_xor(mx[e], o)); }
                    if (fr == 0) { const int col = cgp + bj * HALF + wc * 32 + 8 * fq + 4 * n; const int head = col >> 7, d = col & 127;
                        const size_t idx = ((size_t)((wr * 32 + b * 8 + head) * 32 + blk)) * 128 + d;
                        *(f32x4*)(KMEAN + idx) = s * (1.0f / 256.0f); *(f32x4*)(KABS + idx) = mx; } }
        }
    }
};
struct EpiF32 {
    static constexpr bool PERM = false, AFTER_DRAIN = false;
    float* O; int ldc;
    __device__ __forceinline__ void operator()(const f32x4 (&acc)[2][2][4][2], const Unit& u, int wr, int wc, int fr, int fq) const {
        const int col0 = u.pn * BM + wc * 32 + 4 * fq;
#pragma unroll
        for (int ai = 0; ai < 2; ++ai)
#pragma unroll
            for (int m = 0; m < 4; ++m) { const int r = ai * HALF + wr * 64 + m * 16 + fr; const size_t off = (size_t)(u.pm * BM + r) * ldc + col0;
#pragma unroll
                for (int bj = 0; bj < 2; ++bj)
#pragma unroll
                    for (int n = 0; n < 2; ++n) *(f32x4*)(O + off + bj * HALF + n * 16) = acc[ai][bj][m][n]; }
    }
};
template <class Epi, class Sched, bool ALIGN_EPI = false, bool SP2 = false>
__device__ __forceinline__ void gemm_phase(PG8_LAS unsigned char* lds, const Gemm g, const Sched& S, const Epi& E) {
    const int tid = threadIdx.x, wid = __builtin_amdgcn_readfirstlane(tid >> 6), lane = tid & 63, wr = wid >> 2, wc = wid & 3, fr = lane & 15, fq = lane >> 4;
    const int K = g.K, nt = K / BK;
    unsigned voffA[2], voffB[2];
#pragma unroll
    for (int i = 0; i < 2; ++i) { int R, C; stage_rc(tid * 16 + i * 8192, R, C); const int Rb = Epi::PERM ? ((R & ~31) + perm32(R & 31)) : R;
        voffA[i] = (unsigned)(R * K + C) * 2u; voffB[i] = (unsigned)(Rb * K + C) * 2u; }
    const size_t kstep = (size_t)(BK * 2);
    const size_t hstep = (size_t)HALF * K * 2;
    const size_t tstep = 2 * hstep;
    const unsigned ldsw = (unsigned)wid * 1024u;
    const int aoff = lds_byte(wr * 64 + fr, fq * 8), boff = lds_byte(wc * 32 + fr, fq * 8);
#define PG8_SA(b, h) (((b) * 2 + (h)) * HTB)
#define PG8_SB(b, h) ((4 + (b) * 2 + (h)) * HTB)
#define PG8_STAGE(bufoff, gbase, voff) do { _Pragma("unroll") for (int _i = 0; _i < 2; ++_i) \
        __builtin_amdgcn_global_load_lds((const unsigned*)((const char*)(gbase) + (voff)[_i]), (PG8_LAS unsigned*)(lds + (bufoff) + ldsw + _i * 8192), 16, 0, 0); } while (0)
#define PG8_LDA(dst, b, h) do { _Pragma("unroll") for (int m = 0; m < 4; ++m) _Pragma("unroll") for (int k = 0; k < 2; ++k) dst[m][k] = *(const PG8_LAS bf16x8*)(lds + PG8_SA(b, h) + aoff + m * 2048 + k * 1024); } while (0)
#define PG8_LDB(dst, b, h) do { _Pragma("unroll") for (int n = 0; n < 2; ++n) _Pragma("unroll") for (int k = 0; k < 2; ++k) dst[n][k] = *(const PG8_LAS bf16x8*)(lds + PG8_SB(b, h) + boff + n * 2048 + k * 1024); } while (0)
#define PG8_MMA(ai, bj, At, Bt) do { __builtin_amdgcn_s_setprio(1); _Pragma("unroll") for (int m = 0; m < 4; ++m) _Pragma("unroll") for (int n = 0; n < 2; ++n) _Pragma("unroll") for (int k = 0; k < 2; ++k) \
        acc[ai][bj][m][n] = __builtin_amdgcn_mfma_f32_16x16x32_bf16(Bt[n][k], At[m][k], acc[ai][bj][m][n], 0, 0, 0); __builtin_amdgcn_s_setprio(0); } while (0)
#define PG8_WAIT_V(n) asm volatile("s_waitcnt vmcnt(" #n ")" ::: "memory")
#define PG8_WAIT_L(n) asm volatile("s_waitcnt lgkmcnt(" #n ")" ::: "memory")
#define PG8_BAR __builtin_amdgcn_s_barrier()
#define PG8_SCHED __builtin_amdgcn_sched_barrier(0)
    Unit cur, nxt; int ui = 0;
    if (!S.next(0, cur)) return;
    f32x4 acc[2][2][4][2];
#pragma unroll
    for (int a = 0; a < 2; ++a)
#pragma unroll
        for (int b = 0; b < 2; ++b)
#pragma unroll
            for (int m = 0; m < 4; ++m)
#pragma unroll
                for (int n = 0; n < 2; ++n) acc[a][b][m][n] = (f32x4){0.f, 0.f, 0.f, 0.f};
    bf16x8 At[4][2], B0[2][2], B1[2][2];
    const char* cA = (const char*)g.A + (size_t)cur.pm * tstep; const char* cB = (const char*)g.Bt + (size_t)cur.pn * tstep;
    S.a_ready(cur);
    if constexpr (SP2) {
        PG8_STAGE(PG8_SB(0, 0), cB, voffB); PG8_STAGE(PG8_SB(0, 1), cB + hstep, voffB); PG8_STAGE(PG8_SA(0, 0), cA, voffA); PG8_STAGE(PG8_SA(0, 1), cA + hstep, voffA);
        if (wr == 1) PG8_BAR;
        PG8_WAIT_V(2); PG8_BAR;
        PG8_STAGE(PG8_SB(1, 0), cB + kstep, voffB); PG8_STAGE(PG8_SA(1, 0), cA + kstep, voffA); PG8_STAGE(PG8_SB(1, 1), cB + hstep + kstep, voffB);
        PG8_WAIT_V(6); PG8_BAR;
    } else {
        PG8_STAGE(PG8_SB(0, 0), cB, voffB); PG8_STAGE(PG8_SA(0, 0), cA, voffA); PG8_STAGE(PG8_SB(0, 1), cB + hstep, voffB); PG8_STAGE(PG8_SA(0, 1), cA + hstep, voffA);
        if (wr == 1) PG8_BAR;
        PG8_WAIT_V(4); PG8_BAR;
        PG8_STAGE(PG8_SB(1, 0), cB + kstep, voffB); PG8_STAGE(PG8_SA(1, 0), cA + kstep, voffA); PG8_STAGE(PG8_SB(1, 1), cB + hstep + kstep, voffB);
        PG8_WAIT_V(6); PG8_BAR;
    }
    for (;;) {
        const bool has_next = S.next(ui + 1, nxt);
        const char* nA = has_next ? (const char*)g.A + (size_t)nxt.pm * tstep : cA; const char* nB = has_next ? (const char*)g.Bt + (size_t)nxt.pn * tstep : cB;
        for (int t = 0; t < nt; t += 2) {
            const bool last = (t == nt - 2);
            const char* a1 = cA + (size_t)(t + 1) * kstep;
            const char* a2 = last ? nA : cA + (size_t)(t + 2) * kstep; const char* b2 = last ? nB : cB + (size_t)(t + 2) * kstep;
            const char* a3 = a2 + kstep; const char* b3 = b2 + kstep;
            if (last && has_next) S.a_ready(nxt);
            if constexpr (SP2) {
            PG8_LDB(B0, 0, 0); PG8_LDB(B1, 0, 1); PG8_SCHED; PG8_LDA(At, 0, 0); PG8_STAGE(PG8_SA(1, 1), a1 + hstep, voffA);
            PG8_WAIT_V(8); PG8_WAIT_L(0); PG8_BAR; PG8_MMA(0, 0, At, B0); PG8_MMA(0, 1, At, B1); PG8_BAR; PG8_SCHED;
            PG8_LDA(At, 0, 1); PG8_STAGE(PG8_SB(0, 0), b2, voffB); PG8_STAGE(PG8_SB(0, 1), b2 + hstep, voffB); PG8_STAGE(PG8_SA(0, 0), a2, voffA);
            PG8_WAIT_V(8); PG8_WAIT_L(0); PG8_BAR; PG8_MMA(1, 0, At, B0); PG8_MMA(1, 1, At, B1); PG8_BAR; PG8_SCHED;
            PG8_LDB(B0, 1, 0); PG8_LDB(B1, 1, 1); PG8_SCHED; PG8_LDA(At, 1, 0); PG8_STAGE(PG8_SA(0, 1), a2 + hstep, voffA);
            PG8_WAIT_V(8); PG8_WAIT_L(0); PG8_BAR; PG8_MMA(0, 0, At, B0); PG8_MMA(0, 1, At, B1); PG8_BAR; PG8_SCHED;
            PG8_LDA(At, 1, 1); PG8_STAGE(PG8_SB(1, 0), b3, voffB); PG8_STAGE(PG8_SB(1, 1), b3 + hstep, voffB); PG8_STAGE(PG8_SA(1, 0), a3, voffA);
            PG8_WAIT_V(8); PG8_WAIT_L(0); PG8_BAR; PG8_MMA(1, 0, At, B0); PG8_MMA(1, 1, At, B1); PG8_BAR; PG8_SCHED;
            } else {
            PG8_LDB(B0, 0, 0); PG8_SCHED; PG8_LDA(At, 0, 0); PG8_STAGE(PG8_SA(1, 1), a1 + hstep, voffA);
            PG8_WAIT_L(8); PG8_BAR; PG8_WAIT_L(0); PG8_MMA(0, 0, At, B0); PG8_BAR; PG8_SCHED;
            PG8_LDB(B1, 0, 1); PG8_STAGE(PG8_SB(0, 0), b2, voffB);
            PG8_BAR; PG8_WAIT_L(0); PG8_MMA(0, 1, At, B1); PG8_BAR;
            PG8_LDA(At, 0, 1); PG8_STAGE(PG8_SA(0, 0), a2, voffA);
            PG8_BAR; PG8_WAIT_L(0); PG8_MMA(1, 0, At, B0); PG8_BAR; PG8_SCHED;
            PG8_STAGE(PG8_SB(0, 1), b2 + hstep, voffB);
            PG8_WAIT_V(6); PG8_BAR; PG8_MMA(1, 1, At, B1); PG8_BAR;
            PG8_LDB(B0, 1, 0); PG8_SCHED; PG8_LDA(At, 1, 0); PG8_STAGE(PG8_SA(0, 1), a2 + hstep, voffA);
            PG8_WAIT_L(8); PG8_BAR; PG8_WAIT_L(0); PG8_MMA(0, 0, At, B0); PG8_BAR; PG8_SCHED;
            PG8_LDB(B1, 1, 1); PG8_STAGE(PG8_SB(1, 0), b3, voffB);
            PG8_BAR; PG8_WAIT_L(0); PG8_MMA(0, 1, At, B1); PG8_BAR;
            PG8_LDA(At, 1, 1); PG8_STAGE(PG8_SA(1, 0), a3, voffA);
            PG8_BAR; PG8_WAIT_L(0); PG8_MMA(1, 0, At, B0); PG8_BAR; PG8_SCHED;
            PG8_STAGE(PG8_SB(1, 1), b3 + hstep, voffB);
            PG8_WAIT_V(6); PG8_BAR; PG8_MMA(1, 1, At, B1); PG8_BAR;
            }
        }
        if constexpr (ALIGN_EPI) { if (wr == 0) PG8_BAR; }
        if constexpr (!Epi::AFTER_DRAIN) { E(acc, cur, wr, wc, fr, fq); S.done(cur); }
        if (!has_next) break;
#pragma unroll
        for (int a = 0; a < 2; ++a)
#pragma unroll
            for (int b = 0; b < 2; ++b)
#pragma unroll
                for (int m = 0; m < 4; ++m)
#pragma unroll
                    for (int n = 0; n < 2; ++n) acc[a][b][m][n] = (f32x4){0.f, 0.f, 0.f, 0.f};
        cur = nxt; cA = nA; cB = nB; ++ui;
        if constexpr (ALIGN_EPI) { if (wr == 1) PG8_BAR; }
    }
    PG8_WAIT_V(0);
    if constexpr (!ALIGN_EPI) { if (wr == 0) PG8_BAR; }
    PG8_BAR;
    if constexpr (Epi::AFTER_DRAIN) { E.fused(acc, cur, wr, wc, fr, fq, lds, wid, lane); S.done(cur); }
#undef PG8_SA
#undef PG8_SB
#undef PG8_STAGE
#undef PG8_LDA
#undef PG8_LDB
#undef PG8_MMA
#undef PG8_WAIT_V
#undef PG8_WAIT_L
#undef PG8_BAR
#undef PG8_SCHED
}
}

constexpr int NWAVES = 8, NTHR = 512;
constexpr int BATCH = 4, SEQ = 8192, DM = 1024, MTOK = BATCH * SEQ, NIN = 6144, MIXW = 2048;
constexpr int NH = 8, DH = 128, NBLK = SEQ / 256;
constexpr int MH = 4, MD = 256, LCH = 64, NCH = SEQ / LCH;
constexpr float LOG2E = 1.4426950408889634f;
constexpr float QSCALE = 0.08838834764831845f * LOG2E;
constexpr float RMS_EPS = 1e-6f, LN_EPS = 1e-5f;
constexpr int LISTSZ = 256 * 496;
__host__ __device__ constexpr int list_off(int j) { return 256 * (31 * j - (j * (j - 1)) / 2); }

constexpr size_t MiB = 1u << 20;
constexpr size_t WS_CTL = 0, CTL_ZERO_BYTES = 64 * 1024;
constexpr size_t WS_BIASD = 1 * MiB;
constexpr size_t WS_WEFF = 1 * MiB + 64 * 1024;
constexpr size_t WS_KMEAN = 1 * MiB + 128 * 1024;
constexpr size_t WS_KMAX = 1 * MiB + 640 * 1024;
constexpr size_t WS_BMAX = WS_KMAX + 32 * 1024;
constexpr size_t WS_KM2 = 43 * MiB, WS_KA2 = 44 * MiB;
constexpr size_t WS_GLI = 2 * MiB, WS_GLF = 2 * MiB + 512 * 1024;
constexpr size_t WS_SEL = 3 * MiB;
constexpr size_t WS_LPART = 7 * MiB;
constexpr size_t WS_WINT = 10 * MiB;
constexpr size_t WS_WOUTT = 22 * MiB;
constexpr size_t WS_LIST = 26 * MiB;
constexpr size_t WS_XN = 64 * MiB;
constexpr size_t WS_QK = 128 * MiB;
constexpr size_t WS_V = 256 * MiB, WS_G = 320 * MiB, WS_XM = 384 * MiB, WS_ZM = 448 * MiB, WS_END = 512 * MiB;
constexpr size_t WS_NST = 42 * MiB;
constexpr size_t WS_PST = 42 * MiB + 512 * 1024, WS_MIN = 42 * MiB + 516 * 1024;
constexpr size_t WS_CST = WS_V;
constexpr int NSC = 16, SCCH = NCH / NSC;
constexpr int CW_CNT = 1024;
constexpr int CW_BAR = 4096;
constexpr int LDS_BARST = 163840 - 64;

constexpr int LDS_BYTES = 163840;
#define GAS __attribute__((address_space(1)))
#define LAS __attribute__((address_space(3)))
#define DI __device__ __forceinline__
typedef unsigned short bf16;
typedef unsigned u32x4 __attribute__((ext_vector_type(4)));
typedef unsigned u32x2 __attribute__((ext_vector_type(2)));
typedef int i32x4 __attribute__((ext_vector_type(4)));
typedef float f32x4 __attribute__((ext_vector_type(4)));
typedef float f32x16 __attribute__((ext_vector_type(16)));
typedef short bf16x8 __attribute__((ext_vector_type(8)));
typedef short s16x4 __attribute__((ext_vector_type(4)));
typedef float f32x2_t __attribute__((ext_vector_type(2)));
typedef __bf16 bf16x2_t __attribute__((ext_vector_type(2)));
#define MFMA32(a, b, c) __builtin_amdgcn_mfma_f32_32x32x16_bf16((a), (b), (c), 0, 0, 0)
#define MFMA16(a, b, c) __builtin_amdgcn_mfma_f32_16x16x32_bf16((a), (b), (c), 0, 0, 0)

DI float bf2f(unsigned u16) { return __uint_as_float(u16 << 16); }
DI float bflo(unsigned w) { return __uint_as_float(w << 16); }
DI float bfhi(unsigned w) { return __uint_as_float(w & 0xffff0000u); }
DI unsigned pk2(float lo, float hi) { f32x2_t v = {lo, hi}; bf16x2_t b = __builtin_convertvector(v, bf16x2_t); return __builtin_bit_cast(unsigned, b); }
DI unsigned f2bf(float f) { return pk2(f, 0.f) & 0xffffu; }
DI int crow(int reg, int h) { return (reg & 3) + 8 * (reg >> 2) + 4 * h; }
DI float wave_sum(float v) {
#pragma unroll
    for (int o = 1; o < 64; o <<= 1) v += __shfl_xor(v, o);
    return v;
}
DI float wave_max(float v) {
#pragma unroll
    for (int o = 1; o < 64; o <<= 1) v = fmaxf(v, __shfl_xor(v, o));
    return v;
}
DI bf16x8 pack_lo(const f32x16& x) { u32x4 p; p.x = pk2(x[0], x[1]); p.y = pk2(x[2], x[3]); p.z = pk2(x[4], x[5]); p.w = pk2(x[6], x[7]); return __builtin_bit_cast(bf16x8, p); }
DI bf16x8 pack_hi(const f32x16& x) { u32x4 p; p.x = pk2(x[8], x[9]); p.y = pk2(x[10], x[11]); p.z = pk2(x[12], x[13]); p.w = pk2(x[14], x[15]); return __builtin_bit_cast(bf16x8, p); }
DI float frcp(float x) { return __builtin_amdgcn_rcpf(x); }
DI float frsq(float x) { return __builtin_amdgcn_rsqf(x); }
DI float silu_f(float v) { return v * frcp(1.0f + __builtin_amdgcn_exp2f(-LOG2E * v)); }

struct Args { const float* in[15]; float* out; unsigned char* ws; int ph_lo, ph_hi; };

DI void p0_transpose_item(const float* W, int K, int N, bf16* WT, LAS float* scr, int item, int lane) {
    const int nblk = N / 32, kb = item / nblk, nb = item % nblk, k0 = 64 * kb, n0 = 32 * nb;
#pragma unroll 8
    for (int i = 0; i < 32; ++i) { const int kk = 2 * i + (lane >> 5); scr[kk * 33 + (lane & 31)] = W[(size_t)(k0 + kk) * N + n0 + (lane & 31)]; }
    asm volatile("s_waitcnt lgkmcnt(0)" ::: "memory");
    const int c = lane & 7;
#pragma unroll
    for (int j = 0; j < 4; ++j) { const int n = (lane >> 3) + 8 * j; const LAS float* s = scr + (8 * c) * 33 + n;
        u32x4 o; o.x = pk2(s[0 * 33], s[1 * 33]); o.y = pk2(s[2 * 33], s[3 * 33]); o.z = pk2(s[4 * 33], s[5 * 33]); o.w = pk2(s[6 * 33], s[7 * 33]);
        *(u32x4*)(WT + (size_t)(n0 + n) * K + k0 + 8 * c) = o; }
    asm volatile("s_waitcnt lgkmcnt(0)" ::: "memory");
}
DI int t5_bucket(int n) {
    if (n < 16) return n;
    int b = 16;
    b += (n >= 22); b += (n >= 30); b += (n >= 40); b += (n >= 54); b += (n >= 73); b += (n >= 99); b += (n >= 134); b += (n >= 182);
    b += (n >= 246); b += (n >= 332); b += (n >= 450); b += (n >= 609); b += (n >= 825); b += (n >= 1117); b += (n >= 1513);
    return b;
}
DI void phase_prologue(const Args& a, LAS unsigned char* lds, int tid, int lane, int wave, int bid, int G) {
    const float* x = a.in[0]; const float* rel_bias = a.in[1]; const float* g_pre = a.in[2]; const float* w_in = a.in[4];
    const float* wq = a.in[7]; const float* wk = a.in[8]; const float* wv = a.in[9]; const float* w_if = a.in[10]; const float* w_out = a.in[14];
    unsigned char* ws = a.ws;
    LAS float* scr = (LAS float*)(lds + wave * 16384);
    const int gw = bid * NWAVES + wave, NGW = G * NWAVES;
    constexpr int I_IN = (DM / 64) * (NIN / 32), I_OUT = (MIXW / 64) * (DM / 32);
    for (int it = gw; it < I_IN + I_OUT; it += NGW) {
        if (it < I_IN) p0_transpose_item(w_in, DM, NIN, (bf16*)(ws + WS_WINT), scr, it, lane);
        else p0_transpose_item(w_out, MIXW, DM, (bf16*)(ws + WS_WOUTT), scr, it - I_IN, lane);
    }
    {
        const f32x4* gr = (const f32x4*)g_pre + lane; f32x4 gg[4];
#pragma unroll
        for (int j = 0; j < 4; ++j) gg[j] = gr[64 * j];
        bf16* XN = (bf16*)(ws + WS_XN);
        for (int m = gw; m < MTOK; m += NGW) {
            const f32x4* xr = (const f32x4*)(x + (size_t)m * DM) + lane; f32x4 v[4]; float s = 0.f;
#pragma unroll
            for (int j = 0; j < 4; ++j) { v[j] = xr[64 * j]; s += (v[j].x * v[j].x + v[j].y * v[j].y) + (v[j].z * v[j].z + v[j].w * v[j].w); }
            const float rstd = 1.0f / sqrtf(wave_sum(s) * (1.0f / DM) + RMS_EPS);
            u32x2* o8 = (u32x2*)(XN + (size_t)m * DM) + lane;
#pragma unroll
            for (int j = 0; j < 4; ++j) { u32x2 o; o.x = pk2(v[j].x * rstd * gg[j].x, v[j].y * rstd * gg[j].y); o.y = pk2(v[j].z * rstd * gg[j].z, v[j].w * rstd * gg[j].w); o8[64 * j] = o; }
        }
    }
    const int gt = bid * NTHR + tid, NGT = G * NTHR;
    float* biasd = (float*)(ws + WS_BIASD);
    for (int idx = gt; idx < NH * 2048; idx += NGT) { const int h = idx >> 11, d = idx & 2047; biasd[idx] = rel_bias[t5_bucket(d) * NH + h] * LOG2E; }
    if (gt < NH) { float m = -1e30f; for (int b = 0; b < 32; ++b) m = fmaxf(m, rel_bias[b * NH + gt] * LOG2E); ((float*)(ws + WS_BMAX))[gt] = m; }
    float* weff = (float*)(ws + WS_WEFF);
    for (int idx = gt; idx < 2 * 1024 * 8; idx += NGT) {
        const int which = idx >> 13, c = (idx >> 3) & 1023, g = idx & 7, n = c >> 2, i = c & 3; float s = 0.f;
        if (which == 0) { for (int o = 0; o < 4; ++o) s += wq[n * 16 + i * 4 + o] * w_if[(4 * n + o) * 8 + g] + wk[n * 16 + i * 4 + o] * w_if[(1024 + 4 * n + o) * 8 + g]; }
        else { for (int o = 0; o < 4; ++o) s += wv[n * 16 + i * 4 + o] * w_if[(2048 + 4 * n + o) * 8 + g]; }
        weff[idx] = s;
    }
}

DI void phase_kstat(const Args& a, LAS unsigned char* lds, int tid, int lane, int wave, int bid, int G) {
    const bf16* QK = (const bf16*)(a.ws + WS_QK); float* KMEAN = (float*)(a.ws + WS_KMEAN); float* KMAX = (float*)(a.ws + WS_KMAX);
    LAS float* red = (LAS float*)lds; LAS float* wmx = (LAS float*)(lds + 32 * 128 * 4);
    for (int u = bid; u < 32 * NBLK; u += G) {
        const int bh = u >> 5, blk = u & 31, b = bh >> 3, h = bh & 7;
        const bf16* Kb = QK + (size_t)(b * SEQ + blk * 256) * 2048 + 1024 + h * DH;
        const int rg = tid >> 4, ch = tid & 15;
        float cs[8]; float mx = 0.f;
#pragma unroll
        for (int e = 0; e < 8; ++e) cs[e] = 0.f;
#pragma unroll
        for (int rr = 0; rr < 8; ++rr) {
            const u32x4 v = *(const u32x4*)(Kb + (size_t)(rg * 8 + rr) * 2048 + ch * 8);
            const float f0 = bflo(v.x), f1 = bfhi(v.x), f2 = bflo(v.y), f3 = bfhi(v.y), f4 = bflo(v.z), f5 = bfhi(v.z), f6 = bflo(v.w), f7 = bfhi(v.w);
            cs[0] += f0; cs[1] += f1; cs[2] += f2; cs[3] += f3; cs[4] += f4; cs[5] += f5; cs[6] += f6; cs[7] += f7;
            float ss = (f0 * f0 + f1 * f1) + (f2 * f2 + f3 * f3) + (f4 * f4 + f5 * f5) + (f6 * f6 + f7 * f7);
            ss += __shfl_xor(ss, 1); ss += __shfl_xor(ss, 2); ss += __shfl_xor(ss, 4); ss += __shfl_xor(ss, 8);
            mx = fmaxf(mx, ss);
        }
#pragma unroll
        for (int e = 0; e < 8; ++e) red[rg * 128 + ch * 8 + e] = cs[e];
        mx = wave_max(mx); if (lane == 0) wmx[wave] = mx;
        __syncthreads();
        if (tid < 128) { float s = 0.f; for (int r = 0; r < 32; ++r) s += red[r * 128 + tid]; KMEAN[(size_t)(bh * 32 + blk) * 128 + tid] = s * (1.0f / 256.0f); }
        if (tid == 0) { float m = wmx[0]; for (int w = 1; w < 8; ++w) m = fmaxf(m, wmx[w]); KMAX[bh * 32 + blk] = m; }
        __syncthreads();
    }
}

DI void phase_sel(const Args& a, LAS unsigned char* lds, int tid, int lane, int wave, int bid, int G, int dry) {
    const bf16* QK = (const bf16*)(a.ws + WS_QK); const float* KMEAN = (const float*)(a.ws + WS_KM2); const float* KMAX = (const float*)(a.ws + WS_KA2);
    const float* BMAX = (const float*)(a.ws + WS_BMAX);
    i32x4* SEL = (i32x4*)(a.ws + WS_SEL); unsigned* cnt = (unsigned*)(a.ws + WS_CTL) + CW_CNT + (dry ? 1024 : 0); unsigned* LIST = dry ? (unsigned*)a.out : (unsigned*)(a.ws + WS_LIST);
    LAS float* km = (LAS float*)lds; LAS float* misc = (LAS float*)(lds + 32 * 128 * 4);
    for (int u = bid; u < 32 * NBLK; u += G) {
        const int bh = u >> 5, i = u & 31, b = bh >> 3, h = bh & 7;
        for (int idx = tid; idx < i * 128; idx += NTHR) km[idx] = KMEAN[(size_t)bh * 32 * 128 + idx] + KMEAN[(size_t)(32 + bh) * 32 * 128 + idx];
        { const int d = tid & 127, part = tid >> 7; float m = 0.f;
          float v[16];
#pragma unroll
          for (int k = 0; k < 16; ++k) { const int e = part * 16 + k; v[k] = KMAX[((size_t)(((e >> 5) * 32 + bh) * 32 + (e & 31))) * 128 + d]; }
#pragma unroll
          for (int k = 0; k < 16; ++k) m = fmaxf(m, v[k]);
          misc[128 + part * 128 + d] = m; }
        __syncthreads();
        const int q = tid >> 1, half = tid & 1; const int row = b * SEQ + i * 256 + q;
        const bf16* qp = QK + (size_t)row * 2048 + h * DH + half * 64;
        float qv[64];
#pragma unroll
        for (int c = 0; c < 8; ++c) { const u32x4 v = *(const u32x4*)(qp + c * 8);
            qv[c * 8 + 0] = bflo(v.x); qv[c * 8 + 1] = bfhi(v.x); qv[c * 8 + 2] = bflo(v.y); qv[c * 8 + 3] = bfhi(v.y);
            qv[c * 8 + 4] = bflo(v.z); qv[c * 8 + 5] = bfhi(v.z); qv[c * 8 + 6] = bflo(v.w); qv[c * 8 + 7] = bfhi(v.w); }
        float qn2 = 0.f;
#pragma unroll
        for (int d = 0; d < 64; ++d) { const int dd = half * 64 + d; const float ka = fmaxf(fmaxf(misc[128 + dd], misc[256 + dd]), fmaxf(misc[384 + dd], misc[512 + dd])); qn2 += fabsf(qv[d]) * ka; }
        qn2 += __shfl_xor(qn2, 1);
        float v0 = -INFINITY, v1 = -INFINITY, v2 = -INFINITY; int i0 = -1, i1 = -1, i2 = -1;
        for (int j = 0; j < i; ++j) {
            const LAS float* kr = km + j * 128 + half * 64; float dot = 0.f;
#pragma unroll
            for (int d = 0; d < 64; d += 4) { const f32x4 kk = *(const LAS f32x4*)(kr + d); dot += qv[d] * kk.x + qv[d + 1] * kk.y + qv[d + 2] * kk.z + qv[d + 3] * kk.w; }
            dot += __shfl_xor(dot, 1);
            if (dot > v0) { v2 = v1; i2 = i1; v1 = v0; i1 = i0; v0 = dot; i0 = j; }
            else if (dot > v1) { v2 = v1; i2 = i1; v1 = dot; i1 = j; }
            else if (dot > v2) { v2 = dot; i2 = j; }
        }
        const float shift = qn2 + BMAX[h];
        LAS int* lcnt = (LAS int*)(lds + 32 * 128 * 4 + 4096);
        if (tid < 32) lcnt[tid] = 0;
        __syncthreads();
        int p0 = 0, p1 = 0, p2 = 0;
        if (half == 0) {
            i32x4 s4; s4.x = i0; s4.y = i1; s4.z = i2; s4.w = __float_as_int(shift);
            SEL[((size_t)(b * NH + h)) * SEQ + (size_t)(i * 256 + q)] = s4;
            if (i0 >= 0) p0 = __hip_atomic_fetch_add(lcnt + i0, 1, __ATOMIC_RELAXED, __HIP_MEMORY_SCOPE_WORKGROUP);
            if (i1 >= 0) p1 = __hip_atomic_fetch_add(lcnt + i1, 1, __ATOMIC_RELAXED, __HIP_MEMORY_SCOPE_WORKGROUP);
            if (i2 >= 0) p2 = __hip_atomic_fetch_add(lcnt + i2, 1, __ATOMIC_RELAXED, __HIP_MEMORY_SCOPE_WORKGROUP);
        }
        __syncthreads();
        if (tid < i) { const int c = lcnt[tid]; int base = 0; if (c > 0) base = (int)atomicAdd(&cnt[bh * 32 + tid], (unsigned)c); lcnt[tid] = base; }
        __syncthreads();
        if (half == 0) {
            const unsigned qpos = (unsigned)(i * 256 + q);
            if (i0 >= 0) LIST[(size_t)bh * LISTSZ + list_off(i0) + lcnt[i0] + p0] = qpos | (0u << 16);
            if (i1 >= 0) LIST[(size_t)bh * LISTSZ + list_off(i1) + lcnt[i1] + p1] = qpos | (1u << 16);
            if (i2 >= 0) LIST[(size_t)bh * LISTSZ + list_off(i2) + lcnt[i2] + p2] = qpos | (2u << 16);
        }
        __syncthreads();
    }
}

#ifndef PROBE_VAR
#define PROBE_VAR 0
#endif
constexpr int ATT_KIMG = 0, ATT_KROW = 272, ATT_VIMG = 69632, ATT_VROW = 320, ATT_BIASD = 151552, ATT_NBIAS = 1536, ATT_PREF = 157696, ATT_LST = 161792, ATT_MISC = 162816;
typedef short v4i16_t __attribute__((ext_vector_type(4)));
DI s16x4 lds_tr16(const LAS unsigned char* p) { return __builtin_bit_cast(s16x4, __builtin_amdgcn_ds_read_tr16_b64_v4i16((LAS v4i16_t*)p)); }
DI void att_fill_kv(LAS unsigned char* lds, const bf16* Kg, const bf16* Vg, int tid, int lane, int wave) {
    u32x4 kv[8], vv[8];
#pragma unroll
    for (int it = 0; it < 8; ++it) { const int p = it * NTHR + tid, key = p >> 4, ch = p & 15; kv[it] = *(const u32x4*)(Kg + (size_t)key * 2048 + ch * 8); }
#pragma unroll
    for (int it = 0; it < 8; ++it) { const int p = it * NTHR + tid, key = p >> 4, ch = p & 15; vv[it] = *(const u32x4*)(Vg + (size_t)key * 1024 + ch * 8); }
    __builtin_amdgcn_sched_barrier(0);
#pragma unroll
    for (int it = 0; it < 8; ++it) { const int p = it * NTHR + tid, key = p >> 4, ch = p & 15; *(LAS u32x4*)(lds + ATT_KIMG + key * ATT_KROW + ch * 16) = kv[it]; }
#pragma unroll
    for (int it = 0; it < 8; ++it) { const int p = it * NTHR + tid, key = p >> 4, ch = p & 15; *(LAS u32x4*)(lds + ATT_VIMG + key * ATT_VROW + ch * 16) = vv[it]; }
}
template <bool OWN>
DI void att_tile(LAS unsigned char* lds, const bf16x8 (&qf)[8], int qpos, float shift, int kbase, int kt_end, int wdiag, bool far, float b31,
                 f32x16 (&o)[4], float& lsum, int r, int hf) {
    const LAS float* biasd = (const LAS float*)(lds + ATT_BIASD);
    const int lane16 = (r & 15), grp = (r >> 4);
    const LAS unsigned char* kp = lds + ATT_KIMG + r * ATT_KROW + hf * 16;
    const LAS unsigned char* vp = lds + ATT_VIMG + (4 * hf + (lane16 >> 2)) * ATT_VROW + (16 * grp + 4 * (lane16 & 3)) * 2;
    bf16x8 ka[4];
#pragma unroll
    for (int ks = 0; ks < 4; ++ks) ka[ks] = *(const LAS bf16x8*)(kp + ks * 32);
    for (int kt = 0; kt < kt_end; ++kt) {
        const LAS unsigned char* kc = kp + kt * (32 * ATT_KROW);
        bf16x8 kb[4];
#pragma unroll
        for (int ks = 0; ks < 4; ++ks) kb[ks] = *(const LAS bf16x8*)(kc + (4 + ks) * 32);
        float bv[16];
        if (!far) {
#pragma unroll
            for (int i = 0; i < 16; ++i) { const int key = 32 * kt + crow(i, hf); int dist = qpos - (kbase + key); dist = dist < 0 ? 0 : (dist > ATT_NBIAS - 1 ? ATT_NBIAS - 1 : dist); bv[i] = biasd[dist]; }
        } else {
#pragma unroll
            for (int i = 0; i < 16; ++i) bv[i] = b31;
        }
        __builtin_amdgcn_sched_barrier(0);
        f32x16 x;
#pragma unroll
        for (int i = 0; i < 16; ++i) x[i] = 0.f;
#pragma unroll
        for (int ks = 0; ks < 4; ++ks) x = MFMA32(ka[ks], qf[ks], x);
#pragma unroll
        for (int ks = 0; ks < 4; ++ks) x = MFMA32(kb[ks], qf[4 + ks], x);
        __builtin_amdgcn_sched_barrier(0);
        const LAS unsigned char* vb = vp + kt * (32 * ATT_VROW);
        s16x4 vl[2][4];
#pragma unroll
        for (int dt = 0; dt < 2; ++dt) { vl[dt][0] = lds_tr16(vb + dt * 64); vl[dt][1] = lds_tr16(vb + dt * 64 + 8 * ATT_VROW); vl[dt][2] = lds_tr16(vb + dt * 64 + 16 * ATT_VROW); vl[dt][3] = lds_tr16(vb + dt * 64 + 24 * ATT_VROW); }
        __builtin_amdgcn_sched_barrier(0);
#pragma unroll
        for (int i = 0; i < 16; ++i) { float p = __builtin_amdgcn_exp2f(x[i] + (bv[i] - shift));
            if (OWN) { if (kt == wdiag && crow(i, hf) > r) p = 0.f; }
            lsum += p; x[i] = p; }
        const bf16x8 pa0 = pack_lo(x), pa1 = pack_hi(x);
        __builtin_amdgcn_sched_barrier(0);
        s16x4 vh[2][4];
#pragma unroll
        for (int dt = 0; dt < 2; ++dt) { vh[dt][0] = lds_tr16(vb + (2 + dt) * 64); vh[dt][1] = lds_tr16(vb + (2 + dt) * 64 + 8 * ATT_VROW); vh[dt][2] = lds_tr16(vb + (2 + dt) * 64 + 16 * ATT_VROW); vh[dt][3] = lds_tr16(vb + (2 + dt) * 64 + 24 * ATT_VROW); }
#pragma unroll
        for (int dt = 0; dt < 2; ++dt) {
            o[dt] = MFMA32(__builtin_shufflevector(vl[dt][0], vl[dt][1], 0, 1, 2, 3, 4, 5, 6, 7), pa0, o[dt]);
            o[dt] = MFMA32(__builtin_shufflevector(vl[dt][2], vl[dt][3], 0, 1, 2, 3, 4, 5, 6, 7), pa1, o[dt]); }
        __builtin_amdgcn_sched_barrier(0);
        if (kt + 1 < kt_end) {
#pragma unroll
            for (int ks = 0; ks < 4; ++ks) ka[ks] = *(const LAS bf16x8*)(kc + 32 * ATT_KROW + ks * 32); }
#pragma unroll
        for (int dt = 0; dt < 2; ++dt) {
            o[2 + dt] = MFMA32(__builtin_shufflevector(vh[dt][0], vh[dt][1], 0, 1, 2, 3, 4, 5, 6, 7), pa0, o[2 + dt]);
            o[2 + dt] = MFMA32(__builtin_shufflevector(vh[dt][2], vh[dt][3], 0, 1, 2, 3, 4, 5, 6, 7), pa1, o[2 + dt]); }
    }
}
DI void att_load_biasd(const Args& a, LAS unsigned char* lds, int h, int tid) {
    const float* biasd = (const float*)(a.ws + WS_BIASD) + h * 2048; LAS float* dst = (LAS float*)(lds + ATT_BIASD);
    for (int i = tid; i < ATT_NBIAS; i += NTHR) dst[i] = biasd[i];
}
DI size_t hmrow(int b, int h, int s) { return ((size_t)(b * NH + h)) * SEQ + (size_t)s; }
DI bf16* opart_base(const Args& a, int slot) { return slot == 0 ? (bf16*)a.out : (slot == 1 ? (bf16*)((unsigned char*)a.out + 64 * MiB) : (bf16*)(a.ws + WS_XN)); }

constexpr int ATT_RU = 512, ATT_NT = ATT_RU / 256;
DI void att_swap(unsigned& a, unsigned& b) { const auto r = __builtin_amdgcn_permlane32_swap(a, b, false, false); a = r[0]; b = r[1]; }
DI void att_g_load(const Args& a, const unsigned* lp, int nv, int b, int h, int r, int hf, unsigned& ent, float& shift, bf16x8 (&qf)[8]) {
    const bf16* QK = (const bf16*)(a.ws + WS_QK); const i32x4* SEL = (const i32x4*)(a.ws + WS_SEL);
    ent = lp[r < nv ? r : 0];
    const int qpos = (int)(ent & 0xffffu); const size_t row = (size_t)b * SEQ + qpos;
    shift = __int_as_float(SEL[hmrow(b, h, qpos)].w);
#pragma unroll
    for (int ks = 0; ks < 8; ++ks) qf[ks] = *(const bf16x8*)(QK + row * 2048 + h * DH + ks * 16 + hf * 8);
}
DI void att_g_tile(const Args& a, LAS unsigned char* lds, int nv, int b, int h, int j, int r, int hf, unsigned ent, float shift, const bf16x8 (&qf)[8], int mode) {
    float* LPART = (float*)(a.ws + WS_LPART);
    f32x16 o[4]; float lsum = 0.f;
#pragma unroll
    for (int dt = 0; dt < 4; ++dt)
#pragma unroll
        for (int i = 0; i < 16; ++i) o[dt][i] = 0.f;
    const int qpos = (int)(ent & 0xffffu), slot = (int)(ent >> 16);
    const bool far = __all(qpos - (j * 256 + 255) >= 1513);
    const float b31 = *(const LAS float*)(lds + ATT_BIASD + (ATT_NBIAS - 1) * 4);
    if (mode != 3) att_tile<false>(lds, qf, qpos, shift, j * 256, 8, -1, far, b31, o, lsum, r, hf);
    lsum += __shfl_xor(lsum, 32);
    if (mode == 4) { asm volatile("" :: "v"(o[0]), "v"(o[1]), "v"(o[2]), "v"(o[3]), "v"(lsum)); return; }
    bf16* dst = opart_base(a, slot) + hmrow(b, h, qpos) * 128;
#pragma unroll
    for (int dt = 0; dt < 4; ++dt)
#pragma unroll
        for (int gg = 0; gg < 2; ++gg) {
            unsigned ax = pk2(o[dt][8 * gg + 0], o[dt][8 * gg + 1]), ay = pk2(o[dt][8 * gg + 2], o[dt][8 * gg + 3]), bx = pk2(o[dt][8 * gg + 4], o[dt][8 * gg + 5]), by = pk2(o[dt][8 * gg + 6], o[dt][8 * gg + 7]);
            att_swap(ax, bx); att_swap(ay, by);
            u32x4 v; v.x = ax; v.y = ay; v.z = bx; v.w = by;
            if (r < nv) *(u32x4*)(dst + (4 * dt + 2 * gg + hf) * 8) = v; }
    if (hf == 0 && r < nv) LPART[(size_t)slot * MTOK * 8 + hmrow(b, h, qpos)] = lsum;
}
DI void phase_att_gather(const Args& a, LAS unsigned char* lds, int tid, int lane, int wave, int bid, int G, int dry) {
    const bf16* QK = (const bf16*)(a.ws + WS_QK); const bf16* Vb = (const bf16*)(a.ws + WS_V);
    const unsigned* cnt = (const unsigned*)(a.ws + WS_CTL) + CW_CNT; const unsigned* LIST = (const unsigned*)(a.ws + WS_LIST);
    LAS int* pref = (LAS int*)(lds + ATT_PREF);
    if (tid < 64) {
        int nu[16]; int s = 0;
#pragma unroll
        for (int k = 0; k < 16; ++k) { const int l = tid * 16 + k; int n = 0; if (l < 992) { const int bh = l / 31, j = l % 31; n = (int)((cnt[bh * 32 + j] + (unsigned)(ATT_RU - 1)) / (unsigned)ATT_RU); } nu[k] = n; s += n; }
        int incl = s;
#pragma unroll
        for (int o = 1; o < 64; o <<= 1) { const int t = __shfl_up(incl, o); if (lane >= o) incl += t; }
        int run = incl - s;
#pragma unroll
        for (int k = 0; k < 16; ++k) { const int l = tid * 16 + k; if (l <= 992) pref[l] = run; run += nu[k]; }
    }
    __syncthreads();
    const int U = pref[992];
    const int r = lane & 31, hf = lane >> 5;
    int cur_h = -1;
    for (int u = bid; u < U; u += G) {
        int lo = 0, hi = 992;
        while (hi - lo > 1) { const int mid = (lo + hi) >> 1; if (pref[mid] <= u) lo = mid; else hi = mid; }
        const int l = lo, bh = l / 31, j = l % 31, chunk = u - pref[l], b = bh >> 3, h = bh & 7;
        const int n = (int)cnt[bh * 32 + j]; const int nrows = min(ATT_RU, n - chunk * ATT_RU);
        const unsigned* lp = LIST + (size_t)bh * LISTSZ + list_off(j) + chunk * ATT_RU;
        const int nv0 = min(32, max(0, nrows - 32 * wave)), nv1 = min(32, max(0, nrows - 32 * (8 + wave)));
        unsigned entA = 0; float shA = 0.f; bf16x8 qfA[8];
        const bool skipall = (PROBE_VAR == 5 && dry);
        if (nv0 > 0 && !skipall) att_g_load(a, lp + 32 * wave, nv0, b, h, r, hf, entA, shA, qfA);
        if (h != cur_h) { att_load_biasd(a, lds, h, tid); cur_h = h; }
        att_fill_kv(lds, QK + (size_t)(b * SEQ + j * 256) * 2048 + 1024 + h * DH, Vb + (size_t)(b * SEQ + j * 256) * 1024 + h * DH, tid, lane, wave);
        __syncthreads();
        if (nv0 > 0 && !skipall) {
            att_g_tile(a, lds, nv0, b, h, j, r, hf, entA, shA, qfA, dry ? PROBE_VAR : 0);
            if (nv1 > 0) { att_g_load(a, lp + 32 * (8 + wave), nv1, b, h, r, hf, entA, shA, qfA); att_g_tile(a, lds, nv1, b, h, j, r, hf, entA, shA, qfA, dry ? PROBE_VAR : 0); }
        }
        __syncthreads();
    }
}

DI void phase_att_own(const Args& a, LAS unsigned char* lds, int tid, int lane, int wave, int bid, int G, int dry) {
    bf16* QK = (bf16*)(a.ws + WS_QK); const bf16* Vb = (const bf16*)(a.ws + WS_V); const bf16* Gb = (const bf16*)(a.ws + WS_G);
    const i32x4* SEL = (const i32x4*)(a.ws + WS_SEL); const float* LPART = (const float*)(a.ws + WS_LPART);
    int cur_h = -1;
    for (int u = bid; u < 32 * NBLK; u += G) {
        const int bh = u >> 5, i = u & 31, b = bh >> 3, h = bh & 7;
        const int r0 = lane & 31, hf0 = lane >> 5; const int qpos0 = i * 256 + 32 * wave + r0; const size_t row0 = (size_t)b * SEQ + qpos0;
        const float shift = __int_as_float(SEL[hmrow(b, h, qpos0)].w);
        bf16x8 qf[8];
#pragma unroll
        for (int ks = 0; ks < 8; ++ks) qf[ks] = *(const bf16x8*)(QK + row0 * 2048 + h * DH + ks * 16 + hf0 * 8);
        if (h != cur_h) { att_load_biasd(a, lds, h, tid); cur_h = h; }
        att_fill_kv(lds, QK + (size_t)(b * SEQ + i * 256) * 2048 + 1024 + h * DH, Vb + (size_t)(b * SEQ + i * 256) * 1024 + h * DH, tid, lane, wave);
        __syncthreads();
        f32x16 o[4]; float lsum = 0.f;
#pragma unroll
        for (int dt = 0; dt < 4; ++dt)
#pragma unroll
            for (int k = 0; k < 16; ++k) o[dt][k] = 0.f;
        if (!(PROBE_VAR == 2 && dry)) att_tile<true>(lds, qf, qpos0, shift, i * 256, wave + 1, wave, false, 0.f, o, lsum, r0, hf0);
        lsum += __shfl_xor(lsum, 32);
        int l2_ = lane; asm volatile("" : "+v"(l2_));
        const int r = l2_ & 31, hf = l2_ >> 5; const int qpos = i * 256 + 32 * wave + r; const size_t row = (size_t)b * SEQ + qpos;
        const i32x4 s4 = SEL[hmrow(b, h, qpos)];
        if (PROBE_VAR == 1 && dry) { asm volatile("" :: "v"(o[0]), "v"(o[1]), "v"(o[2]), "v"(o[3]), "v"(lsum)); __syncthreads(); continue; }
        float l = lsum;
        const unsigned mk0 = s4.x >= 0 ? 0xffffffffu : 0u, mk1 = s4.y >= 0 ? 0xffffffffu : 0u, mk2 = s4.z >= 0 ? 0xffffffffu : 0u;
#pragma unroll
        for (int k = 0; k < 3; ++k) { const unsigned mk = (k == 0) ? mk0 : (k == 1 ? mk1 : mk2); const float lp = LPART[(size_t)k * MTOK * 8 + hmrow(b, h, qpos)]; l += __uint_as_float(__float_as_uint(lp) & mk); }
        const float rl = frcp(l);
#pragma unroll
        for (int dt = 0; dt < 4; ++dt) {
            u32x4 pv[2][3], gv[2];
#pragma unroll
            for (int gg = 0; gg < 2; ++gg) { const int c = 4 * dt + 2 * gg + hf;
                gv[gg] = *(const u32x4*)(Gb + row * 1024 + h * DH + c * 8);
#pragma unroll
                for (int k = 0; k < 3; ++k) pv[gg][k] = *(const u32x4*)(opart_base(a, k) + hmrow(b, h, qpos) * 128 + c * 8); }
#pragma unroll
            for (int gg = 0; gg < 2; ++gg) { const int c = 4 * dt + 2 * gg + hf;
                unsigned w[8];
#pragma unroll
                for (int k = 0; k < 8; ++k) w[k] = __float_as_uint(o[dt][8 * gg + k]);
#pragma unroll
                for (int k = 0; k < 4; ++k) att_swap(w[k], w[4 + k]);
                float acc[8];
#pragma unroll
                for (int k = 0; k < 8; ++k) acc[k] = __uint_as_float(w[k]);
#pragma unroll
                for (int k = 0; k < 3; ++k) { const unsigned mk = (k == 0) ? mk0 : (k == 1 ? mk1 : mk2); u32x4 p = pv[gg][k]; p.x &= mk; p.y &= mk; p.z &= mk; p.w &= mk;
                    acc[0] += bflo(p.x); acc[1] += bfhi(p.x); acc[2] += bflo(p.y); acc[3] += bfhi(p.y); acc[4] += bflo(p.z); acc[5] += bfhi(p.z); acc[6] += bflo(p.w); acc[7] += bfhi(p.w); }
                const u32x4 g4 = gv[gg];
                u32x4 ov; ov.x = pk2(acc[0] * rl * silu_f(bflo(g4.x)), acc[1] * rl * silu_f(bfhi(g4.x))); ov.y = pk2(acc[2] * rl * silu_f(bflo(g4.y)), acc[3] * rl * silu_f(bfhi(g4.y)));
                ov.z = pk2(acc[4] * rl * silu_f(bflo(g4.z)), acc[5] * rl * silu_f(bfhi(g4.z))); ov.w = pk2(acc[6] * rl * silu_f(bflo(g4.w)), acc[7] * rl * silu_f(bfhi(g4.w)));
                if (!dry) *(u32x4*)(QK + row * 2048 + h * DH + c * 8) = ov; else asm volatile("" :: "v"(ov)); }
        }
        __syncthreads();
    }
}

DI void phase_mgate(const Args& a, LAS unsigned char* lds, int tid, int lane, int wave, int bid, int G) {
    const float* conv_w = a.in[5]; const float* conv_b = a.in[6]; const float* b_if = a.in[11];
    const float* weff = (const float*)(a.ws + WS_WEFF);
    const bf16* XM = (const bf16*)(a.ws + WS_XM);
    float* GLI = (float*)(a.ws + WS_GLI); float* GLF = (float*)(a.ws + WS_GLF);
    LAS float* red = (LAS float*)lds;
    const int tk = tid >> 8, n = tid & 255;
    float cw[4][4], cb[4], wc[4][8], wm[4][8];
#pragma unroll
    for (int w = 0; w < 4; ++w) { const f32x4 t = *(const f32x4*)(conv_w + w * 1024 + 4 * n); cw[w][0] = t.x; cw[w][1] = t.y; cw[w][2] = t.z; cw[w][3] = t.w; }
    { const f32x4 t = *(const f32x4*)(conv_b + 4 * n); cb[0] = t.x; cb[1] = t.y; cb[2] = t.z; cb[3] = t.w; }
#pragma unroll
    for (int i = 0; i < 4; ++i)
#pragma unroll
        for (int g = 0; g < 8; ++g) { wc[i][g] = weff[(4 * n + i) * 8 + g]; wm[i][g] = weff[8192 + (4 * n + i) * 8 + g]; }
    for (int blk = bid; blk < MTOK / 16; blk += G) {
        const int mb = 16 * blk + 8 * tk, s0 = mb & (SEQ - 1);
        u32x2 win[11];
#pragma unroll
        for (int j = 0; j < 11; ++j) { u32x2 v = *(const u32x2*)(XM + (ptrdiff_t)(mb - 3 + j) * 1024 + 4 * n); const unsigned mk = (s0 - 3 + j >= 0) ? 0xffffffffu : 0u; v.x &= mk; v.y &= mk; win[j] = v; }
#pragma unroll
        for (int k = 0; k < 8; ++k) {
            float xc[4], xm[4];
            xm[0] = bflo(win[k + 3].x); xm[1] = bfhi(win[k + 3].x); xm[2] = bflo(win[k + 3].y); xm[3] = bfhi(win[k + 3].y);
            { float y0 = cb[0], y1 = cb[1], y2 = cb[2], y3 = cb[3];
#pragma unroll
              for (int w = 0; w < 4; ++w) { y0 += bflo(win[k + w].x) * cw[w][0]; y1 += bfhi(win[k + w].x) * cw[w][1]; y2 += bflo(win[k + w].y) * cw[w][2]; y3 += bfhi(win[k + w].y) * cw[w][3]; }
              xc[0] = silu_f(y0); xc[1] = silu_f(y1); xc[2] = silu_f(y2); xc[3] = silu_f(y3); }
#pragma unroll
            for (int g = 0; g < 8; ++g) { float sg = 0.f;
#pragma unroll
                for (int i = 0; i < 4; ++i) sg += xc[i] * wc[i][g] + xm[i] * wm[i][g];
                red[((8 * tk + k) * 8 + g) * 256 + n] = sg; }
        }
        __syncthreads();
        { const int row = tid >> 2, qd = tid & 3; float s = 0.f;
#pragma unroll
          for (int k = 0; k < 16; ++k) { const f32x4 v = *(const LAS f32x4*)(red + row * 256 + qd * 64 + k * 4); s += (v.x + v.y) + (v.z + v.w); }
          s += __shfl_xor(s, 1); s += __shfl_xor(s, 2);
          if (qd == 0) { const int tok = row >> 3, g = row & 7; const int m2 = 16 * blk + tok, s2 = m2 & (SEQ - 1), b2 = m2 >> 13; const float gate = s + b_if[g];
              if (g < 4) GLI[(size_t)(b2 * 4 + g) * SEQ + s2] = gate;
              else GLF[(size_t)(b2 * 4 + g - 4) * SEQ + s2] = fminf(gate, 0.f) - log1pf(__expf(-fabsf(gate))); } }
        __syncthreads();
    }
}

constexpr int MC_QI = 0, MC_QROW = 528, MC_KI = 33792, MC_KT = 67584, MC_TROW = 144, MC_VT = 104448, MC_P = 141312, MC_SC = 150528, MC_NV = 153600, MC_MISC = 154624;
constexpr int MC_STROW = 1040;
DI LAS float* mc_sc(LAS unsigned char* lds, int k) { return (LAS float*)(lds + MC_SC + k * 256); }

template <bool FULL>
DI void mfill(const Args& a, LAS unsigned char* lds, size_t rowbase, int spos0, int hd, int tk, int n64, u32x2 (&xcp)[8]) {
    const float* conv_w = a.in[5]; const float* conv_b = a.in[6]; const float* wq = a.in[7]; const float* wk = a.in[8]; const float* wv = a.in[9];
    const bf16* XM = (const bf16*)(a.ws + WS_XM);
    const int ch = hd * MD + 4 * n64, ng = hd * 64 + n64;
    const bf16* xp = XM + (rowbase + 8 * tk) * 1024 + ch;
    u32x2 win[11];
#pragma unroll
    for (int j = 0; j < 11; ++j) { u32x2 v = *(const u32x2*)(xp + (ptrdiff_t)(j - 3) * 1024); const unsigned mk = (spos0 + 8 * tk - 3 + j >= 0) ? 0xffffffffu : 0u; v.x &= mk; v.y &= mk; win[j] = v; }
    __builtin_amdgcn_sched_barrier(0);
    { float fw[16];
#pragma unroll
      for (int q4 = 0; q4 < 4; ++q4) { const f32x4 t = *(const f32x4*)(wv + ng * 16 + q4 * 4); fw[q4 * 4 + 0] = t.x; fw[q4 * 4 + 1] = t.y; fw[q4 * 4 + 2] = t.z; fw[q4 * 4 + 3] = t.w; }
      unsigned tw[4][4]; float prev[4];
#pragma unroll
      for (int k = 0; k < 8; ++k) { float o[4]; const float x0 = bflo(win[k + 3].x), x1 = bfhi(win[k + 3].x), x2 = bflo(win[k + 3].y), x3 = bfhi(win[k + 3].y);
#pragma unroll
          for (int oo = 0; oo < 4; ++oo) o[oo] = x0 * fw[oo] + x1 * fw[4 + oo] + x2 * fw[8 + oo] + x3 * fw[12 + oo];
          if ((k & 1) == 0) { prev[0] = o[0]; prev[1] = o[1]; prev[2] = o[2]; prev[3] = o[3]; }
          else { tw[0][k >> 1] = pk2(prev[0], o[0]); tw[1][k >> 1] = pk2(prev[1], o[1]); tw[2][k >> 1] = pk2(prev[2], o[2]); tw[3][k >> 1] = pk2(prev[3], o[3]); } }
#pragma unroll
      for (int oo = 0; oo < 4; ++oo) { u32x4 w4; w4.x = tw[oo][0]; w4.y = tw[oo][1]; w4.z = tw[oo][2]; w4.w = tw[oo][3]; *(LAS u32x4*)(lds + MC_VT + (4 * n64 + oo) * MC_TROW + 16 * tk) = w4; } }
    { float cw[4][4], cb[4];
#pragma unroll
      for (int w = 0; w < 4; ++w) { const f32x4 t = *(const f32x4*)(conv_w + w * 1024 + ch); cw[w][0] = t.x; cw[w][1] = t.y; cw[w][2] = t.z; cw[w][3] = t.w; }
      { const f32x4 t = *(const f32x4*)(conv_b + ch); cb[0] = t.x; cb[1] = t.y; cb[2] = t.z; cb[3] = t.w; }
#pragma unroll
      for (int k = 0; k < 8; ++k) { float y0 = cb[0], y1 = cb[1], y2 = cb[2], y3 = cb[3];
#pragma unroll
          for (int w = 0; w < 4; ++w) { y0 += bflo(win[k + w].x) * cw[w][0]; y1 += bfhi(win[k + w].x) * cw[w][1]; y2 += bflo(win[k + w].y) * cw[w][2]; y3 += bfhi(win[k + w].y) * cw[w][3]; }
          u32x2 p; p.x = pk2(silu_f(y0), silu_f(y1)); p.y = pk2(silu_f(y2), silu_f(y3)); xcp[k] = p; } }
    asm volatile("" : "+v"(xcp[0]), "+v"(xcp[1]), "+v"(xcp[2]), "+v"(xcp[3]), "+v"(xcp[4]), "+v"(xcp[5]), "+v"(xcp[6]), "+v"(xcp[7]));
    { float fw[16];
#pragma unroll
      for (int q4 = 0; q4 < 4; ++q4) { const f32x4 t = *(const f32x4*)(wk + ng * 16 + q4 * 4); fw[q4 * 4 + 0] = t.x * 0.0625f; fw[q4 * 4 + 1] = t.y * 0.0625f; fw[q4 * 4 + 2] = t.z * 0.0625f; fw[q4 * 4 + 3] = t.w * 0.0625f; }
      unsigned tw[4][4]; float prev[4];
#pragma unroll
      for (int k = 0; k < 8; ++k) { float o[4]; const float x0 = bflo(xcp[k].x), x1 = bfhi(xcp[k].x), x2 = bflo(xcp[k].y), x3 = bfhi(xcp[k].y);
#pragma unroll
          for (int oo = 0; oo < 4; ++oo) o[oo] = x0 * fw[oo] + x1 * fw[4 + oo] + x2 * fw[8 + oo] + x3 * fw[12 + oo];
          if (FULL) { u32x2 p; p.x = pk2(o[0], o[1]); p.y = pk2(o[2], o[3]); *(LAS u32x2*)(lds + MC_KI + (8 * tk + k) * MC_QROW + 8 * n64) = p; }
          if ((k & 1) == 0) { prev[0] = o[0]; prev[1] = o[1]; prev[2] = o[2]; prev[3] = o[3]; }
          else { tw[0][k >> 1] = pk2(prev[0], o[0]); tw[1][k >> 1] = pk2(prev[1], o[1]); tw[2][k >> 1] = pk2(prev[2], o[2]); tw[3][k >> 1] = pk2(prev[3], o[3]); } }
#pragma unroll
      for (int oo = 0; oo < 4; ++oo) { u32x4 w4; w4.x = tw[oo][0]; w4.y = tw[oo][1]; w4.z = tw[oo][2]; w4.w = tw[oo][3]; *(LAS u32x4*)(lds + MC_KT + (4 * n64 + oo) * MC_TROW + 16 * tk) = w4; } }
    if (FULL) { float fw[16];
#pragma unroll
      for (int q4 = 0; q4 < 4; ++q4) { const f32x4 t = *(const f32x4*)(wq + ng * 16 + q4 * 4); fw[q4 * 4 + 0] = t.x; fw[q4 * 4 + 1] = t.y; fw[q4 * 4 + 2] = t.z; fw[q4 * 4 + 3] = t.w; }
#pragma unroll
      for (int k = 0; k < 8; ++k) { float o[4]; const float x0 = bflo(xcp[k].x), x1 = bfhi(xcp[k].x), x2 = bflo(xcp[k].y), x3 = bfhi(xcp[k].y);
#pragma unroll
          for (int oo = 0; oo < 4; ++oo) o[oo] = x0 * fw[oo] + x1 * fw[4 + oo] + x2 * fw[8 + oo] + x3 * fw[12 + oo];
          u32x2 p; p.x = pk2(o[0], o[1]); p.y = pk2(o[2], o[3]); *(LAS u32x2*)(lds + MC_QI + (8 * tk + k) * MC_QROW + 8 * n64) = p; } }
}

DI void phase_mstate(const Args& a, LAS unsigned char* lds, int tid, int lane0, int wave, int bid, int G) {
    const float* GLI = (const float*)(a.ws + WS_GLI); const float* GLF = (const float*)(a.ws + WS_GLF);
    float* CST = (float*)(a.ws + WS_CST); float* NST = (float*)(a.ws + WS_NST); float* PST = (float*)(a.ws + WS_PST); float* MIN = (float*)(a.ws + WS_MIN);
    LAS float* nvec = (LAS float*)(lds + MC_NV); LAS float* misc = (LAS float*)(lds + MC_MISC);
    LAS float* aggb = (LAS float*)(lds + MC_QI); LAS float* agga = aggb + 128; LAS float* marr = aggb + 256;
#define OPQ(name) int name = tid; asm volatile("" : "+v"(name))
    for (int u = bid; u < BATCH * MH * NSC; u += G) {
        const int bh = u >> 4, sc = u & 15, b = bh >> 2, hd = bh & 3; const int c0 = sc * SCCH, c1 = c0 + SCCH;
        { OPQ(tA); const int laneA = tA & 63;
            for (int c = wave; c < c1; c += NWAVES) {
                const float lf = GLF[(size_t)bh * SEQ + c * LCH + laneA], li = GLI[(size_t)bh * SEQ + c * LCH + laneA];
                float bc = lf;
#pragma unroll
                for (int o = 1; o < 64; o <<= 1) { const float t = __shfl_up(bc, o); if (laneA >= o) bc += t; }
                const float am = wave_max(li - bc); const float bL = __shfl(bc, 63);
                if (laneA == 0) { aggb[c] = bL; agga[c] = am; }
            }
        }
        __syncthreads();
        if (tid == 0) { float m = 0.f; for (int c = 0; c < c1; ++c) { marr[c] = m; m = aggb[c] + fmaxf(m, agga[c]); } }
        __syncthreads();
        if (tid < SCCH) MIN[bh * NCH + c0 + tid] = marr[c0 + tid];
        f32x16 C[8];
#pragma unroll
        for (int dt = 0; dt < 8; ++dt)
#pragma unroll
            for (int i = 0; i < 16; ++i) C[dt][i] = 0.f;
        if (tid < 256) nvec[tid] = 0.f;
        float pprod = 1.f;
        for (int c = c0; c < c1; ++c) {
            const size_t rowbase = (size_t)b * SEQ + (size_t)c * LCH;
            { OPQ(tB); const int laneB = tB & 63;
            { u32x2 dummy[8]; mfill<false>(a, lds, rowbase, c * LCH, hd, wave, laneB, dummy); }
            if (wave == 0) {
                const float lf = GLF[(size_t)bh * SEQ + c * LCH + laneB], li = GLI[(size_t)bh * SEQ + c * LCH + laneB];
                float bc = lf;
#pragma unroll
                for (int o = 1; o < 64; o <<= 1) { const float t = __shfl_up(bc, o); if (laneB >= o) bc += t; }
                const float av = li - bc; const float mi = marr[c]; const float Gc = fmaxf(mi, wave_max(av));
                mc_sc(lds, 3)[laneB] = __expf(av - Gc);
                if (laneB == 0) misc[0] = __expf(mi - Gc);
            } }
            __syncthreads();
            const float cd = misc[0]; pprod *= cd;
            { OPQ(tC); const int laneC = tC & 63, r = laneC & 31, hf = laneC >> 5;
            bf16x8 vt[4];
            const LAS unsigned char* vbase = lds + MC_VT + (32 * wave + r) * MC_TROW + hf * 16;
#pragma unroll
            for (int ks = 0; ks < 4; ++ks) { vt[ks] = *(const LAS bf16x8*)(vbase + ks * 32);
                const f32x4 w0 = *(const LAS f32x4*)(mc_sc(lds, 3) + 16 * ks + 8 * hf), w1 = *(const LAS f32x4*)(mc_sc(lds, 3) + 16 * ks + 8 * hf + 4);
                const u32x4 vv = __builtin_bit_cast(u32x4, vt[ks]); u32x4 o;
                o.x = pk2(bflo(vv.x) * w0.x, bfhi(vv.x) * w0.y); o.y = pk2(bflo(vv.y) * w0.z, bfhi(vv.y) * w0.w); o.z = pk2(bflo(vv.z) * w1.x, bfhi(vv.z) * w1.y); o.w = pk2(bflo(vv.w) * w1.z, bfhi(vv.w) * w1.w);
                vt[ks] = __builtin_bit_cast(bf16x8, o); }
            const LAS unsigned char* kbase = lds + MC_KT + r * MC_TROW + hf * 16;
#pragma unroll
            for (int dt = 0; dt < 8; ++dt) {
#pragma unroll
                for (int i = 0; i < 16; ++i) C[dt][i] *= cd;
#pragma unroll
                for (int ks = 0; ks < 4; ++ks) { const bf16x8 kA = *(const LAS bf16x8*)(kbase + dt * 32 * MC_TROW + ks * 32); C[dt] = MFMA32(kA, vt[ks], C[dt]); } }
            if (tC < 256) { float sacc = cd * nvec[tC];
#pragma unroll
                for (int k = 0; k < 8; ++k) { const u32x4 kv = *(const LAS u32x4*)(lds + MC_KT + tC * MC_TROW + k * 16);
                    const f32x4 w0 = *(const LAS f32x4*)(mc_sc(lds, 3) + k * 8), w1 = *(const LAS f32x4*)(mc_sc(lds, 3) + k * 8 + 4);
                    sacc += bflo(kv.x) * w0.x + bfhi(kv.x) * w0.y + bflo(kv.y) * w0.z + bfhi(kv.y) * w0.w + bflo(kv.z) * w1.x + bfhi(kv.z) * w1.y + bflo(kv.w) * w1.z + bfhi(kv.w) * w1.w; }
                nvec[tC] = sacc; }
            }
            __syncthreads();
        }
        { OPQ(tD); const int laneD = tD & 63, r = laneD & 31, hf = laneD >> 5;
            float* cs = CST + (size_t)u * 65536 + 32 * wave + r;
#pragma unroll
            for (int dt = 0; dt < 8; ++dt)
#pragma unroll
                for (int i = 0; i < 16; ++i) cs[(32 * dt + crow(i, hf)) * 256] = C[dt][i];
            if (tD < 256) NST[u * 256 + tD] = nvec[tD];
            if (tD == 0) PST[u] = pprod;
        }
        __syncthreads();
    }
#undef OPQ
}
DI void phase_mcomb(const Args& a, int tid, int bid, int G, int dry) {
    float* CST = (float*)(a.ws + WS_CST); float* NST = (float*)(a.ws + WS_NST); const float* PST = (const float*)(a.ws + WS_PST);
    const int gt = bid * NTHR + tid, NGT = G * NTHR;
    for (int idx = gt; idx < BATCH * MH * 65536; idx += NGT) { const int bh = idx >> 16, e = idx & 65535; float run = 0.f;
#pragma unroll 4
        for (int sc = 0; sc < NSC; ++sc) { float* p = CST + (size_t)(bh * NSC + sc) * 65536 + e; const float tmp = *p; if (!dry) *p = run; else asm volatile("" :: "v"(run)); run = PST[bh * NSC + sc] * run + tmp; } }
    for (int idx = gt; idx < BATCH * MH * 256; idx += NGT) { const int bh = idx >> 8, e = idx & 255; float run = 0.f;
        for (int sc = 0; sc < NSC; ++sc) { float* p = NST + (size_t)(bh * NSC + sc) * 256 + e; const float tmp = *p; if (!dry) *p = run; else asm volatile("" :: "v"(run)); run = PST[bh * NSC + sc] * run + tmp; } }
}
DI void phase_mscan(const Args& a, LAS unsigned char* lds, int tid, int lane0, int wave, int bid, int G) {
    const bf16* ZM = (const bf16*)(a.ws + WS_ZM); bf16* QK = (bf16*)(a.ws + WS_QK);
    const float* GLI = (const float*)(a.ws + WS_GLI); const float* GLF = (const float*)(a.ws + WS_GLF);
    const float* mh_norm = a.in[12]; const float* skip = a.in[13];
    LAS float* nvec = (LAS float*)(lds + MC_NV); LAS float* misc = (LAS float*)(lds + MC_MISC);
#define OPQ(name) int name = tid; asm volatile("" : "+v"(name))
    const float* CST = (const float*)(a.ws + WS_CST); const float* NST = (const float*)(a.ws + WS_NST); const float* MIN = (const float*)(a.ws + WS_MIN);
    for (int u = bid; u < BATCH * MH * NSC; u += G) {
        const int bh = u >> 4, sc = u & 15, b = bh >> 2, hd = bh & 3;
        f32x16 C[8];
        { OPQ(t0); const int lane_ = t0 & 63, r = lane_ & 31, hf = lane_ >> 5;
            const float* cs = CST + (size_t)u * 65536 + 32 * wave + r;
#pragma unroll
            for (int dt = 0; dt < 8; ++dt)
#pragma unroll
                for (int i = 0; i < 16; ++i) C[dt][i] = cs[(32 * dt + crow(i, hf)) * 256];
            if (t0 < 256) nvec[t0] = NST[u * 256 + t0];
        }
        float mrun = MIN[bh * NCH + sc * SCCH];
        for (int c = sc * SCCH; c < (sc + 1) * SCCH; ++c) {
            const size_t rowbase = (size_t)b * SEQ + (size_t)c * LCH;
            u32x2 xcp[8];
            { OPQ(tA); const int laneA = tA & 63;
            mfill<true>(a, lds, rowbase, c * LCH, hd, wave, laneA, xcp);
            if (wave == 0) {
                const float lf = GLF[(size_t)bh * SEQ + c * LCH + laneA], li = GLI[(size_t)bh * SEQ + c * LCH + laneA];
                float bc = lf;
#pragma unroll
                for (int o = 1; o < 64; o <<= 1) { const float t = __shfl_up(bc, o); if (laneA >= o) bc += t; }
                const float av = li - bc; float cm = av;
#pragma unroll
                for (int o = 1; o < 64; o <<= 1) { const float t = __shfl_up(cm, o); if (laneA >= o) cm = fmaxf(cm, t); }
                const float gv = fmaxf(mrun, cm); const float Gc = __shfl(gv, 63), bL = __shfl(bc, 63);
                mc_sc(lds, 0)[laneA] = av; mc_sc(lds, 1)[laneA] = gv; mc_sc(lds, 2)[laneA] = __expf(mrun - gv); mc_sc(lds, 3)[laneA] = __expf(av - Gc); mc_sc(lds, 4)[laneA] = __expf(-(bc + gv));
                if (laneA == 0) misc[0] = __expf(mrun - Gc);
                mrun = bL + Gc;
            } }
            __syncthreads();
            { OPQ(tB); const int laneB = tB & 63, l15 = laneB & 15, l4 = laneB >> 4;
                const int tt = wave >> 1;
#pragma unroll
                for (int sti = 0; sti < 2; ++sti) { const int st = 2 * (wave & 1) + sti;
                    f32x4 acc4 = {0.f, 0.f, 0.f, 0.f};
                    if (st <= tt) {
#pragma unroll
                        for (int ks = 0; ks < 8; ++ks) { const bf16x8 A = *(const LAS bf16x8*)(lds + MC_QI + (16 * tt + l15) * MC_QROW + ks * 64 + l4 * 16);
                            const bf16x8 B = *(const LAS bf16x8*)(lds + MC_KI + (16 * st + l15) * MC_QROW + ks * 64 + l4 * 16); acc4 = MFMA16(A, B, acc4); }
                    }
                    const int sidx = 16 * st + l15; const float as_ = mc_sc(lds, 0)[sidx];
#pragma unroll
                    for (int rg = 0; rg < 4; ++rg) { const int t = 16 * tt + 4 * l4 + rg; float p = 0.f;
                        if (st <= tt && sidx <= t) p = acc4[rg] * __expf(as_ - mc_sc(lds, 1)[t]);
                        *(LAS unsigned short*)(lds + MC_P + t * MC_TROW + sidx * 2) = (unsigned short)f2bf(p);
                        float sum = p; sum += __shfl_xor(sum, 1); sum += __shfl_xor(sum, 2); sum += __shfl_xor(sum, 4); sum += __shfl_xor(sum, 8);
                        if (l15 == 0) mc_sc(lds, 7 + st)[t] = sum; }
                }
              const int t = tB >> 3, seg = tB & 7; float sacc = 0.f;
#pragma unroll
                for (int k = 0; k < 4; ++k) { const u32x4 qv = *(const LAS u32x4*)(lds + MC_QI + t * MC_QROW + (seg * 32 + k * 8) * 2);
                    const f32x4 n0 = *(const LAS f32x4*)(nvec + seg * 32 + k * 8), n1 = *(const LAS f32x4*)(nvec + seg * 32 + k * 8 + 4);
                    sacc += bflo(qv.x) * n0.x + bfhi(qv.x) * n0.y + bflo(qv.y) * n0.z + bfhi(qv.y) * n0.w + bflo(qv.z) * n1.x + bfhi(qv.z) * n1.y + bflo(qv.w) * n1.z + bfhi(qv.w) * n1.w; }
                sacc += __shfl_xor(sacc, 1); sacc += __shfl_xor(sacc, 2); sacc += __shfl_xor(sacc, 4);
                if (seg == 0) mc_sc(lds, 5)[t] = sacc; }
            __syncthreads();
            const float cd = misc[0];
            f32x16 acc[2];
            { OPQ(tC); const int laneC = tC & 63, r = laneC & 31, hf = laneC >> 5;
            if (tC < 64) { const int t = tC; const float den = mc_sc(lds, 7)[t] + mc_sc(lds, 8)[t] + mc_sc(lds, 9)[t] + mc_sc(lds, 10)[t];
                const float dn = den + mc_sc(lds, 2)[t] * mc_sc(lds, 5)[t]; mc_sc(lds, 6)[t] = frcp(fmaxf(fabsf(dn), mc_sc(lds, 4)[t])); }
#pragma unroll
            for (int t2 = 0; t2 < 2; ++t2)
#pragma unroll
                for (int i = 0; i < 16; ++i) acc[t2][i] = 0.f;
            const LAS unsigned char* qbase = lds + MC_QI + r * MC_QROW + hf * 8;
#pragma unroll
            for (int dt = 0; dt < 8; ++dt) { const bf16x8 cl = pack_lo(C[dt]), chh = pack_hi(C[dt]);
#pragma unroll
                for (int t2 = 0; t2 < 2; ++t2) { const LAS unsigned char* qb = qbase + t2 * 32 * MC_QROW + dt * 64;
                    const s16x4 a0l = *(const LAS s16x4*)(qb), a0h = *(const LAS s16x4*)(qb + 16), a1l = *(const LAS s16x4*)(qb + 32), a1h = *(const LAS s16x4*)(qb + 48);
                    acc[t2] = MFMA32(__builtin_shufflevector(a0l, a0h, 0, 1, 2, 3, 4, 5, 6, 7), cl, acc[t2]);
                    acc[t2] = MFMA32(__builtin_shufflevector(a1l, a1h, 0, 1, 2, 3, 4, 5, 6, 7), chh, acc[t2]); } }
#pragma unroll
            for (int t2 = 0; t2 < 2; ++t2)
#pragma unroll
                for (int i = 0; i < 16; ++i) acc[t2][i] *= mc_sc(lds, 2)[32 * t2 + crow(i, hf)];
            bf16x8 vt[4];
            const LAS unsigned char* vbase = lds + MC_VT + (32 * wave + r) * MC_TROW + hf * 16;
#pragma unroll
            for (int ks = 0; ks < 4; ++ks) vt[ks] = *(const LAS bf16x8*)(vbase + ks * 32);
            const LAS unsigned char* pbase = lds + MC_P + r * MC_TROW + hf * 16;
#pragma unroll
            for (int t2 = 0; t2 < 2; ++t2)
#pragma unroll
                for (int ks = 0; ks < 4; ++ks) { const bf16x8 pA = *(const LAS bf16x8*)(pbase + t2 * 32 * MC_TROW + ks * 32); acc[t2] = MFMA32(pA, vt[ks], acc[t2]); }
            asm volatile("" : "+v"(acc[0]), "+v"(acc[1]));
#pragma unroll
            for (int ks = 0; ks < 4; ++ks) {
                const f32x4 w0 = *(const LAS f32x4*)(mc_sc(lds, 3) + 16 * ks + 8 * hf), w1 = *(const LAS f32x4*)(mc_sc(lds, 3) + 16 * ks + 8 * hf + 4);
                const u32x4 vv = __builtin_bit_cast(u32x4, vt[ks]); u32x4 o;
                o.x = pk2(bflo(vv.x) * w0.x, bfhi(vv.x) * w0.y); o.y = pk2(bflo(vv.y) * w0.z, bfhi(vv.y) * w0.w); o.z = pk2(bflo(vv.z) * w1.x, bfhi(vv.z) * w1.y); o.w = pk2(bflo(vv.w) * w1.z, bfhi(vv.w) * w1.w);
                vt[ks] = __builtin_bit_cast(bf16x8, o); }
            const LAS unsigned char* kbase = lds + MC_KT + r * MC_TROW + hf * 16;
#pragma unroll
            for (int dt = 0; dt < 8; ++dt) {
#pragma unroll
                for (int i = 0; i < 16; ++i) C[dt][i] *= cd;
#pragma unroll
                for (int ks = 0; ks < 4; ++ks) { const bf16x8 kA = *(const LAS bf16x8*)(kbase + dt * 32 * MC_TROW + ks * 32); C[dt] = MFMA32(kA, vt[ks], C[dt]); } }
            if (tC < 256) { float sacc = cd * nvec[tC];
#pragma unroll
                for (int k = 0; k < 8; ++k) { const u32x4 kv = *(const LAS u32x4*)(lds + MC_KT + tC * MC_TROW + k * 16);
                    const f32x4 w0 = *(const LAS f32x4*)(mc_sc(lds, 3) + k * 8), w1 = *(const LAS f32x4*)(mc_sc(lds, 3) + k * 8 + 4);
                    sacc += bflo(kv.x) * w0.x + bfhi(kv.x) * w0.y + bflo(kv.y) * w0.z + bfhi(kv.y) * w0.w + bflo(kv.z) * w1.x + bfhi(kv.z) * w1.y + bflo(kv.w) * w1.z + bfhi(kv.w) * w1.w; }
                nvec[tC] = sacc; }
            }
            __syncthreads();
            { OPQ(tD); const int laneD = tD & 63, r = laneD & 31, hf = laneD >> 5;
              u32x2 zr[8];
#pragma unroll
              for (int k = 0; k < 8; ++k) zr[k] = *(const u32x2*)(ZM + (rowbase + 8 * wave + k) * 1024 + hd * MD + 4 * laneD);
              const f32x4 mhn = *(const f32x4*)(mh_norm + hd * MD + 4 * laneD), skp = *(const f32x4*)(skip + hd * MD + 4 * laneD);
#pragma unroll
              for (int t2 = 0; t2 < 2; ++t2)
#pragma unroll
                for (int i = 0; i < 16; ++i) *(LAS float*)(lds + MC_QI + (32 * t2 + crow(i, hf)) * MC_STROW + (32 * wave + r) * 4) = acc[t2][i];
              __syncthreads();
#pragma unroll
              for (int k = 0; k < 8; ++k) { const int t = 8 * wave + k; const float rden = mc_sc(lds, 6)[t];
                  const f32x4 h4 = *(const LAS f32x4*)(lds + MC_QI + t * MC_STROW + 16 * laneD) * rden;
                  const float s1 = wave_sum((h4.x + h4.y) + (h4.z + h4.w)), s2 = wave_sum((h4.x * h4.x + h4.y * h4.y) + (h4.z * h4.z + h4.w * h4.w));
                  const float mean = s1 * (1.0f / MD); const float var = fmaxf(s2 * (1.0f / MD) - mean * mean, 0.f); const float rstd = frsq(var + LN_EPS);
                  const float y0 = ((h4.x - mean) * rstd * mhn.x + skp.x * bflo(xcp[k].x)) * silu_f(bflo(zr[k].x)), y1 = ((h4.y - mean) * rstd * mhn.y + skp.y * bfhi(xcp[k].x)) * silu_f(bfhi(zr[k].x));
                  const float y2 = ((h4.z - mean) * rstd * mhn.z + skp.z * bflo(xcp[k].y)) * silu_f(bflo(zr[k].y)), y3 = ((h4.w - mean) * rstd * mhn.w + skp.w * bfhi(xcp[k].y)) * silu_f(bfhi(zr[k].y));
                  u32x2 o; o.x = pk2(y0, y1); o.y = pk2(y2, y3);
                  *(u32x2*)(QK + (rowbase + t) * 2048 + 1024 + hd * MD + 4 * laneD) = o; } }
            __syncthreads();
        }
    }
#undef OPQ
}

DI void phase_final(const Args& a, int lane, int wave, int bid, int G, int dry) {
    const float* x = a.in[0]; const float* g_post = a.in[3]; float* out = a.out;
    const int gw = bid * NWAVES + wave, NGW = G * NWAVES;
    const f32x4* gr = (const f32x4*)g_post + lane; f32x4 gg[4];
#pragma unroll
    for (int j = 0; j < 4; ++j) gg[j] = gr[64 * j];
    for (int m = gw; m < MTOK; m += NGW) {
        f32x4* yr = (f32x4*)(out + (size_t)m * DM) + lane; const f32x4* xr = (const f32x4*)(x + (size_t)m * DM) + lane; f32x4 v[4], xv[4]; float s = 0.f;
#pragma unroll
        for (int j = 0; j < 4; ++j) { v[j] = yr[64 * j]; xv[j] = xr[64 * j]; s += (v[j].x * v[j].x + v[j].y * v[j].y) + (v[j].z * v[j].z + v[j].w * v[j].w); }
        const float rstd = 1.0f / sqrtf(wave_sum(s) * (1.0f / DM) + RMS_EPS);
#pragma unroll
        for (int j = 0; j < 4; ++j) { f32x4 o; o.x = xv[j].x + v[j].x * rstd * gg[j].x; o.y = xv[j].y + v[j].y * rstd * gg[j].y; o.z = xv[j].z + v[j].z * rstd * gg[j].z; o.w = xv[j].w + v[j].w * rstd * gg[j].w; if (!dry) yr[64 * j] = o; else asm volatile("" :: "v"(o)); }
    }
}

#define XB_TMO      128
#define XB_XCNT(j)  (256  + 64 * (j))
#define XB_XSUB(j)  (1280 + 64 * (j))
#define XB_XGEN(j)  (2304 + 64 * (j))
#define XB_TOP      3328
#define XB_TOPGEN   3392
#define XCD_BAR_WORDS 3456
#define XB_SPIN_CAP (1u << 18)

__device__ __forceinline__ unsigned xb_ld(unsigned* p)              { return __hip_atomic_load(p, __ATOMIC_RELAXED, __HIP_MEMORY_SCOPE_AGENT); }
__device__ __forceinline__ unsigned xb_add(unsigned* p, unsigned v) { return __hip_atomic_fetch_add(p, v, __ATOMIC_RELAXED, __HIP_MEMORY_SCOPE_AGENT); }
__device__ __forceinline__ unsigned xb_xcc_id() { return (unsigned)__builtin_amdgcn_s_getreg((3 << 11) | 20) & 0xFu; }
#define XB_SPIN(cond, bar) do { unsigned _sp = 0; while (cond) { __builtin_amdgcn_s_sleep(1); \
    if ((++_sp & 255u) == 0u) { if (xb_ld(&(bar)[XB_TMO])) break; if (_sp > XB_SPIN_CAP) { atomicAdd(&(bar)[XB_TMO], 1u); break; } } } } while (0)

struct XcdBarrier {
    unsigned* bar; unsigned x;
    volatile LAS unsigned* st;
};

__device__ __forceinline__ XcdBarrier xcd_barrier_post(unsigned* bar, volatile LAS unsigned* st) {
    XcdBarrier b; b.bar = bar; b.x = xb_xcc_id(); b.st = st;
    if (threadIdx.x == 0) (void)xb_add(&bar[XB_XCNT(b.x)], 1u);
    return b;
}
__device__ __forceinline__ void xcd_barrier_complete(unsigned* bar, unsigned x, unsigned& nloc, unsigned& nx) {
    const unsigned G = gridDim.x * gridDim.y * gridDim.z;
    unsigned sum, cnt, mine, sp = 0u;
    for (;;) {
        sum = 0u; cnt = 0u; mine = 0u;
#pragma unroll
        for (unsigned j = 0; j < 16; ++j) { const unsigned c = xb_ld(&bar[XB_XCNT(j)]); sum += c; cnt += (c > 0u) ? 1u : 0u; mine = (j == x) ? c : mine; }
        if (sum == G) break;
        __builtin_amdgcn_s_sleep(1);
        if ((++sp & 255u) == 0u) { if (xb_ld(&bar[XB_TMO])) break; if (sp > XB_SPIN_CAP) { atomicAdd(&bar[XB_TMO], 1u); break; } }
    }
    nloc = mine > 0u ? mine : 1u; nx = cnt > 0u ? cnt : 1u;
}

__device__ __forceinline__ void xcd_barrier(const XcdBarrier& b) {
    asm volatile("s_waitcnt vmcnt(0)" ::: "memory");
    __syncthreads();
    if (threadIdx.x == 0) {
        unsigned* bar = b.bar;
        __builtin_amdgcn_s_waitcnt(0);
        unsigned nloc = b.st[0], nx = b.st[1];
        if (nloc == 0u) { xcd_barrier_complete(bar, b.x, nloc, nx); b.st[0] = nloc; b.st[1] = nx; }
        const unsigned old = xb_add(&bar[XB_XSUB(b.x)], 1u);
        const unsigned gen = old / nloc;
        if (old + 1u == (gen + 1u) * nloc) {
            __builtin_amdgcn_fence(__ATOMIC_RELEASE, "agent");
            asm volatile("s_waitcnt vmcnt(0)" ::: "memory");
            const unsigned og = xb_add(&bar[XB_TOP], 1u);
            const unsigned tg = og / nx;
            if (og + 1u == (tg + 1u) * nx) xb_add(&bar[XB_TOPGEN], 1u);
            else XB_SPIN(xb_ld(&bar[XB_TOPGEN]) == tg, bar);
            __builtin_amdgcn_fence(__ATOMIC_ACQUIRE, "agent");
            xb_add(&bar[XB_XGEN(b.x)], 1u);
            asm volatile("s_waitcnt vmcnt(0)" ::: "memory");
        } else {
            XB_SPIN(xb_ld(&bar[XB_XGEN(b.x)]) == gen, bar);
            __builtin_amdgcn_fence(__ATOMIC_ACQUIRE, "agent");
            asm volatile("s_waitcnt vmcnt(0)" ::: "memory");
        }
    }
    __syncthreads();
}

constexpr int NPHASE = 12;
#ifndef DUP_PHASE
#define DUP_PHASE -1
#endif
#define NREP(k) (DUP_PHASE == (k) ? 2 : 1)
#ifndef MK_MULTI
#define MK_MULTI 0
#endif
__global__ void __launch_bounds__(NTHR, 2) hymba_fwd(Args args) {
    extern __shared__ __attribute__((aligned(16))) unsigned char lds_raw[];
    LAS unsigned char* lds = (LAS unsigned char*)lds_raw;
    cg::grid_group grid = cg::this_grid();
    const int tid = threadIdx.x, lane = tid & 63, wave = __builtin_amdgcn_readfirstlane(tid >> 6), bid = blockIdx.x, G = gridDim.x;
    const int lo = args.ph_lo, hi = args.ph_hi;
#ifdef ONLY_PHASE
#define IN(k) ((k) == ONLY_PHASE && lo <= (k) && (k) < hi)
#else
#define IN(k) (lo <= (k) && (k) < hi)
#endif
    unsigned char* ws = args.ws;
    volatile LAS unsigned* barst = (volatile LAS unsigned*)(lds + LDS_BARST);
    if (tid < 2) barst[tid] = 0u;
    __syncthreads();
    XcdBarrier xbar = xcd_barrier_post((unsigned*)(ws + WS_CTL) + CW_BAR, barst);
#define SEAM(k) do { if (IN(k) && IN((k) + 1)) { if ((k) == 0) grid.sync(); else xcd_barrier(xbar); } } while (0)
#undef DUPSYNC
    if (IN(0)) { for (int rep = 0; rep < NREP(0); ++rep) { if (rep) xcd_barrier(xbar); int t_ = tid; asm volatile("" : "+v"(t_)); phase_prologue(args, lds, t_, t_ & 63, wave, bid, G); } } SEAM(0);
    if (IN(1)) {
        pg8::Gemm g{(const pg8::bf16_t*)(ws + WS_XN), (const pg8::bf16_t*)(ws + WS_WINT), MTOK, NIN, DM}; pg8::StaticOrder S; S.init(MTOK, NIN, G, bid);
        pg8::EpiProj E{(pg8::bf16_t*)(ws + WS_QK), (pg8::bf16_t*)(ws + WS_V), (pg8::bf16_t*)(ws + WS_G), (pg8::bf16_t*)(ws + WS_XM), (pg8::bf16_t*)(ws + WS_ZM), QSCALE, (float*)(ws + WS_KM2), (float*)(ws + WS_KA2)};
        for (int rep = 0; rep < NREP(1); ++rep) { if (rep) xcd_barrier(xbar); pg8::gemm_phase<pg8::EpiProj, pg8::StaticOrder, true, true>(lds, g, S, E); }
    } SEAM(1);
    if (IN(2)) { for (int rep = 0; rep < NREP(2); ++rep) { if (rep) xcd_barrier(xbar); int t_ = tid; asm volatile("" : "+v"(t_)); phase_mgate(args, lds, t_, t_ & 63, wave, bid, G); } } SEAM(2);
    if (IN(3)) { for (int rep = 0; rep < NREP(3); ++rep) { if (rep) xcd_barrier(xbar); int t_ = tid; asm volatile("" : "+v"(t_)); phase_sel(args, lds, t_, t_ & 63, wave, bid, G, rep); } } SEAM(3);
    if (IN(4)) { for (int rep = 0; rep < NREP(4); ++rep) { if (rep) xcd_barrier(xbar); int t_ = tid; asm volatile("" : "+v"(t_)); phase_att_gather(args, lds, t_, t_ & 63, wave, bid, G, rep); } } SEAM(4);
    if (IN(5)) { for (int rep = 0; rep < NREP(5); ++rep) { if (rep) xcd_barrier(xbar); int t_ = tid; asm volatile("" : "+v"(t_)); phase_att_own(args, lds, t_, t_ & 63, wave, bid, G, rep); } } SEAM(5);
    if (IN(7)) { for (int rep = 0; rep < NREP(7); ++rep) { if (rep) xcd_barrier(xbar); int t_ = tid; asm volatile("" : "+v"(t_)); phase_mstate(args, lds, t_, t_ & 63, wave, bid, G); } } SEAM(7);
    if (IN(8)) { for (int rep = 0; rep < NREP(8); ++rep) { if (rep) xcd_barrier(xbar); phase_mcomb(args, tid, bid, G, rep); } } SEAM(8);
    if (IN(9)) { for (int rep = 0; rep < NREP(9); ++rep) { if (rep) xcd_barrier(xbar); int t_ = tid; asm volatile("" : "+v"(t_)); phase_mscan(args, lds, t_, t_ & 63, wave, bid, G); } } SEAM(9);
    if (IN(10)) {
        pg8::Gemm g{(const pg8::bf16_t*)(ws + WS_QK), (const pg8::bf16_t*)(ws + WS_WOUTT), MTOK, DM, MIXW}; pg8::StaticOrder S; S.init(MTOK, DM, G, bid);
        pg8::EpiF32 E{args.out, DM};
        for (int rep = 0; rep < NREP(10); ++rep) { if (rep) xcd_barrier(xbar); pg8::gemm_phase<pg8::EpiF32, pg8::StaticOrder, true, true>(lds, g, S, E); }
    } SEAM(10);
    if (IN(11)) { for (int rep = 0; rep < NREP(11); ++rep) { if (rep) xcd_barrier(xbar); phase_final(args, lane, wave, bid, G, rep); } }
#undef IN
#undef SEAM
}

extern "C" void kernel_launch(void* const* d_in, const int* in_sizes, int n_in, void* d_out, int out_size, void* d_ws, size_t ws_size, hipStream_t stream) {
    static int grid = 0;
    if (grid == 0) {
        if (n_in != 15 || out_size != MTOK * DM || ws_size < WS_END) { fprintf(stderr, "kernel_launch: unexpected shapes (n_in %d out %d ws %zu)\n", n_in, out_size, ws_size); grid = -1; return; }
        int dev = 0, cus = 0, per_cu = 0;
        if (hipGetDevice(&dev) != hipSuccess || hipDeviceGetAttribute(&cus, hipDeviceAttributeMultiprocessorCount, dev) != hipSuccess) { grid = -1; return; }
        if (hipFuncSetAttribute((const void*)hymba_fwd, hipFuncAttributeMaxDynamicSharedMemorySize, LDS_BYTES) != hipSuccess) { fprintf(stderr, "kernel_launch: hipFuncSetAttribute failed\n"); grid = -1; return; }
        if (hipOccupancyMaxActiveBlocksPerMultiprocessor(&per_cu, (const void*)hymba_fwd, NTHR, LDS_BYTES) != hipSuccess || per_cu < 1) { fprintf(stderr, "kernel_launch: occupancy query says %d\n", per_cu); per_cu = 1; }
        (void)hipGetLastError();
        grid = cus * 1;
        fprintf(stderr, "kernel_launch: grid %d (cus %d, query per_cu %d)\n", grid, cus, per_cu);
    }
    if (grid < 0) return;
    (void)hipMemsetAsync((char*)d_ws + WS_CTL, 0, CTL_ZERO_BYTES, stream);
    Args a{};
    for (int i = 0; i < 15; ++i) a.in[i] = (const float*)d_in[i];
    a.out = (float*)d_out; a.ws = (unsigned char*)d_ws;
#if MK_MULTI
    for (int p = 0; p < NPHASE; ++p) { a.ph_lo = p; a.ph_hi = p + 1; hipLaunchKernelGGL(hymba_fwd, dim3(grid), dim3(NTHR), LDS_BYTES, stream, a); }
#else
    a.ph_lo = 0; a.ph_hi = NPHASE;
    void* kargs[] = {&a};
    hipError_t e = hipLaunchCooperativeKernel((const void*)hymba_fwd, dim3(grid), dim3(NTHR), kargs, LDS_BYTES, stream);
    if (e != hipSuccess) fprintf(stderr, "kernel_launch: cooperative launch failed: %s (grid %d)\n", hipGetErrorString(e), grid);
#endif
}
```

```cpp
#include <hip/hip_runtime.h>
#include <hip/hip_cooperative_groups.h>
#include <cstdio>
#include <cstdint>
namespace cg = cooperative_groups;
namespace pg8 {
#define PG8_LAS __attribute__((address_space(3)))
typedef unsigned short bf16_t;
typedef short bf16x8 __attribute__((ext_vector_type(8)));
typedef float f32x4 __attribute__((ext_vector_type(4)));
typedef unsigned u32x4 __attribute__((ext_vector_type(4)));
constexpr int BM = 256, BK = 64, HALF = 128, HTB = HALF * BK * 2  , STAGE_BYTES = 8 * HTB, NXCD = 8, WGM = 8;

__host__ __device__ __forceinline__ int lds_byte(int r, int c) { const int st = (r >> 4) * 2 + (c >> 5), rr = r & 15, cc = c & 31, ob = rr * 64 + cc * 2; return st * 1024 + (ob ^ (((ob >> 9) & 1) << 5)); }
__host__ __device__ __forceinline__ void stage_rc(int b, int& R, int& C) { const int st = b / 1024, sb = b % 1024, swz = sb ^ (((sb >> 9) & 1) << 5); R = (st >> 1) * 16 + swz / 64; C = (st & 1) * 32 + (swz % 64) / 2; }
__host__ __device__ __forceinline__ int perm32(int rho) { const int n = rho >> 4, i = rho & 15; return 8 * (i >> 2) + 4 * n + (i & 3); }

struct Unit { int pm, pn; };
struct Gemm { const bf16_t* A; const bf16_t* Bt; int M, N, K; };

struct StaticOrder {
    int nM, nN, nwg, G, c;
    __host__ __device__ void init(int M, int N, int G_, int c_) { nM = M / BM; nN = N / BM; nwg = nM * nN; G = G_; c = c_; }
    __host__ __device__ bool next(int i, Unit& u) const {
        const long L = (long)i * G + c; if (L >= nwg) return false;
        int wgid = (int)L; { const int q = nwg / NXCD, r = nwg % NXCD, xcd = wgid % NXCD, off = wgid / NXCD; wgid = (xcd < r ? xcd * (q + 1) : r * (q + 1) + (xcd - r) * q) + off; }
        const int nig = WGM * nN, gid = wgid / nig, fm = gid * WGM, gsz = (nM - fm) < WGM ? (nM - fm) : WGM;
        u.pm = fm + ((wgid % nig) % gsz); u.pn = (wgid % nig) / gsz; return true;
    }
    __device__ __forceinline__ void a_ready(const Unit&) const {}
    __device__ __forceinline__ void done(const Unit&) const {}
};

__device__ __forceinline__ unsigned cvt_pk_bf16(float lo, float hi) { unsigned r; asm volatile("v_cvt_pk_bf16_f32 %0, %1, %2" : "=v"(r) : "v"(lo), "v"(hi)); return r; }
typedef float f32x2 __attribute__((ext_vector_type(2)));
struct EpiProj {
    static constexpr bool PERM = true, AFTER_DRAIN = false;
    bf16_t* QK; bf16_t* V; bf16_t* G; bf16_t* XM; bf16_t* ZM; float qscale; float* KMEAN; float* KABS;
    __device__ __forceinline__ void operator()(const f32x4 (&acc)[2][2][4][2], const Unit& u, int wr, int wc, int fr, int fq) const {
        const int row0 = u.pm * BM + wr * 64 + fr; const int colt = u.pn * BM; const int t = colt >> 10; const int cgp = colt & 1023;
        bf16_t* base; int ldc; float sc = 1.f;
        if (t == 0) { base = QK; ldc = 2048; sc = qscale; } else if (t == 1) { base = QK + 1024; ldc = 2048; } else if (t == 2) { base = V; ldc = 1024; }
        else if (t == 3) { base = G; ldc = 1024; } else if (t == 4) { base = XM; ldc = 1024; } else { base = ZM; ldc = 1024; }
        const int col0 = cgp + wc * 32 + 8 * fq;
#pragma unroll
        for (int ai = 0; ai < 2; ++ai)
#pragma unroll
            for (int m = 0; m < 4; ++m) { bf16_t* rowp = base + (size_t)(row0 + ai * HALF + m * 16) * ldc + col0;
#pragma unroll
                for (int bj = 0; bj < 2; ++bj) { f32x4 v0 = acc[ai][bj][m][0] * sc, v1 = acc[ai][bj][m][1] * sc;
                    u32x4 w; w.x = cvt_pk_bf16(v0[0], v0[1]); w.y = cvt_pk_bf16(v0[2], v0[3]); w.z = cvt_pk_bf16(v1[0], v1[1]); w.w = cvt_pk_bf16(v1[2], v1[3]);
                    *(u32x4*)(rowp + bj * HALF) = w; } }
        if (t == 1) {
            const int b = u.pm >> 5, blk = u.pm & 31;
#pragma unroll
            for (int bj = 0; bj < 2; ++bj)
#pragma unroll
                for (int n = 0; n < 2; ++n) { f32x4 s = {0.f, 0.f, 0.f, 0.f}, mx = {0.f, 0.f, 0.f, 0.f};
#pragma unroll
                    for (int ai = 0; ai < 2; ++ai)
#pragma unroll
                        for (int m = 0; m < 4; ++m) { const f32x4 v = acc[ai][bj][m][n]; s += v; mx[0] = fmaxf(mx[0], fabsf(v[0])); mx[1] = fmaxf(mx[1], fabsf(v[1])); mx[2] = fmaxf(mx[2], fabsf(v[2])); mx[3] = fmaxf(mx[3], fabsf(v[3])); }
#pragma unroll
                    for (int o = 1; o < 16; o <<= 1)
#pragma unroll
                        for (int e = 0; e < 4; ++e) { s[e] += __shfl_xor(s[e], o); mx[e] = fmaxf(mx[e], __shfl_xor(mx[e], o)); }
                    if (fr == 0) { const int col = cgp + bj * HALF + wc * 32 + 8 * fq + 4 * n; const int head = col >> 7, d = col & 127;
                        const size_t idx = ((size_t)((wr * 32 + b * 8 + head) * 32 + blk)) * 128 + d;
                        *(f32x4*)(KMEAN + idx) = s * (1.0f / 256.0f); *(f32x4*)(KABS + idx) = mx; } }
        }
    }
};
struct EpiF32 {
    static constexpr bool PERM = false, AFTER_DRAIN = false;
    float* O; int ldc;
    __device__ __forceinline__ void operator()(const f32x4 (&acc)[2][2][4][2], const Unit& u, int wr, int wc, int fr, int fq) const {
        const int col0 = u.pn * BM + wc * 32 + 4 * fq;
#pragma unroll
        for (int ai = 0; ai < 2; ++ai)
#pragma unroll
            for (int m = 0; m < 4; ++m) { const int r = ai * HALF + wr * 64 + m * 16 + fr; const size_t off = (size_t)(u.pm * BM + r) * ldc + col0;
#pragma unroll
                for (int bj = 0; bj < 2; ++bj)
#pragma unroll
                    for (int n = 0; n < 2; ++n) *(f32x4*)(O + off + bj * HALF + n * 16) = acc[ai][bj][m][n]; }
    }
};
template <class Epi, class Sched, bool ALIGN_EPI = false, bool SP2 = false>
__device__ __forceinline__ void gemm_phase(PG8_LAS unsigned char* lds, const Gemm g, const Sched& S, const Epi& E) {
    const int tid = threadIdx.x, wid = __builtin_amdgcn_readfirstlane(tid >> 6), lane = tid & 63, wr = wid >> 2, wc = wid & 3, fr = lane & 15, fq = lane >> 4;
    const int K = g.K, nt = K / BK;
    unsigned voffA[2], voffB[2];
#pragma unroll
    for (int i = 0; i < 2; ++i) { int R, C; stage_rc(tid * 16 + i * 8192, R, C); const int Rb = Epi::PERM ? ((R & ~31) + perm32(R & 31)) : R;
        voffA[i] = (unsigned)(R * K + C) * 2u; voffB[i] = (unsigned)(Rb * K + C) * 2u; }
    const size_t kstep = (size_t)(BK * 2);
    const size_t hstep = (size_t)HALF * K * 2;
    const size_t tstep = 2 * hstep;
    const unsigned ldsw = (unsigned)wid * 1024u;
    const int aoff = lds_byte(wr * 64 + fr, fq * 8), boff = lds_byte(wc * 32 + fr, fq * 8);
#define PG8_SA(b, h) (((b) * 2 + (h)) * HTB)
#define PG8_SB(b, h) ((4 + (b) * 2 + (h)) * HTB)
#define PG8_STAGE(bufoff, gbase, voff) do { _Pragma("unroll") for (int _i = 0; _i < 2; ++_i) \
        __builtin_amdgcn_global_load_lds((const unsigned*)((const char*)(gbase) + (voff)[_i]), (PG8_LAS unsigned*)(lds + (bufoff) + ldsw + _i * 8192), 16, 0, 0); } while (0)
#define PG8_LDA(dst, b, h) do { _Pragma("unroll") for (int m = 0; m < 4; ++m) _Pragma("unroll") for (int k = 0; k < 2; ++k) dst[m][k] = *(const PG8_LAS bf16x8*)(lds + PG8_SA(b, h) + aoff + m * 2048 + k * 1024); } while (0)
#define PG8_LDB(dst, b, h) do { _Pragma("unroll") for (int n = 0; n < 2; ++n) _Pragma("unroll") for (int k = 0; k < 2; ++k) dst[n][k] = *(const PG8_LAS bf16x8*)(lds + PG8_SB(b, h) + boff + n * 2048 + k * 1024); } while (0)
#define PG8_MMA(ai, bj, At, Bt) do { __builtin_amdgcn_s_setprio(1); _Pragma("unroll") for (int m = 0; m < 4; ++m) _Pragma("unroll") for (int n = 0; n < 2; ++n) _Pragma("unroll") for (int k = 0; k < 2; ++k) \
        acc[ai][bj][m][n] = __builtin_amdgcn_mfma_f32_16x16x32_bf16(Bt[n][k], At[m][k], acc[ai][bj][m][n], 0, 0, 0); __builtin_amdgcn_s_setprio(0); } while (0)
#define PG8_WAIT_V(n) asm volatile("s_waitcnt vmcnt(" #n ")" ::: "memory")
#define PG8_WAIT_L(n) asm volatile("s_waitcnt lgkmcnt(" #n ")" ::: "memory")
#define PG8_BAR __builtin_amdgcn_s_barrier()
#define PG8_SCHED __builtin_amdgcn_sched_barrier(0)
    Unit cur, nxt; int ui = 0;
    if (!S.next(0, cur)) return;
    f32x4 acc[2][2][4][2];
#pragma unroll
    for (int a = 0; a < 2; ++a)
#pragma unroll
        for (int b = 0; b < 2; ++b)
#pragma unroll
            for (int m = 0; m < 4; ++m)
#pragma unroll
                for (int n = 0; n < 2; ++n) acc[a][b][m][n] = (f32x4){0.f, 0.f, 0.f, 0.f};
    bf16x8 At[4][2], B0[2][2], B1[2][2];
    const char* cA = (const char*)g.A + (size_t)cur.pm * tstep; const char* cB = (const char*)g.Bt + (size_t)cur.pn * tstep;
    S.a_ready(cur);
    if constexpr (SP2) {
        PG8_STAGE(PG8_SB(0, 0), cB, voffB); PG8_STAGE(PG8_SB(0, 1), cB + hstep, voffB); PG8_STAGE(PG8_SA(0, 0), cA, voffA); PG8_STAGE(PG8_SA(0, 1), cA + hstep, voffA);
        if (wr == 1) PG8_BAR;
        PG8_WAIT_V(2); PG8_BAR;
        PG8_STAGE(PG8_SB(1, 0), cB + kstep, voffB); PG8_STAGE(PG8_SA(1, 0), cA + kstep, voffA); PG8_STAGE(PG8_SB(1, 1), cB + hstep + kstep, voffB);
        PG8_WAIT_V(6); PG8_BAR;
    } else {
        PG8_STAGE(PG8_SB(0, 0), cB, voffB); PG8_STAGE(PG8_SA(0, 0), cA, voffA); PG8_STAGE(PG8_SB(0, 1), cB + hstep, voffB); PG8_STAGE(PG8_SA(0, 1), cA + hstep, voffA);
        if (wr == 1) PG8_BAR;
        PG8_WAIT_V(4); PG8_BAR;
        PG8_STAGE(PG8_SB(1, 0), cB + kstep, voffB); PG8_STAGE(PG8_SA(1, 0), cA + kstep, voffA); PG8_STAGE(PG8_SB(1, 1), cB + hstep + kstep, voffB);
        PG8_WAIT_V(6); PG8_BAR;
    }
    for (;;) {
        const bool has_next = S.next(ui + 1, nxt);
        const char* nA = has_next ? (const char*)g.A + (size_t)nxt.pm * tstep : cA; const char* nB = has_next ? (const char*)g.Bt + (size_t)nxt.pn * tstep : cB;
        for (int t = 0; t < nt; t += 2) {
            const bool last = (t == nt - 2);
            const char* a1 = cA + (size_t)(t + 1) * kstep;
            const char* a2 = last ? nA : cA + (size_t)(t + 2) * kstep; const char* b2 = last ? nB : cB + (size_t)(t + 2) * kstep;
            const char* a3 = a2 + kstep; const char* b3 = b2 + kstep;
            if (last && has_next) S.a_ready(nxt);
            if constexpr (SP2) {
            PG8_LDB(B0, 0, 0); PG8_LDB(B1, 0, 1); PG8_SCHED; PG8_LDA(At, 0, 0); PG8_STAGE(PG8_SA(1, 1), a1 + hstep, voffA);
            PG8_WAIT_V(8); PG8_WAIT_L(0); PG8_BAR; PG8_MMA(0, 0, At, B0); PG8_MMA(0, 1, At, B1); PG8_BAR; PG8_SCHED;
            PG8_LDA(At, 0, 1); PG8_STAGE(PG8_SB(0, 0), b2, voffB); PG8_STAGE(PG8_SB(0, 1), b2 + hstep, voffB); PG8_STAGE(PG8_SA(0, 0), a2, voffA);
            PG8_WAIT_V(8); PG8_WAIT_L(0); PG8_BAR; PG8_MMA(1, 0, At, B0); PG8_MMA(1, 1, At, B1); PG8_BAR; PG8_SCHED;
            PG8_LDB(B0, 1, 0); PG8_LDB(B1, 1, 1); PG8_SCHED; PG8_LDA(At, 1, 0); PG8_STAGE(PG8_SA(0, 1), a2 + hstep, voffA);
            PG8_WAIT_V(8); PG8_WAIT_L(0); PG8_BAR; PG8_MMA(0, 0, At, B0); PG8_MMA(0, 1, At, B1); PG8_BAR; PG8_SCHED;
            PG8_LDA(At, 1, 1); PG8_STAGE(PG8_SB(1, 0), b3, voffB); PG8_STAGE(PG8_SB(1, 1), b3 + hstep, voffB); PG8_STAGE(PG8_SA(1, 0), a3, voffA);
            PG8_WAIT_V(8); PG8_WAIT_L(0); PG8_BAR; PG8_MMA(1, 0, At, B0); PG8_MMA(1, 1, At, B1); PG8_BAR; PG8_SCHED;
            } else {
            PG8_LDB(B0, 0, 0); PG8_SCHED; PG8_LDA(At, 0, 0); PG8_STAGE(PG8_SA(1, 1), a1 + hstep, voffA);
            PG8_WAIT_L(8); PG8_BAR; PG8_WAIT_L(0); PG8_MMA(0, 0, At, B0); PG8_BAR; PG8_SCHED;
            PG8_LDB(B1, 0, 1); PG8_STAGE(PG8_SB(0, 0), b2, voffB);
            PG8_BAR; PG8_WAIT_L(0); PG8_MMA(0, 1, At, B1); PG8_BAR;
            PG8_LDA(At, 0, 1); PG8_STAGE(PG8_SA(0, 0), a2, voffA);
            PG8_BAR; PG8_WAIT_L(0); PG8_MMA(1, 0, At, B0); PG8_BAR; PG8_SCHED;
            PG8_STAGE(PG8_SB(0, 1), b2 + hstep, voffB);
            PG8_WAIT_V(6); PG8_BAR; PG8_MMA(1, 1, At, B1); PG8_BAR;
            PG8_LDB(B0, 1, 0); PG8_SCHED; PG8_LDA(At, 1, 0); PG8_STAGE(PG8_SA(0, 1), a2 + hstep, voffA);
            PG8_WAIT_L(8); PG8_BAR; PG8_WAIT_L(0); PG8_MMA(0, 0, At, B0); PG8_BAR; PG8_SCHED;
            PG8_LDB(B1, 1, 1); PG8_STAGE(PG8_SB(1, 0), b3, voffB);
            PG8_BAR; PG8_WAIT_L(0); PG8_MMA(0, 1, At, B1); PG8_BAR;
            PG8_LDA(At, 1, 1); PG8_STAGE(PG8_SA(1, 0), a3, voffA);
            PG8_BAR; PG8_WAIT_L(0); PG8_MMA(1, 0, At, B0); PG8_BAR; PG8_SCHED;
            PG8_STAGE(PG8_SB(1, 1), b3 + hstep, voffB);
            PG8_WAIT_V(6); PG8_BAR; PG8_MMA(1, 1, At, B1); PG8_BAR;
            }
        }
        if constexpr (ALIGN_EPI) { if (wr == 0) PG8_BAR; }
        if constexpr (!Epi::AFTER_DRAIN) { E(acc, cur, wr, wc, fr, fq); S.done(cur); }
        if (!has_next) break;
#pragma unroll
        for (int a = 0; a < 2; ++a)
#pragma unroll
            for (int b = 0; b < 2; ++b)
#pragma unroll
                for (int m = 0; m < 4; ++m)
#pragma unroll
                    for (int n = 0; n < 2; ++n) acc[a][b][m][n] = (f32x4){0.f, 0.f, 0.f, 0.f};
        cur = nxt; cA = nA; cB = nB; ++ui;
        if constexpr (ALIGN_EPI) { if (wr == 1) PG8_BAR; }
    }
    PG8_WAIT_V(0);
    if constexpr (!ALIGN_EPI) { if (wr == 0) PG8_BAR; }
    PG8_BAR;
    if constexpr (Epi::AFTER_DRAIN) { E.fused(acc, cur, wr, wc, fr, fq, lds, wid, lane); S.done(cur); }
#undef PG8_SA
#undef PG8_SB
#undef PG8_STAGE
#undef PG8_LDA
#undef PG8_LDB
#undef PG8_MMA
#undef PG8_WAIT_V
#undef PG8_WAIT_L
#undef PG8_BAR
#undef PG8_SCHED
}
}

constexpr int NWAVES = 8, NTHR = 512;
constexpr int BATCH = 4, SEQ = 8192, DM = 1024, MTOK = BATCH * SEQ, NIN = 6144, MIXW = 2048;
constexpr int NH = 8, DH = 128, NBLK = SEQ / 256;
constexpr int MH = 4, MD = 256, LCH = 64, NCH = SEQ / LCH;
constexpr float LOG2E = 1.4426950408889634f;
constexpr float QSCALE = 0.08838834764831845f * LOG2E;
constexpr float RMS_EPS = 1e-6f, LN_EPS = 1e-5f;
constexpr int LISTSZ = 256 * 496;
__host__ __device__ constexpr int list_off(int j) { return 256 * (31 * j - (j * (j - 1)) / 2); }

constexpr size_t MiB = 1u << 20;
constexpr size_t WS_CTL = 0, CTL_ZERO_BYTES = 64 * 1024;
constexpr size_t WS_BIASD = 1 * MiB;
constexpr size_t WS_WEFF = 1 * MiB + 64 * 1024;
constexpr size_t WS_KMEAN = 1 * MiB + 128 * 1024;
constexpr size_t WS_KMAX = 1 * MiB + 640 * 1024;
constexpr size_t WS_BMAX = WS_KMAX + 32 * 1024;
constexpr size_t WS_KM2 = 43 * MiB, WS_KA2 = 44 * MiB;
constexpr size_t WS_GLI = 2 * MiB, WS_GLF = 2 * MiB + 512 * 1024;
constexpr size_t WS_SEL = 3 * MiB;
constexpr size_t WS_LPART = 7 * MiB;
constexpr size_t WS_WINT = 10 * MiB;
constexpr size_t WS_WOUTT = 22 * MiB;
constexpr size_t WS_LIST = 26 * MiB;
constexpr size_t WS_XN = 64 * MiB;
constexpr size_t WS_QK = 128 * MiB;
constexpr size_t WS_V = 256 * MiB, WS_G = 320 * MiB, WS_XM = 384 * MiB, WS_ZM = 448 * MiB, WS_END = 512 * MiB;
constexpr size_t WS_NST = 42 * MiB;
constexpr size_t WS_PST = 42 * MiB + 512 * 1024, WS_MIN = 42 * MiB + 516 * 1024;
constexpr size_t WS_CST = WS_V;
constexpr int NSC = 16, SCCH = NCH / NSC;
constexpr int CW_CNT = 1024;
constexpr int CW_BAR = 4096;
constexpr int LDS_BARST = 163840 - 64;

constexpr int LDS_BYTES = 163840;
#define GAS __attribute__((address_space(1)))
#define LAS __attribute__((address_space(3)))
#define DI __device__ __forceinline__
typedef unsigned short bf16;
typedef unsigned u32x4 __attribute__((ext_vector_type(4)));
typedef unsigned u32x2 __attribute__((ext_vector_type(2)));
typedef int i32x4 __attribute__((ext_vector_type(4)));
typedef float f32x4 __attribute__((ext_vector_type(4)));
typedef float f32x16 __attribute__((ext_vector_type(16)));
typedef short bf16x8 __attribute__((ext_vector_type(8)));
typedef short s16x4 __attribute__((ext_vector_type(4)));
typedef float f32x2_t __attribute__((ext_vector_type(2)));
typedef __bf16 bf16x2_t __attribute__((ext_vector_type(2)));
#define MFMA32(a, b, c) __builtin_amdgcn_mfma_f32_32x32x16_bf16((a), (b), (c), 0, 0, 0)
#define MFMA16(a, b, c) __builtin_amdgcn_mfma_f32_16x16x32_bf16((a), (b), (c), 0, 0, 0)

DI float bf2f(unsigned u16) { return __uint_as_float(u16 << 16); }
DI float bflo(unsigned w) { return __uint_as_float(w << 16); }
DI float bfhi(unsigned w) { return __uint_as_float(w & 0xffff0000u); }
DI unsigned pk2(float lo, float hi) { f32x2_t v = {lo, hi}; bf16x2_t b = __builtin_convertvector(v, bf16x2_t); return __builtin_bit_cast(unsigned, b); }
DI unsigned f2bf(float f) { return pk2(f, 0.f) & 0xffffu; }
DI int crow(int reg, int h) { return (reg & 3) + 8 * (reg >> 2) + 4 * h; }
DI float wave_sum(float v) {
#pragma unroll
    for (int o = 1; o < 64; o <<= 1) v += __shfl_xor(v, o);
    return v;
}
DI float wave_sum_dpp(float v) {
    v += __builtin_bit_cast(float, __builtin_amdgcn_update_dpp(0, __builtin_bit_cast(int, v), 0xB1, 0xF, 0xF, true));
    v += __builtin_bit_cast(float, __builtin_amdgcn_update_dpp(0, __builtin_bit_cast(int, v), 0x4E, 0xF, 0xF, true));
    v += __builtin_bit_cast(float, __builtin_amdgcn_update_dpp(0, __builtin_bit_cast(int, v), 0x141, 0xF, 0xF, true));
    v += __builtin_bit_cast(float, __builtin_amdgcn_update_dpp(0, __builtin_bit_cast(int, v), 0x140, 0xF, 0xF, true));
    const int iv = __builtin_bit_cast(int, v);
    return (__builtin_bit_cast(float, __builtin_amdgcn_readlane(iv, 0)) + __builtin_bit_cast(float, __builtin_amdgcn_readlane(iv, 16))) +
           (__builtin_bit_cast(float, __builtin_amdgcn_readlane(iv, 32)) + __builtin_bit_cast(float, __builtin_amdgcn_readlane(iv, 48)));
}
DI float wave_max(float v) {
#pragma unroll
    for (int o = 1; o < 64; o <<= 1) v = fmaxf(v, __shfl_xor(v, o));
    return v;
}
DI bf16x8 pack_lo(const f32x16& x) { u32x4 p; p.x = pk2(x[0], x[1]); p.y = pk2(x[2], x[3]); p.z = pk2(x[4], x[5]); p.w = pk2(x[6], x[7]); return __builtin_bit_cast(bf16x8, p); }
DI bf16x8 pack_hi(const f32x16& x) { u32x4 p; p.x = pk2(x[8], x[9]); p.y = pk2(x[10], x[11]); p.z = pk2(x[12], x[13]); p.w = pk2(x[14], x[15]); return __builtin_bit_cast(bf16x8, p); }
DI float frcp(float x) { return __builtin_amdgcn_rcpf(x); }
DI float frsq(float x) { return __builtin_amdgcn_rsqf(x); }
DI float silu_f(float v) { return v * frcp(1.0f + __builtin_amdgcn_exp2f(-LOG2E * v)); }

struct Args { const float* in[15]; float* out; unsigned char* ws; int ph_lo, ph_hi; };

DI void p0_transpose_item(const float* W, int K, int N, bf16* WT, LAS float* scr, int item, int lane) {
    const int nblk = N / 32, kb = item / nblk, nb = item % nblk, k0 = 64 * kb, n0 = 32 * nb;
#pragma unroll 8
    for (int i = 0; i < 32; ++i) { const int kk = 2 * i + (lane >> 5); scr[kk * 33 + (lane & 31)] = W[(size_t)(k0 + kk) * N + n0 + (lane & 31)]; }
    asm volatile("s_waitcnt lgkmcnt(0)" ::: "memory");
    const int c = lane & 7;
#pragma unroll
    for (int j = 0; j < 4; ++j) { const int n = (lane >> 3) + 8 * j; const LAS float* s = scr + (8 * c) * 33 + n;
        u32x4 o; o.x = pk2(s[0 * 33], s[1 * 33]); o.y = pk2(s[2 * 33], s[3 * 33]); o.z = pk2(s[4 * 33], s[5 * 33]); o.w = pk2(s[6 * 33], s[7 * 33]);
        *(u32x4*)(WT + (size_t)(n0 + n) * K + k0 + 8 * c) = o; }
    asm volatile("s_waitcnt lgkmcnt(0)" ::: "memory");
}
DI int t5_bucket(int n) {
    if (n < 16) return n;
    int b = 16;
    b += (n >= 22); b += (n >= 30); b += (n >= 40); b += (n >= 54); b += (n >= 73); b += (n >= 99); b += (n >= 134); b += (n >= 182);
    b += (n >= 246); b += (n >= 332); b += (n >= 450); b += (n >= 609); b += (n >= 825); b += (n >= 1117); b += (n >= 1513);
    return b;
}
DI void phase_prologue(const Args& a, LAS unsigned char* lds, int tid, int lane, int wave, int bid, int G) {
    const float* x = a.in[0]; const float* rel_bias = a.in[1]; const float* g_pre = a.in[2]; const float* w_in = a.in[4];
    const float* wq = a.in[7]; const float* wk = a.in[8]; const float* wv = a.in[9]; const float* w_if = a.in[10]; const float* w_out = a.in[14];
    unsigned char* ws = a.ws;
    LAS float* scr = (LAS float*)(lds + wave * 16384);
    const int gw = bid * NWAVES + wave, NGW = G * NWAVES;
    constexpr int I_IN = (DM / 64) * (NIN / 32), I_OUT = (MIXW / 64) * (DM / 32);
    for (int it = gw; it < I_IN + I_OUT; it += NGW) {
        if (it < I_IN) p0_transpose_item(w_in, DM, NIN, (bf16*)(ws + WS_WINT), scr, it, lane);
        else p0_transpose_item(w_out, MIXW, DM, (bf16*)(ws + WS_WOUTT), scr, it - I_IN, lane);
    }
    {
        const f32x4* gr = (const f32x4*)g_pre + lane; f32x4 gg[4];
#pragma unroll
        for (int j = 0; j < 4; ++j) gg[j] = gr[64 * j];
        bf16* XN = (bf16*)(ws + WS_XN);
        for (int m = gw; m < MTOK; m += NGW) {
            const f32x4* xr = (const f32x4*)(x + (size_t)m * DM) + lane; f32x4 v[4]; float s = 0.f;
#pragma unroll
            for (int j = 0; j < 4; ++j) { v[j] = xr[64 * j]; s += (v[j].x * v[j].x + v[j].y * v[j].y) + (v[j].z * v[j].z + v[j].w * v[j].w); }
            const float rstd = frsq(wave_sum_dpp(s) * (1.0f / DM) + RMS_EPS);
            u32x2* o8 = (u32x2*)(XN + (size_t)m * DM) + lane;
#pragma unroll
            for (int j = 0; j < 4; ++j) { u32x2 o; o.x = pk2(v[j].x * rstd * gg[j].x, v[j].y * rstd * gg[j].y); o.y = pk2(v[j].z * rstd * gg[j].z, v[j].w * rstd * gg[j].w); o8[64 * j] = o; }
        }
    }
    const int gt = bid * NTHR + tid, NGT = G * NTHR;
    float* biasd = (float*)(ws + WS_BIASD);
    for (int idx = gt; idx < NH * 2048; idx += NGT) { const int h = idx >> 11, d = idx & 2047; biasd[idx] = rel_bias[t5_bucket(d) * NH + h] * LOG2E; }
    if (gt < NH) { float m = -1e30f; for (int b = 0; b < 32; ++b) m = fmaxf(m, rel_bias[b * NH + gt] * LOG2E); ((float*)(ws + WS_BMAX))[gt] = m; }
    float* weff = (float*)(ws + WS_WEFF);
    for (int idx = gt; idx < 2 * 1024 * 8; idx += NGT) {
        const int which = idx >> 13, c = (idx >> 3) & 1023, g = idx & 7, n = c >> 2, i = c & 3; float s = 0.f;
        if (which == 0) { for (int o = 0; o < 4; ++o) s += wq[n * 16 + i * 4 + o] * w_if[(4 * n + o) * 8 + g] + wk[n * 16 + i * 4 + o] * w_if[(1024 + 4 * n + o) * 8 + g]; }
        else { for (int o = 0; o < 4; ++o) s += wv[n * 16 + i * 4 + o] * w_if[(2048 + 4 * n + o) * 8 + g]; }
        weff[idx] = s;
    }
}

DI void phase_kstat(const Args& a, LAS unsigned char* lds, int tid, int lane, int wave, int bid, int G) {
    const bf16* QK = (const bf16*)(a.ws + WS_QK); float* KMEAN = (float*)(a.ws + WS_KMEAN); float* KMAX = (float*)(a.ws + WS_KMAX);
    LAS float* red = (LAS float*)lds; LAS float* wmx = (LAS float*)(lds + 32 * 128 * 4);
    for (int u = bid; u < 32 * NBLK; u += G) {
        const int bh = u >> 5, blk = u & 31, b = bh >> 3, h = bh & 7;
        const bf16* Kb = QK + (size_t)(b * SEQ + blk * 256) * 2048 + 1024 + h * DH;
        const int rg = tid >> 4, ch = tid & 15;
        float cs[8]; float mx = 0.f;
#pragma unroll
        for (int e = 0; e < 8; ++e) cs[e] = 0.f;
#pragma unroll
        for (int rr = 0; rr < 8; ++rr) {
            const u32x4 v = *(const u32x4*)(Kb + (size_t)(rg * 8 + rr) * 2048 + ch * 8);
            const float f0 = bflo(v.x), f1 = bfhi(v.x), f2 = bflo(v.y), f3 = bfhi(v.y), f4 = bflo(v.z), f5 = bfhi(v.z), f6 = bflo(v.w), f7 = bfhi(v.w);
            cs[0] += f0; cs[1] += f1; cs[2] += f2; cs[3] += f3; cs[4] += f4; cs[5] += f5; cs[6] += f6; cs[7] += f7;
            float ss = (f0 * f0 + f1 * f1) + (f2 * f2 + f3 * f3) + (f4 * f4 + f5 * f5) + (f6 * f6 + f7 * f7);
            ss += __shfl_xor(ss, 1); ss += __shfl_xor(ss, 2); ss += __shfl_xor(ss, 4); ss += __shfl_xor(ss, 8);
            mx = fmaxf(mx, ss);
        }
#pragma unroll
        for (int e = 0; e < 8; ++e) red[rg * 128 + ch * 8 + e] = cs[e];
        mx = wave_max(mx); if (lane == 0) wmx[wave] = mx;
        __syncthreads();
        if (tid < 128) { float s = 0.f; for (int r = 0; r < 32; ++r) s += red[r * 128 + tid]; KMEAN[(size_t)(bh * 32 + blk) * 128 + tid] = s * (1.0f / 256.0f); }
        if (tid == 0) { float m = wmx[0]; for (int w = 1; w < 8; ++w) m = fmaxf(m, wmx[w]); KMAX[bh * 32 + blk] = m; }
        __syncthreads();
    }
}

DI void sel_insert(float v, int j, float& v0, float& v1, float& v2, int& i0, int& i1, int& i2) {
    const bool b0 = (v > v0) || (v == v0 && j < i0), b1 = (v > v1) || (v == v1 && j < i1), b2 = (v > v2) || (v == v2 && j < i2);
    const float n2 = b1 ? v1 : (b2 ? v : v2); const int m2 = b1 ? i1 : (b2 ? j : i2);
    const float n1 = b0 ? v0 : (b1 ? v : v1); const int m1 = b0 ? i0 : (b1 ? j : i1);
    const float n0 = b0 ? v : v0;             const int m0 = b0 ? j : i0;
    v0 = n0; v1 = n1; v2 = n2; i0 = m0; i1 = m1; i2 = m2;
}
DI void phase_sel(const Args& a, LAS unsigned char* lds, int tid, int lane, int wave, int bid, int G, int dry) {
    const bf16* QK = (const bf16*)(a.ws + WS_QK); const float* KMEAN = (const float*)(a.ws + WS_KM2); const float* KMAX = (const float*)(a.ws + WS_KA2);
    const float* BMAX = (const float*)(a.ws + WS_BMAX);
    i32x4* SEL = (i32x4*)(a.ws + WS_SEL); unsigned* cnt = (unsigned*)(a.ws + WS_CTL) + CW_CNT + (dry ? 1024 : 0); unsigned* LIST = dry ? (unsigned*)a.out : (unsigned*)(a.ws + WS_LIST);
    LAS float* km = (LAS float*)lds;
    LAS float* kab = (LAS float*)(lds + 32 * 132 * 4);
    LAS int* lcnt = (LAS int*)(lds + 32 * 132 * 4 + 4096);
    const int r = lane & 31, hf = lane >> 5;
    for (int u = bid; u < 32 * NBLK; u += G) {
        const int bh = u >> 5, i = u & 31, b = bh >> 3, h = bh & 7;
        const int qpos = i * 256 + 32 * wave + r; const size_t row = (size_t)b * SEQ + qpos;
        bf16x8 qf[8];
#pragma unroll
        for (int ks = 0; ks < 8; ++ks) qf[ks] = *(const bf16x8*)(QK + row * 2048 + h * DH + ks * 16 + hf * 8);
        for (int idx = tid; idx < 32 * 128; idx += NTHR) { const int j = idx >> 7, d = idx & 127; float v = 0.f;
            if (j < i) v = KMEAN[(size_t)bh * 32 * 128 + idx] + KMEAN[(size_t)(32 + bh) * 32 * 128 + idx];
            km[j * 132 + d] = v; }
        { const int d = tid & 127, part = tid >> 7; float m = 0.f; float v[16];
#pragma unroll
          for (int k = 0; k < 16; ++k) { const int e = part * 16 + k; v[k] = KMAX[((size_t)(((e >> 5) * 32 + bh) * 32 + (e & 31))) * 128 + d]; }
#pragma unroll
          for (int k = 0; k < 16; ++k) m = fmaxf(m, v[k]);
          kab[part * 128 + d] = m; }
        if (tid < 32) lcnt[tid] = 0;
        __syncthreads();
        if (tid < 128) kab[512 + tid] = fmaxf(fmaxf(kab[tid], kab[128 + tid]), fmaxf(kab[256 + tid], kab[384 + tid]));
        f32x16 x;
#pragma unroll
        for (int k = 0; k < 16; ++k) x[k] = 0.f;
#pragma unroll
        for (int ks = 0; ks < 8; ++ks) {
            const f32x4 m0 = *(const LAS f32x4*)(km + r * 132 + ks * 16 + hf * 8), m1 = *(const LAS f32x4*)(km + r * 132 + ks * 16 + hf * 8 + 4);
            const unsigned h0 = pk2(m0.x, m0.y), h1 = pk2(m0.z, m0.w), h2 = pk2(m1.x, m1.y), h3 = pk2(m1.z, m1.w);
            const unsigned l0 = pk2(m0.x - bflo(h0), m0.y - bfhi(h0)), l1 = pk2(m0.z - bflo(h1), m0.w - bfhi(h1)), l2 = pk2(m1.x - bflo(h2), m1.y - bfhi(h2)), l3 = pk2(m1.z - bflo(h3), m1.w - bfhi(h3));
            u32x4 hi4; hi4.x = h0; hi4.y = h1; hi4.z = h2; hi4.w = h3; u32x4 lo4; lo4.x = l0; lo4.y = l1; lo4.z = l2; lo4.w = l3;
            x = MFMA32(__builtin_bit_cast(bf16x8, hi4), qf[ks], x); x = MFMA32(__builtin_bit_cast(bf16x8, lo4), qf[ks], x); }
        __syncthreads();
        float sb = 0.f;
#pragma unroll
        for (int ks = 0; ks < 8; ++ks) { const f32x4 k0 = *(const LAS f32x4*)(kab + 512 + ks * 16 + hf * 8), k1 = *(const LAS f32x4*)(kab + 512 + ks * 16 + hf * 8 + 4);
            const u32x4 qq = __builtin_bit_cast(u32x4, qf[ks]);
            sb += fabsf(bflo(qq.x)) * k0.x + fabsf(bfhi(qq.x)) * k0.y + fabsf(bflo(qq.y)) * k0.z + fabsf(bfhi(qq.y)) * k0.w + fabsf(bflo(qq.z)) * k1.x + fabsf(bfhi(qq.z)) * k1.y + fabsf(bflo(qq.w)) * k1.z + fabsf(bfhi(qq.w)) * k1.w; }
        sb += __shfl_xor(sb, 32);
        const float shift = sb + BMAX[h];
        float v0 = -INFINITY, v1 = -INFINITY, v2 = -INFINITY; int i0 = 64, i1 = 64, i2 = 64;
#pragma unroll
        for (int k = 0; k < 16; ++k) { const int j = crow(k, hf); const bool ok = j < i; sel_insert(ok ? x[k] : -INFINITY, ok ? j : 64, v0, v1, v2, i0, i1, i2); }
        { const float w0 = __shfl_xor(v0, 32), w1 = __shfl_xor(v1, 32), w2 = __shfl_xor(v2, 32); const int j0 = __shfl_xor(i0, 32), j1 = __shfl_xor(i1, 32), j2 = __shfl_xor(i2, 32);
          sel_insert(w0, j0, v0, v1, v2, i0, i1, i2); sel_insert(w1, j1, v0, v1, v2, i0, i1, i2); sel_insert(w2, j2, v0, v1, v2, i0, i1, i2); }
        if (i0 >= 64) i0 = -1; if (i1 >= 64) i1 = -1; if (i2 >= 64) i2 = -1;
        int p0 = 0, p1 = 0, p2 = 0;
        if (hf == 0) {
            i32x4 s4; s4.x = i0; s4.y = i1; s4.z = i2; s4.w = __float_as_int(shift);
            SEL[((size_t)(b * NH + h)) * SEQ + (size_t)qpos] = s4;
            if (i0 >= 0) p0 = __hip_atomic_fetch_add(lcnt + i0, 1, __ATOMIC_RELAXED, __HIP_MEMORY_SCOPE_WORKGROUP);
            if (i1 >= 0) p1 = __hip_atomic_fetch_add(lcnt + i1, 1, __ATOMIC_RELAXED, __HIP_MEMORY_SCOPE_WORKGROUP);
            if (i2 >= 0) p2 = __hip_atomic_fetch_add(lcnt + i2, 1, __ATOMIC_RELAXED, __HIP_MEMORY_SCOPE_WORKGROUP);
        }
        __syncthreads();
        if (tid < i) { const int c = lcnt[tid]; int base = 0; if (c > 0) base = (int)atomicAdd(&cnt[bh * 32 + tid], (unsigned)c); lcnt[tid] = base; }
        __syncthreads();
        if (hf == 0) {
            const unsigned qp = (unsigned)qpos;
            if (i0 >= 0) LIST[(size_t)bh * LISTSZ + list_off(i0) + lcnt[i0] + p0] = qp | (0u << 16);
            if (i1 >= 0) LIST[(size_t)bh * LISTSZ + list_off(i1) + lcnt[i1] + p1] = qp | (1u << 16);
            if (i2 >= 0) LIST[(size_t)bh * LISTSZ + list_off(i2) + lcnt[i2] + p2] = qp | (2u << 16);
        }
        __syncthreads();
    }
}

#ifndef PROBE_VAR
#define PROBE_VAR 0
#endif
constexpr int ATT_KIMG = 0, ATT_KROW = 272, ATT_VIMG = 69632, ATT_VROW = 320, ATT_BIASD = 151552, ATT_NBIAS = 1536, ATT_PREF = 157696, ATT_LST = 161792, ATT_MISC = 162816;
typedef short v4i16_t __attribute__((ext_vector_type(4)));
DI s16x4 lds_tr16(const LAS unsigned char* p) { return __builtin_bit_cast(s16x4, __builtin_amdgcn_ds_read_tr16_b64_v4i16((LAS v4i16_t*)p)); }
DI void att_fill_kv(LAS unsigned char* lds, const bf16* Kg, const bf16* Vg, int tid, int lane, int wave) {
    u32x4 kv[8], vv[8];
#pragma unroll
    for (int it = 0; it < 8; ++it) { const int p = it * NTHR + tid, key = p >> 4, ch = p & 15; kv[it] = *(const u32x4*)(Kg + (size_t)key * 2048 + ch * 8); }
#pragma unroll
    for (int it = 0; it < 8; ++it) { const int p = it * NTHR + tid, key = p >> 4, ch = p & 15; vv[it] = *(const u32x4*)(Vg + (size_t)key * 1024 + ch * 8); }
    __builtin_amdgcn_sched_barrier(0);
#pragma unroll
    for (int it = 0; it < 8; ++it) { const int p = it * NTHR + tid, key = p >> 4, ch = p & 15; *(LAS u32x4*)(lds + ATT_KIMG + key * ATT_KROW + ch * 16) = kv[it]; }
#pragma unroll
    for (int it = 0; it < 8; ++it) { const int p = it * NTHR + tid, key = p >> 4, ch = p & 15; *(LAS u32x4*)(lds + ATT_VIMG + key * ATT_VROW + ch * 16) = vv[it]; }
}
template <bool OWN>
DI void att_tile(LAS unsigned char* lds, const bf16x8 (&qf)[8], int qpos, float shift, int kbase, int kt_end, int wdiag, bool far, float b31,
                 f32x16 (&o)[4], float& lsum, int r, int hf) {
    const LAS float* biasd = (const LAS float*)(lds + ATT_BIASD);
    const int lane16 = (r & 15), grp = (r >> 4);
    const LAS unsigned char* kp = lds + ATT_KIMG + r * ATT_KROW + hf * 16;
    const LAS unsigned char* vp = lds + ATT_VIMG + (4 * hf + (lane16 >> 2)) * ATT_VROW + (16 * grp + 4 * (lane16 & 3)) * 2;
    bf16x8 ka[4];
#pragma unroll
    for (int ks = 0; ks < 4; ++ks) ka[ks] = *(const LAS bf16x8*)(kp + ks * 32);
    for (int kt = 0; kt < kt_end; ++kt) {
        const LAS unsigned char* kc = kp + kt * (32 * ATT_KROW);
        bf16x8 kb[4];
#pragma unroll
        for (int ks = 0; ks < 4; ++ks) kb[ks] = *(const LAS bf16x8*)(kc + (4 + ks) * 32);
        float bv[16];
        if (!far) {
#pragma unroll
            for (int i = 0; i < 16; ++i) { const int key = 32 * kt + crow(i, hf); int dist = qpos - (kbase + key); dist = dist < 0 ? 0 : (dist > ATT_NBIAS - 1 ? ATT_NBIAS - 1 : dist); bv[i] = biasd[dist]; }
        } else {
#pragma unroll
            for (int i = 0; i < 16; ++i) bv[i] = b31;
        }
        __builtin_amdgcn_sched_barrier(0);
        f32x16 x;
#pragma unroll
        for (int i = 0; i < 16; ++i) x[i] = 0.f;
#pragma unroll
        for (int ks = 0; ks < 4; ++ks) x = MFMA32(ka[ks], qf[ks], x);
#pragma unroll
        for (int ks = 0; ks < 4; ++ks) x = MFMA32(kb[ks], qf[4 + ks], x);
        __builtin_amdgcn_sched_barrier(0);
        const LAS unsigned char* vb = vp + kt * (32 * ATT_VROW);
        s16x4 vl[2][4];
#pragma unroll
        for (int dt = 0; dt < 2; ++dt) { vl[dt][0] = lds_tr16(vb + dt * 64); vl[dt][1] = lds_tr16(vb + dt * 64 + 8 * ATT_VROW); vl[dt][2] = lds_tr16(vb + dt * 64 + 16 * ATT_VROW); vl[dt][3] = lds_tr16(vb + dt * 64 + 24 * ATT_VROW); }
        __builtin_amdgcn_sched_barrier(0);
#pragma unroll
        for (int i = 0; i < 16; ++i) { float p = __builtin_amdgcn_exp2f(x[i] + (bv[i] - shift));
            if (OWN) { if (kt == wdiag && crow(i, hf) > r) p = 0.f; }
            lsum += p; x[i] = p; }
        const bf16x8 pa0 = pack_lo(x), pa1 = pack_hi(x);
        __builtin_amdgcn_sched_barrier(0);
        s16x4 vh[2][4];
#pragma unroll
        for (int dt = 0; dt < 2; ++dt) { vh[dt][0] = lds_tr16(vb + (2 + dt) * 64); vh[dt][1] = lds_tr16(vb + (2 + dt) * 64 + 8 * ATT_VROW); vh[dt][2] = lds_tr16(vb + (2 + dt) * 64 + 16 * ATT_VROW); vh[dt][3] = lds_tr16(vb + (2 + dt) * 64 + 24 * ATT_VROW); }
#pragma unroll
        for (int dt = 0; dt < 2; ++dt) {
            o[dt] = MFMA32(__builtin_shufflevector(vl[dt][0], vl[dt][1], 0, 1, 2, 3, 4, 5, 6, 7), pa0, o[dt]);
            o[dt] = MFMA32(__builtin_shufflevector(vl[dt][2], vl[dt][3], 0, 1, 2, 3, 4, 5, 6, 7), pa1, o[dt]); }
        __builtin_amdgcn_sched_barrier(0);
        if (kt + 1 < kt_end) {
#pragma unroll
            for (int ks = 0; ks < 4; ++ks) ka[ks] = *(const LAS bf16x8*)(kc + 32 * ATT_KROW + ks * 32); }
#pragma unroll
        for (int dt = 0; dt < 2; ++dt) {
            o[2 + dt] = MFMA32(__builtin_shufflevector(vh[dt][0], vh[dt][1], 0, 1, 2, 3, 4, 5, 6, 7), pa0, o[2 + dt]);
            o[2 + dt] = MFMA32(__builtin_shufflevector(vh[dt][2], vh[dt][3], 0, 1, 2, 3, 4, 5, 6, 7), pa1, o[2 + dt]); }
    }
}
DI void att_load_biasd(const Args& a, LAS unsigned char* lds, int h, int tid) {
    const float* biasd = (const float*)(a.ws + WS_BIASD) + h * 2048; LAS float* dst = (LAS float*)(lds + ATT_BIASD);
    for (int i = tid; i < ATT_NBIAS; i += NTHR) dst[i] = biasd[i];
}
DI size_t hmrow(int b, int h, int s) { return ((size_t)(b * NH + h)) * SEQ + (size_t)s; }
DI bf16* opart_base(const Args& a, int slot) { return slot == 0 ? (bf16*)a.out : (slot == 1 ? (bf16*)((unsigned char*)a.out + 64 * MiB) : (bf16*)(a.ws + WS_XN)); }

constexpr int ATT_RU = 512, ATT_NT = ATT_RU / 256;
DI void att_swap(unsigned& a, unsigned& b) { const auto r = __builtin_amdgcn_permlane32_swap(a, b, false, false); a = r[0]; b = r[1]; }
DI void att_g_load(const Args& a, const unsigned* lp, int nv, int b, int h, int r, int hf, unsigned& ent, float& shift, bf16x8 (&qf)[8]) {
    const bf16* QK = (const bf16*)(a.ws + WS_QK); const i32x4* SEL = (const i32x4*)(a.ws + WS_SEL);
    ent = lp[r < nv ? r : 0];
    const int qpos = (int)(ent & 0xffffu); const size_t row = (size_t)b * SEQ + qpos;
    shift = __int_as_float(SEL[hmrow(b, h, qpos)].w);
#pragma unroll
    for (int ks = 0; ks < 8; ++ks) qf[ks] = *(const bf16x8*)(QK + row * 2048 + h * DH + ks * 16 + hf * 8);
}
DI void att_g_tile(const Args& a, LAS unsigned char* lds, int nv, int b, int h, int j, int r, int hf, unsigned ent, float shift, const bf16x8 (&qf)[8], int mode) {
    float* LPART = (float*)(a.ws + WS_LPART);
    f32x16 o[4]; float lsum = 0.f;
#pragma unroll
    for (int dt = 0; dt < 4; ++dt)
#pragma unroll
        for (int i = 0; i < 16; ++i) o[dt][i] = 0.f;
    const int qpos = (int)(ent & 0xffffu), slot = (int)(ent >> 16);
    const bool far = __all(qpos - (j * 256 + 255) >= 1513);
    const float b31 = *(const LAS float*)(lds + ATT_BIASD + (ATT_NBIAS - 1) * 4);
    if (mode != 3) att_tile<false>(lds, qf, qpos, shift, j * 256, 8, -1, far, b31, o, lsum, r, hf);
    lsum += __shfl_xor(lsum, 32);
    if (mode == 4) { asm volatile("" :: "v"(o[0]), "v"(o[1]), "v"(o[2]), "v"(o[3]), "v"(lsum)); return; }
    bf16* dst = opart_base(a, slot) + hmrow(b, h, qpos) * 128;
#pragma unroll
    for (int dt = 0; dt < 4; ++dt)
#pragma unroll
        for (int gg = 0; gg < 2; ++gg) {
            unsigned ax = pk2(o[dt][8 * gg + 0], o[dt][8 * gg + 1]), ay = pk2(o[dt][8 * gg + 2], o[dt][8 * gg + 3]), bx = pk2(o[dt][8 * gg + 4], o[dt][8 * gg + 5]), by = pk2(o[dt][8 * gg + 6], o[dt][8 * gg + 7]);
            att_swap(ax, bx); att_swap(ay, by);
            u32x4 v; v.x = ax; v.y = ay; v.z = bx; v.w = by;
            if (r < nv) *(u32x4*)(dst + (4 * dt + 2 * gg + hf) * 8) = v; }
    if (hf == 0 && r < nv) LPART[(size_t)slot * MTOK * 8 + hmrow(b, h, qpos)] = lsum;
}
DI void phase_att_gather(const Args& a, LAS unsigned char* lds, int tid, int lane, int wave, int bid, int G, int dry) {
    const bf16* QK = (const bf16*)(a.ws + WS_QK); const bf16* Vb = (const bf16*)(a.ws + WS_V);
    const unsigned* cnt = (const unsigned*)(a.ws + WS_CTL) + CW_CNT; const unsigned* LIST = (const unsigned*)(a.ws + WS_LIST);
    LAS int* pref = (LAS int*)(lds + ATT_PREF);
    if (tid < 64) {
        int nu[16]; int s = 0;
#pragma unroll
        for (int k = 0; k < 16; ++k) { const int l = tid * 16 + k; int n = 0; if (l < 992) { const int bh = l / 31, j = l % 31; n = (int)((cnt[bh * 32 + j] + (unsigned)(ATT_RU - 1)) / (unsigned)ATT_RU); } nu[k] = n; s += n; }
        int incl = s;
#pragma unroll
        for (int o = 1; o < 64; o <<= 1) { const int t = __shfl_up(incl, o); if (lane >= o) incl += t; }
        int run = incl - s;
#pragma unroll
        for (int k = 0; k < 16; ++k) { const int l = tid * 16 + k; if (l <= 992) pref[l] = run; run += nu[k]; }
    }
    __syncthreads();
    const int U = pref[992];
    const int r = lane & 31, hf = lane >> 5;
    int cur_h = -1;
    for (int u = bid; u < U; u += G) {
        int lo = 0, hi = 992;
        while (hi - lo > 1) { const int mid = (lo + hi) >> 1; if (pref[mid] <= u) lo = mid; else hi = mid; }
        const int l = lo, bh = l / 31, j = l % 31, chunk = u - pref[l], b = bh >> 3, h = bh & 7;
        const int n = (int)cnt[bh * 32 + j]; const int nrows = min(ATT_RU, n - chunk * ATT_RU);
        const unsigned* lp = LIST + (size_t)bh * LISTSZ + list_off(j) + chunk * ATT_RU;
        const int nv0 = min(32, max(0, nrows - 32 * wave)), nv1 = min(32, max(0, nrows - 32 * (8 + wave)));
        unsigned entA = 0; float shA = 0.f; bf16x8 qfA[8];
        const bool skipall = (PROBE_VAR == 5 && dry);
        if (nv0 > 0 && !skipall) att_g_load(a, lp + 32 * wave, nv0, b, h, r, hf, entA, shA, qfA);
        if (h != cur_h) { att_load_biasd(a, lds, h, tid); cur_h = h; }
        att_fill_kv(lds, QK + (size_t)(b * SEQ + j * 256) * 2048 + 1024 + h * DH, Vb + (size_t)(b * SEQ + j * 256) * 1024 + h * DH, tid, lane, wave);
        __syncthreads();
        if (nv0 > 0 && !skipall) {
            att_g_tile(a, lds, nv0, b, h, j, r, hf, entA, shA, qfA, dry ? PROBE_VAR : 0);
            if (nv1 > 0) { att_g_load(a, lp + 32 * (8 + wave), nv1, b, h, r, hf, entA, shA, qfA); att_g_tile(a, lds, nv1, b, h, j, r, hf, entA, shA, qfA, dry ? PROBE_VAR : 0); }
        }
        __syncthreads();
    }
}

DI void phase_att_own(const Args& a, LAS unsigned char* lds, int tid, int lane, int wave, int bid, int G, int dry) {
    bf16* QK = (bf16*)(a.ws + WS_QK); const bf16* Vb = (const bf16*)(a.ws + WS_V); const bf16* Gb = (const bf16*)(a.ws + WS_G);
    const i32x4* SEL = (const i32x4*)(a.ws + WS_SEL); const float* LPART = (const float*)(a.ws + WS_LPART);
    int cur_h = -1;
    for (int u = bid; u < 32 * NBLK; u += G) {
        const int bh = u >> 5, i = u & 31, b = bh >> 3, h = bh & 7;
        const int r0 = lane & 31, hf0 = lane >> 5; const int qpos0 = i * 256 + 32 * wave + r0; const size_t row0 = (size_t)b * SEQ + qpos0;
        const float shift = __int_as_float(SEL[hmrow(b, h, qpos0)].w);
        bf16x8 qf[8];
#pragma unroll
        for (int ks = 0; ks < 8; ++ks) qf[ks] = *(const bf16x8*)(QK + row0 * 2048 + h * DH + ks * 16 + hf0 * 8);
        if (h != cur_h) { att_load_biasd(a, lds, h, tid); cur_h = h; }
        att_fill_kv(lds, QK + (size_t)(b * SEQ + i * 256) * 2048 + 1024 + h * DH, Vb + (size_t)(b * SEQ + i * 256) * 1024 + h * DH, tid, lane, wave);
        __syncthreads();
        f32x16 o[4]; float lsum = 0.f;
#pragma unroll
        for (int dt = 0; dt < 4; ++dt)
#pragma unroll
            for (int k = 0; k < 16; ++k) o[dt][k] = 0.f;
        if (!(PROBE_VAR == 2 && dry)) att_tile<true>(lds, qf, qpos0, shift, i * 256, wave + 1, wave, false, 0.f, o, lsum, r0, hf0);
        lsum += __shfl_xor(lsum, 32);
        int l2_ = lane; asm volatile("" : "+v"(l2_));
        const int r = l2_ & 31, hf = l2_ >> 5; const int qpos = i * 256 + 32 * wave + r; const size_t row = (size_t)b * SEQ + qpos;
        const i32x4 s4 = SEL[hmrow(b, h, qpos)];
        if (PROBE_VAR == 1 && dry) { asm volatile("" :: "v"(o[0]), "v"(o[1]), "v"(o[2]), "v"(o[3]), "v"(lsum)); __syncthreads(); continue; }
        float l = lsum;
        const unsigned mk0 = s4.x >= 0 ? 0xffffffffu : 0u, mk1 = s4.y >= 0 ? 0xffffffffu : 0u, mk2 = s4.z >= 0 ? 0xffffffffu : 0u;
#pragma unroll
        for (int k = 0; k < 3; ++k) { const unsigned mk = (k == 0) ? mk0 : (k == 1 ? mk1 : mk2); const float lp = LPART[(size_t)k * MTOK * 8 + hmrow(b, h, qpos)]; l += __uint_as_float(__float_as_uint(lp) & mk); }
        const float rl = frcp(l);
#pragma unroll
        for (int dt = 0; dt < 4; ++dt) {
            u32x4 pv[2][3], gv[2];
#pragma unroll
            for (int gg = 0; gg < 2; ++gg) { const int c = 4 * dt + 2 * gg + hf;
                gv[gg] = *(const u32x4*)(Gb + row * 1024 + h * DH + c * 8);
#pragma unroll
                for (int k = 0; k < 3; ++k) pv[gg][k] = *(const u32x4*)(opart_base(a, k) + hmrow(b, h, qpos) * 128 + c * 8); }
#pragma unroll
            for (int gg = 0; gg < 2; ++gg) { const int c = 4 * dt + 2 * gg + hf;
                unsigned w[8];
#pragma unroll
                for (int k = 0; k < 8; ++k) w[k] = __float_as_uint(o[dt][8 * gg + k]);
#pragma unroll
                for (int k = 0; k < 4; ++k) att_swap(w[k], w[4 + k]);
                float acc[8];
#pragma unroll
                for (int k = 0; k < 8; ++k) acc[k] = __uint_as_float(w[k]);
#pragma unroll
                for (int k = 0; k < 3; ++k) { const unsigned mk = (k == 0) ? mk0 : (k == 1 ? mk1 : mk2); u32x4 p = pv[gg][k]; p.x &= mk; p.y &= mk; p.z &= mk; p.w &= mk;
                    acc[0] += bflo(p.x); acc[1] += bfhi(p.x); acc[2] += bflo(p.y); acc[3] += bfhi(p.y); acc[4] += bflo(p.z); acc[5] += bfhi(p.z); acc[6] += bflo(p.w); acc[7] += bfhi(p.w); }
                const u32x4 g4 = gv[gg];
                u32x4 ov; ov.x = pk2(acc[0] * rl * silu_f(bflo(g4.x)), acc[1] * rl * silu_f(bfhi(g4.x))); ov.y = pk2(acc[2] * rl * silu_f(bflo(g4.y)), acc[3] * rl * silu_f(bfhi(g4.y)));
                ov.z = pk2(acc[4] * rl * silu_f(bflo(g4.z)), acc[5] * rl * silu_f(bfhi(g4.z))); ov.w = pk2(acc[6] * rl * silu_f(bflo(g4.w)), acc[7] * rl * silu_f(bfhi(g4.w)));
                if (!dry) *(u32x4*)(QK + row * 2048 + h * DH + c * 8) = ov; else asm volatile("" :: "v"(ov)); }
        }
        __syncthreads();
    }
}

DI void phase_mgate(const Args& a, LAS unsigned char* lds, int tid, int lane, int wave, int bid, int G) {
    const float* conv_w = a.in[5]; const float* conv_b = a.in[6]; const float* b_if = a.in[11];
    const float* weff = (const float*)(a.ws + WS_WEFF);
    const bf16* XM = (const bf16*)(a.ws + WS_XM);
    float* GLI = (float*)(a.ws + WS_GLI); float* GLF = (float*)(a.ws + WS_GLF);
    LAS float* red = (LAS float*)lds;
    const int tk = tid >> 8, n = tid & 255;
    float cw[4][4], cb[4], wc[4][8], wm[4][8];
#pragma unroll
    for (int w = 0; w < 4; ++w) { const f32x4 t = *(const f32x4*)(conv_w + w * 1024 + 4 * n); cw[w][0] = t.x; cw[w][1] = t.y; cw[w][2] = t.z; cw[w][3] = t.w; }
    { const f32x4 t = *(const f32x4*)(conv_b + 4 * n); cb[0] = t.x; cb[1] = t.y; cb[2] = t.z; cb[3] = t.w; }
#pragma unroll
    for (int i = 0; i < 4; ++i)
#pragma unroll
        for (int g = 0; g < 8; ++g) { wc[i][g] = weff[(4 * n + i) * 8 + g]; wm[i][g] = weff[8192 + (4 * n + i) * 8 + g]; }
    for (int blk = bid; blk < MTOK / 16; blk += G) {
        const int mb = 16 * blk + 8 * tk, s0 = mb & (SEQ - 1);
        u32x2 win[11];
#pragma unroll
        for (int j = 0; j < 11; ++j) { u32x2 v = *(const u32x2*)(XM + (ptrdiff_t)(mb - 3 + j) * 1024 + 4 * n); const unsigned mk = (s0 - 3 + j >= 0) ? 0xffffffffu : 0u; v.x &= mk; v.y &= mk; win[j] = v; }
#pragma unroll
        for (int k = 0; k < 8; ++k) {
            float xc[4], xm[4];
            xm[0] = bflo(win[k + 3].x); xm[1] = bfhi(win[k + 3].x); xm[2] = bflo(win[k + 3].y); xm[3] = bfhi(win[k + 3].y);
            { float y0 = cb[0], y1 = cb[1], y2 = cb[2], y3 = cb[3];
#pragma unroll
              for (int w = 0; w < 4; ++w) { y0 += bflo(win[k + w].x) * cw[w][0]; y1 += bfhi(win[k + w].x) * cw[w][1]; y2 += bflo(win[k + w].y) * cw[w][2]; y3 += bfhi(win[k + w].y) * cw[w][3]; }
              xc[0] = silu_f(y0); xc[1] = silu_f(y1); xc[2] = silu_f(y2); xc[3] = silu_f(y3); }
#pragma unroll
            for (int g = 0; g < 8; ++g) { float sg = 0.f;
#pragma unroll
                for (int i = 0; i < 4; ++i) sg += xc[i] * wc[i][g] + xm[i] * wm[i][g];
                red[((8 * tk + k) * 8 + g) * 256 + n] = sg; }
        }
        __syncthreads();
        { const int row = tid >> 2, qd = tid & 3; float s = 0.f;
#pragma unroll
          for (int k = 0; k < 16; ++k) { const f32x4 v = *(const LAS f32x4*)(red + row * 256 + qd * 64 + k * 4); s += (v.x + v.y) + (v.z + v.w); }
          s += __shfl_xor(s, 1); s += __shfl_xor(s, 2);
          if (qd == 0) { const int tok = row >> 3, g = row & 7; const int m2 = 16 * blk + tok, s2 = m2 & (SEQ - 1), b2 = m2 >> 13; const float gate = s + b_if[g];
              if (g < 4) GLI[(size_t)(b2 * 4 + g) * SEQ + s2] = gate;
              else GLF[(size_t)(b2 * 4 + g - 4) * SEQ + s2] = fminf(gate, 0.f) - log1pf(__expf(-fabsf(gate))); } }
        __syncthreads();
    }
}

constexpr int MC_QI = 0, MC_QROW = 528, MC_KI = 33792, MC_KT = 67584, MC_TROW = 144, MC_VT = 104448, MC_P = 141312, MC_SC = 150528, MC_NV = 153600, MC_MISC = 154624;
constexpr int MC_STROW = 1040;
DI LAS float* mc_sc(LAS unsigned char* lds, int k) { return (LAS float*)(lds + MC_SC + k * 256); }

template <bool FULL>
DI void mfill(const Args& a, LAS unsigned char* lds, size_t rowbase, int spos0, int hd, int tk, int n64, u32x2 (&xcp)[8]) {
    const float* conv_w = a.in[5]; const float* conv_b = a.in[6]; const float* wq = a.in[7]; const float* wk = a.in[8]; const float* wv = a.in[9];
    const bf16* XM = (const bf16*)(a.ws + WS_XM);
    const int ch = hd * MD + 4 * n64, ng = hd * 64 + n64;
    const bf16* xp = XM + (rowbase + 8 * tk) * 1024 + ch;
    u32x2 win[11];
#pragma unroll
    for (int j = 0; j < 11; ++j) { u32x2 v = *(const u32x2*)(xp + (ptrdiff_t)(j - 3) * 1024); const unsigned mk = (spos0 + 8 * tk - 3 + j >= 0) ? 0xffffffffu : 0u; v.x &= mk; v.y &= mk; win[j] = v; }
    __builtin_amdgcn_sched_barrier(0);
    { float fw[16];
#pragma unroll
      for (int q4 = 0; q4 < 4; ++q4) { const f32x4 t = *(const f32x4*)(wv + ng * 16 + q4 * 4); fw[q4 * 4 + 0] = t.x; fw[q4 * 4 + 1] = t.y; fw[q4 * 4 + 2] = t.z; fw[q4 * 4 + 3] = t.w; }
      unsigned tw[4][4]; float prev[4];
#pragma unroll
      for (int k = 0; k < 8; ++k) { float o[4]; const float x0 = bflo(win[k + 3].x), x1 = bfhi(win[k + 3].x), x2 = bflo(win[k + 3].y), x3 = bfhi(win[k + 3].y);
#pragma unroll
          for (int oo = 0; oo < 4; ++oo) o[oo] = x0 * fw[oo] + x1 * fw[4 + oo] + x2 * fw[8 + oo] + x3 * fw[12 + oo];
          if ((k & 1) == 0) { prev[0] = o[0]; prev[1] = o[1]; prev[2] = o[2]; prev[3] = o[3]; }
          else { tw[0][k >> 1] = pk2(prev[0], o[0]); tw[1][k >> 1] = pk2(prev[1], o[1]); tw[2][k >> 1] = pk2(prev[2], o[2]); tw[3][k >> 1] = pk2(prev[3], o[3]); } }
#pragma unroll
      for (int oo = 0; oo < 4; ++oo) { u32x4 w4; w4.x = tw[oo][0]; w4.y = tw[oo][1]; w4.z = tw[oo][2]; w4.w = tw[oo][3]; *(LAS u32x4*)(lds + MC_VT + (4 * n64 + oo) * MC_TROW + 16 * tk) = w4; } }
    { float cw[4][4], cb[4];
#pragma unroll
      for (int w = 0; w < 4; ++w) { const f32x4 t = *(const f32x4*)(conv_w + w * 1024 + ch); cw[w][0] = t.x; cw[w][1] = t.y; cw[w][2] = t.z; cw[w][3] = t.w; }
      { const f32x4 t = *(const f32x4*)(conv_b + ch); cb[0] = t.x; cb[1] = t.y; cb[2] = t.z; cb[3] = t.w; }
#pragma unroll
      for (int k = 0; k < 8; ++k) { float y0 = cb[0], y1 = cb[1], y2 = cb[2], y3 = cb[3];
#pragma unroll
          for (int w = 0; w < 4; ++w) { y0 += bflo(win[k + w].x) * cw[w][0]; y1 += bfhi(win[k + w].x) * cw[w][1]; y2 += bflo(win[k + w].y) * cw[w][2]; y3 += bfhi(win[k + w].y) * cw[w][3]; }
          u32x2 p; p.x = pk2(silu_f(y0), silu_f(y1)); p.y = pk2(silu_f(y2), silu_f(y3)); xcp[k] = p; } }
    asm volatile("" : "+v"(xcp[0]), "+v"(xcp[1]), "+v"(xcp[2]), "+v"(xcp[3]), "+v"(xcp[4]), "+v"(xcp[5]), "+v"(xcp[6]), "+v"(xcp[7]));
    { float fw[16];
#pragma unroll
      for (int q4 = 0; q4 < 4; ++q4) { const f32x4 t = *(const f32x4*)(wk + ng * 16 + q4 * 4); fw[q4 * 4 + 0] = t.x * 0.0625f; fw[q4 * 4 + 1] = t.y * 0.0625f; fw[q4 * 4 + 2] = t.z * 0.0625f; fw[q4 * 4 + 3] = t.w * 0.0625f; }
      unsigned tw[4][4]; float prev[4];
#pragma unroll
      for (int k = 0; k < 8; ++k) { float o[4]; const float x0 = bflo(xcp[k].x), x1 = bfhi(xcp[k].x), x2 = bflo(xcp[k].y), x3 = bfhi(xcp[k].y);
#pragma unroll
          for (int oo = 0; oo < 4; ++oo) o[oo] = x0 * fw[oo] + x1 * fw[4 + oo] + x2 * fw[8 + oo] + x3 * fw[12 + oo];
          if (FULL) { u32x2 p; p.x = pk2(o[0], o[1]); p.y = pk2(o[2], o[3]); *(LAS u32x2*)(lds + MC_KI + (8 * tk + k) * MC_QROW + 8 * n64) = p; }
          if ((k & 1) == 0) { prev[0] = o[0]; prev[1] = o[1]; prev[2] = o[2]; prev[3] = o[3]; }
          else { tw[0][k >> 1] = pk2(prev[0], o[0]); tw[1][k >> 1] = pk2(prev[1], o[1]); tw[2][k >> 1] = pk2(prev[2], o[2]); tw[3][k >> 1] = pk2(prev[3], o[3]); } }
#pragma unroll
      for (int oo = 0; oo < 4; ++oo) { u32x4 w4; w4.x = tw[oo][0]; w4.y = tw[oo][1]; w4.z = tw[oo][2]; w4.w = tw[oo][3]; *(LAS u32x4*)(lds + MC_KT + (4 * n64 + oo) * MC_TROW + 16 * tk) = w4; } }
    if (FULL) { float fw[16];
#pragma unroll
      for (int q4 = 0; q4 < 4; ++q4) { const f32x4 t = *(const f32x4*)(wq + ng * 16 + q4 * 4); fw[q4 * 4 + 0] = t.x; fw[q4 * 4 + 1] = t.y; fw[q4 * 4 + 2] = t.z; fw[q4 * 4 + 3] = t.w; }
#pragma unroll
      for (int k = 0; k < 8; ++k) { float o[4]; const float x0 = bflo(xcp[k].x), x1 = bfhi(xcp[k].x), x2 = bflo(xcp[k].y), x3 = bfhi(xcp[k].y);
#pragma unroll
          for (int oo = 0; oo < 4; ++oo) o[oo] = x0 * fw[oo] + x1 * fw[4 + oo] + x2 * fw[8 + oo] + x3 * fw[12 + oo];
          u32x2 p; p.x = pk2(o[0], o[1]); p.y = pk2(o[2], o[3]); *(LAS u32x2*)(lds + MC_QI + (8 * tk + k) * MC_QROW + 8 * n64) = p; } }
}

DI void phase_mstate(const Args& a, LAS unsigned char* lds, int tid, int lane0, int wave, int bid, int G) {
    const float* GLI = (const float*)(a.ws + WS_GLI); const float* GLF = (const float*)(a.ws + WS_GLF);
    float* CST = (float*)(a.ws + WS_CST); float* NST = (float*)(a.ws + WS_NST); float* PST = (float*)(a.ws + WS_PST); float* MIN = (float*)(a.ws + WS_MIN);
    LAS float* nvec = (LAS float*)(lds + MC_NV); LAS float* misc = (LAS float*)(lds + MC_MISC);
    LAS float* aggb = (LAS float*)(lds + MC_QI); LAS float* agga = aggb + 128; LAS float* marr = aggb + 256;
#define OPQ(name) int name = tid; asm volatile("" : "+v"(name))
    for (int u = bid; u < BATCH * MH * NSC; u += G) {
        const int bh = u >> 4, sc = u & 15, b = bh >> 2, hd = bh & 3; const int c0 = sc * SCCH, c1 = c0 + SCCH;
        { OPQ(tA); const int laneA = tA & 63;
            for (int c = wave; c < c1; c += NWAVES) {
                const float lf = GLF[(size_t)bh * SEQ + c * LCH + laneA], li = GLI[(size_t)bh * SEQ + c * LCH + laneA];
                float bc = lf;
#pragma unroll
                for (int o = 1; o < 64; o <<= 1) { const float t = __shfl_up(bc, o); if (laneA >= o) bc += t; }
                const float am = wave_max(li - bc); const float bL = __shfl(bc, 63);
                if (laneA == 0) { aggb[c] = bL; agga[c] = am; }
            }
        }
        __syncthreads();
        if (tid == 0) { float m = 0.f; for (int c = 0; c < c1; ++c) { marr[c] = m; m = aggb[c] + fmaxf(m, agga[c]); } }
        __syncthreads();
        if (tid < SCCH) MIN[bh * NCH + c0 + tid] = marr[c0 + tid];
        f32x16 C[8];
#pragma unroll
        for (int dt = 0; dt < 8; ++dt)
#pragma unroll
            for (int i = 0; i < 16; ++i) C[dt][i] = 0.f;
        if (tid < 256) nvec[tid] = 0.f;
        float pprod = 1.f;
        for (int c = c0; c < c1; ++c) {
            const size_t rowbase = (size_t)b * SEQ + (size_t)c * LCH;
            { OPQ(tB); const int laneB = tB & 63;
            { u32x2 dummy[8]; mfill<false>(a, lds, rowbase, c * LCH, hd, wave, laneB, dummy); }
            if (wave == 0) {
                const float lf = GLF[(size_t)bh * SEQ + c * LCH + laneB], li = GLI[(size_t)bh * SEQ + c * LCH + laneB];
                float bc = lf;
#pragma unroll
                for (int o = 1; o < 64; o <<= 1) { const float t = __shfl_up(bc, o); if (laneB >= o) bc += t; }
                const float av = li - bc; const float mi = marr[c]; const float Gc = fmaxf(mi, wave_max(av));
                mc_sc(lds, 3)[laneB] = __expf(av - Gc);
                if (laneB == 0) misc[0] = __expf(mi - Gc);
            } }
            __syncthreads();
            const float cd = misc[0]; pprod *= cd;
            { OPQ(tC); const int laneC = tC & 63, r = laneC & 31, hf = laneC >> 5;
            bf16x8 vt[4];
            const LAS unsigned char* vbase = lds + MC_VT + (32 * wave + r) * MC_TROW + hf * 16;
#pragma unroll
            for (int ks = 0; ks < 4; ++ks) { vt[ks] = *(const LAS bf16x8*)(vbase + ks * 32);
                const f32x4 w0 = *(const LAS f32x4*)(mc_sc(lds, 3) + 16 * ks + 8 * hf), w1 = *(const LAS f32x4*)(mc_sc(lds, 3) + 16 * ks + 8 * hf + 4);
                const u32x4 vv = __builtin_bit_cast(u32x4, vt[ks]); u32x4 o;
                o.x = pk2(bflo(vv.x) * w0.x, bfhi(vv.x) * w0.y); o.y = pk2(bflo(vv.y) * w0.z, bfhi(vv.y) * w0.w); o.z = pk2(bflo(vv.z) * w1.x, bfhi(vv.z) * w1.y); o.w = pk2(bflo(vv.w) * w1.z, bfhi(vv.w) * w1.w);
                vt[ks] = __builtin_bit_cast(bf16x8, o); }
            const LAS unsigned char* kbase = lds + MC_KT + r * MC_TROW + hf * 16;
            { bf16x8 kq[4];
#pragma unroll
              for (int ks = 0; ks < 4; ++ks) kq[ks] = *(const LAS bf16x8*)(kbase + ks * 32);
#pragma unroll
              for (int dt = 0; dt < 8; ++dt) {
                  bf16x8 kn[4];
                  if (dt < 7) {
#pragma unroll
                      for (int ks = 0; ks < 4; ++ks) kn[ks] = *(const LAS bf16x8*)(kbase + (dt + 1) * 32 * MC_TROW + ks * 32); }
#pragma unroll
                  for (int i = 0; i < 16; ++i) C[dt][i] *= cd;
                  __builtin_amdgcn_sched_barrier(0);
#pragma unroll
                  for (int ks = 0; ks < 4; ++ks) C[dt] = MFMA32(kq[ks], vt[ks], C[dt]);
                  if (dt < 7) { kq[0] = kn[0]; kq[1] = kn[1]; kq[2] = kn[2]; kq[3] = kn[3]; } } }
            if (tC < 256) { float sacc = cd * nvec[tC];
#pragma unroll
                for (int k = 0; k < 8; ++k) { const u32x4 kv = *(const LAS u32x4*)(lds + MC_KT + tC * MC_TROW + k * 16);
                    const f32x4 w0 = *(const LAS f32x4*)(mc_sc(lds, 3) + k * 8), w1 = *(const LAS f32x4*)(mc_sc(lds, 3) + k * 8 + 4);
                    sacc += bflo(kv.x) * w0.x + bfhi(kv.x) * w0.y + bflo(kv.y) * w0.z + bfhi(kv.y) * w0.w + bflo(kv.z) * w1.x + bfhi(kv.z) * w1.y + bflo(kv.w) * w1.z + bfhi(kv.w) * w1.w; }
                nvec[tC] = sacc; }
            }
            __syncthreads();
        }
        { OPQ(tD); const int laneD = tD & 63, r = laneD & 31, hf = laneD >> 5;
            float* cs = CST + (size_t)u * 65536 + 32 * wave + r;
#pragma unroll
            for (int dt = 0; dt < 8; ++dt)
#pragma unroll
                for (int i = 0; i < 16; ++i) cs[(32 * dt + crow(i, hf)) * 256] = C[dt][i];
            if (tD < 256) NST[u * 256 + tD] = nvec[tD];
            if (tD == 0) PST[u] = pprod;
        }
        __syncthreads();
    }
#undef OPQ
}
DI void phase_mcomb(const Args& a, int tid, int bid, int G, int dry) {
    float* CST = (float*)(a.ws + WS_CST); float* NST = (float*)(a.ws + WS_NST); const float* PST = (const float*)(a.ws + WS_PST);
    const int gt = bid * NTHR + tid, NGT = G * NTHR;
    for (int idx = gt; idx < BATCH * MH * 65536; idx += NGT) { const int bh = idx >> 16, e = idx & 65535; float run = 0.f;
#pragma unroll 4
        for (int sc = 0; sc < NSC; ++sc) { float* p = CST + (size_t)(bh * NSC + sc) * 65536 + e; const float tmp = *p; if (!dry) *p = run; else asm volatile("" :: "v"(run)); run = PST[bh * NSC + sc] * run + tmp; } }
    for (int idx = gt; idx < BATCH * MH * 256; idx += NGT) { const int bh = idx >> 8, e = idx & 255; float run = 0.f;
        for (int sc = 0; sc < NSC; ++sc) { float* p = NST + (size_t)(bh * NSC + sc) * 256 + e; const float tmp = *p; if (!dry) *p = run; else asm volatile("" :: "v"(run)); run = PST[bh * NSC + sc] * run + tmp; } }
}
DI void phase_mscan(const Args& a, LAS unsigned char* lds, int tid, int lane0, int wave, int bid, int G) {
    const bf16* ZM = (const bf16*)(a.ws + WS_ZM); bf16* QK = (bf16*)(a.ws + WS_QK);
    const float* GLI = (const float*)(a.ws + WS_GLI); const float* GLF = (const float*)(a.ws + WS_GLF);
    const float* mh_norm = a.in[12]; const float* skip = a.in[13];
    LAS float* nvec = (LAS float*)(lds + MC_NV); LAS float* misc = (LAS float*)(lds + MC_MISC);
#define OPQ(name) int name = tid; asm volatile("" : "+v"(name))
    const float* CST = (const float*)(a.ws + WS_CST); const float* NST = (const float*)(a.ws + WS_NST); const float* MIN = (const float*)(a.ws + WS_MIN);
    for (int u = bid; u < BATCH * MH * NSC; u += G) {
        const int bh = u >> 4, sc = u & 15, b = bh >> 2, hd = bh & 3;
        f32x16 C[8];
        { OPQ(t0); const int lane_ = t0 & 63, r = lane_ & 31, hf = lane_ >> 5;
            const float* cs = CST + (size_t)u * 65536 + 32 * wave + r;
#pragma unroll
            for (int dt = 0; dt < 8; ++dt)
#pragma unroll
                for (int i = 0; i < 16; ++i) C[dt][i] = cs[(32 * dt + crow(i, hf)) * 256];
            if (t0 < 256) nvec[t0] = NST[u * 256 + t0];
        }
        float mrun = MIN[bh * NCH + sc * SCCH];
        for (int c = sc * SCCH; c < (sc + 1) * SCCH; ++c) {
            const size_t rowbase = (size_t)b * SEQ + (size_t)c * LCH;
            u32x2 xcp[8];
            { OPQ(tA); const int laneA = tA & 63;
            mfill<true>(a, lds, rowbase, c * LCH, hd, wave, laneA, xcp);
            if (wave == 0) {
                const float lf = GLF[(size_t)bh * SEQ + c * LCH + laneA], li = GLI[(size_t)bh * SEQ + c * LCH + laneA];
                float bc = lf;
#pragma unroll
                for (int o = 1; o < 64; o <<= 1) { const float t = __shfl_up(bc, o); if (laneA >= o) bc += t; }
                const float av = li - bc; float cm = av;
#pragma unroll
                for (int o = 1; o < 64; o <<= 1) { const float t = __shfl_up(cm, o); if (laneA >= o) cm = fmaxf(cm, t); }
                const float gv = fmaxf(mrun, cm); const float Gc = __shfl(gv, 63), bL = __shfl(bc, 63);
                mc_sc(lds, 0)[laneA] = av; mc_sc(lds, 1)[laneA] = gv; mc_sc(lds, 2)[laneA] = __expf(mrun - gv); mc_sc(lds, 3)[laneA] = __expf(av - Gc); mc_sc(lds, 4)[laneA] = __expf(-(bc + gv));
                if (laneA == 0) misc[0] = __expf(mrun - Gc);
                mrun = bL + Gc;
            } }
            __syncthreads();
            { OPQ(tB); const int laneB = tB & 63, l15 = laneB & 15, l4 = laneB >> 4;
                const int tt = wave >> 1;
#pragma unroll
                for (int sti = 0; sti < 2; ++sti) { const int st = 2 * (wave & 1) + sti;
                    f32x4 acc4 = {0.f, 0.f, 0.f, 0.f};
                    if (st <= tt) {
                        bf16x8 fa[8], fb[8];
#pragma unroll
                        for (int ks = 0; ks < 8; ++ks) { fa[ks] = *(const LAS bf16x8*)(lds + MC_QI + (16 * tt + l15) * MC_QROW + ks * 64 + l4 * 16);
                            fb[ks] = *(const LAS bf16x8*)(lds + MC_KI + (16 * st + l15) * MC_QROW + ks * 64 + l4 * 16); }
                        __builtin_amdgcn_sched_barrier(0);
#pragma unroll
                        for (int ks = 0; ks < 8; ++ks) acc4 = MFMA16(fa[ks], fb[ks], acc4);
                    }
                    const int sidx = 16 * st + l15; const float as_ = mc_sc(lds, 0)[sidx];
#pragma unroll
                    for (int rg = 0; rg < 4; ++rg) { const int t = 16 * tt + 4 * l4 + rg; float p = 0.f;
                        if (st <= tt && sidx <= t) p = acc4[rg] * __expf(as_ - mc_sc(lds, 1)[t]);
                        *(LAS unsigned short*)(lds + MC_P + t * MC_TROW + sidx * 2) = (unsigned short)f2bf(p);
                        float sum = p; sum += __shfl_xor(sum, 1); sum += __shfl_xor(sum, 2); sum += __shfl_xor(sum, 4); sum += __shfl_xor(sum, 8);
                        if (l15 == 0) mc_sc(lds, 7 + st)[t] = sum; }
                }
              const int t = tB >> 3, seg = tB & 7; float sacc = 0.f;
#pragma unroll
                for (int k = 0; k < 4; ++k) { const u32x4 qv = *(const LAS u32x4*)(lds + MC_QI + t * MC_QROW + (seg * 32 + k * 8) * 2);
                    const f32x4 n0 = *(const LAS f32x4*)(nvec + seg * 32 + k * 8), n1 = *(const LAS f32x4*)(nvec + seg * 32 + k * 8 + 4);
                    sacc += bflo(qv.x) * n0.x + bfhi(qv.x) * n0.y + bflo(qv.y) * n0.z + bfhi(qv.y) * n0.w + bflo(qv.z) * n1.x + bfhi(qv.z) * n1.y + bflo(qv.w) * n1.z + bfhi(qv.w) * n1.w; }
                sacc += __shfl_xor(sacc, 1); sacc += __shfl_xor(sacc, 2); sacc += __shfl_xor(sacc, 4);
                if (seg == 0) mc_sc(lds, 5)[t] = sacc; }
            __syncthreads();
            const float cd = misc[0];
            f32x16 acc[2];
            { OPQ(tC); const int laneC = tC & 63, r = laneC & 31, hf = laneC >> 5;
            if (tC < 64) { const int t = tC; const float den = mc_sc(lds, 7)[t] + mc_sc(lds, 8)[t] + mc_sc(lds, 9)[t] + mc_sc(lds, 10)[t];
                const float dn = den + mc_sc(lds, 2)[t] * mc_sc(lds, 5)[t]; mc_sc(lds, 6)[t] = frcp(fmaxf(fabsf(dn), mc_sc(lds, 4)[t])); }
#pragma unroll
            for (int t2 = 0; t2 < 2; ++t2)
#pragma unroll
                for (int i = 0; i < 16; ++i) acc[t2][i] = 0.f;
            const LAS unsigned char* qbase = lds + MC_QI + r * MC_QROW + hf * 8;
#define MC_LDQ(dst, dt_) do { _Pragma("unroll") for (int t2_ = 0; t2_ < 2; ++t2_) { const LAS unsigned char* qb_ = qbase + t2_ * 32 * MC_QROW + (dt_) * 64; \
                const s16x4 l0_ = *(const LAS s16x4*)(qb_), h0_ = *(const LAS s16x4*)(qb_ + 16), l1_ = *(const LAS s16x4*)(qb_ + 32), h1_ = *(const LAS s16x4*)(qb_ + 48); \
                dst[2 * t2_] = __builtin_shufflevector(l0_, h0_, 0, 1, 2, 3, 4, 5, 6, 7); dst[2 * t2_ + 1] = __builtin_shufflevector(l1_, h1_, 0, 1, 2, 3, 4, 5, 6, 7); } } while (0)
            { bf16x8 aq[4]; MC_LDQ(aq, 0);
#pragma unroll
              for (int dt = 0; dt < 8; ++dt) { const bf16x8 cl = pack_lo(C[dt]), chh = pack_hi(C[dt]);
                  bf16x8 an[4];
                  if (dt < 7) MC_LDQ(an, dt + 1);
                  __builtin_amdgcn_sched_barrier(0);
                  acc[0] = MFMA32(aq[0], cl, acc[0]); acc[0] = MFMA32(aq[1], chh, acc[0]); acc[1] = MFMA32(aq[2], cl, acc[1]); acc[1] = MFMA32(aq[3], chh, acc[1]);
                  if (dt < 7) { aq[0] = an[0]; aq[1] = an[1]; aq[2] = an[2]; aq[3] = an[3]; } } }
#undef MC_LDQ
            bf16x8 vt[4];
            const LAS unsigned char* vbase = lds + MC_VT + (32 * wave + r) * MC_TROW + hf * 16;
            const LAS unsigned char* pbase = lds + MC_P + r * MC_TROW + hf * 16;
            { bf16x8 pA[4], pB[4];
#pragma unroll
              for (int ks = 0; ks < 4; ++ks) vt[ks] = *(const LAS bf16x8*)(vbase + ks * 32);
#pragma unroll
              for (int ks = 0; ks < 4; ++ks) pA[ks] = *(const LAS bf16x8*)(pbase + ks * 32);
#pragma unroll
              for (int t2 = 0; t2 < 2; ++t2)
#pragma unroll
                  for (int i = 0; i < 16; ++i) acc[t2][i] *= mc_sc(lds, 2)[32 * t2 + crow(i, hf)];
              __builtin_amdgcn_sched_barrier(0);
#pragma unroll
              for (int ks = 0; ks < 4; ++ks) pB[ks] = *(const LAS bf16x8*)(pbase + 32 * MC_TROW + ks * 32);
#pragma unroll
              for (int ks = 0; ks < 4; ++ks) acc[0] = MFMA32(pA[ks], vt[ks], acc[0]);
              __builtin_amdgcn_sched_barrier(0);
#pragma unroll
              for (int ks = 0; ks < 4; ++ks) acc[1] = MFMA32(pB[ks], vt[ks], acc[1]); }
            asm volatile("" : "+v"(acc[0]), "+v"(acc[1]));
#pragma unroll
            for (int ks = 0; ks < 4; ++ks) {
                const f32x4 w0 = *(const LAS f32x4*)(mc_sc(lds, 3) + 16 * ks + 8 * hf), w1 = *(const LAS f32x4*)(mc_sc(lds, 3) + 16 * ks + 8 * hf + 4);
                const u32x4 vv = __builtin_bit_cast(u32x4, vt[ks]); u32x4 o;
                o.x = pk2(bflo(vv.x) * w0.x, bfhi(vv.x) * w0.y); o.y = pk2(bflo(vv.y) * w0.z, bfhi(vv.y) * w0.w); o.z = pk2(bflo(vv.z) * w1.x, bfhi(vv.z) * w1.y); o.w = pk2(bflo(vv.w) * w1.z, bfhi(vv.w) * w1.w);
                vt[ks] = __builtin_bit_cast(bf16x8, o); }
            const LAS unsigned char* kbase = lds + MC_KT + r * MC_TROW + hf * 16;
            { bf16x8 kq[4];
#pragma unroll
              for (int ks = 0; ks < 4; ++ks) kq[ks] = *(const LAS bf16x8*)(kbase + ks * 32);
#pragma unroll
              for (int dt = 0; dt < 8; ++dt) {
                  bf16x8 kn[4];
                  if (dt < 7) {
#pragma unroll
                      for (int ks = 0; ks < 4; ++ks) kn[ks] = *(const LAS bf16x8*)(kbase + (dt + 1) * 32 * MC_TROW + ks * 32); }
#pragma unroll
                  for (int i = 0; i < 16; ++i) C[dt][i] *= cd;
                  __builtin_amdgcn_sched_barrier(0);
#pragma unroll
                  for (int ks = 0; ks < 4; ++ks) C[dt] = MFMA32(kq[ks], vt[ks], C[dt]);
                  if (dt < 7) { kq[0] = kn[0]; kq[1] = kn[1]; kq[2] = kn[2]; kq[3] = kn[3]; } } }
            if (tC < 256) { float sacc = cd * nvec[tC];
#pragma unroll
                for (int k = 0; k < 8; ++k) { const u32x4 kv = *(const LAS u32x4*)(lds + MC_KT + tC * MC_TROW + k * 16);
                    const f32x4 w0 = *(const LAS f32x4*)(mc_sc(lds, 3) + k * 8), w1 = *(const LAS f32x4*)(mc_sc(lds, 3) + k * 8 + 4);
                    sacc += bflo(kv.x) * w0.x + bfhi(kv.x) * w0.y + bflo(kv.y) * w0.z + bfhi(kv.y) * w0.w + bflo(kv.z) * w1.x + bfhi(kv.z) * w1.y + bflo(kv.w) * w1.z + bfhi(kv.w) * w1.w; }
                nvec[tC] = sacc; }
            }
            __syncthreads();
            { OPQ(tD); const int laneD = tD & 63, r = laneD & 31, hf = laneD >> 5;
              u32x2 zr[8];
#pragma unroll
              for (int k = 0; k < 8; ++k) zr[k] = *(const u32x2*)(ZM + (rowbase + 8 * wave + k) * 1024 + hd * MD + 4 * laneD);
              const f32x4 mhn = *(const f32x4*)(mh_norm + hd * MD + 4 * laneD), skp = *(const f32x4*)(skip + hd * MD + 4 * laneD);
#pragma unroll
              for (int t2 = 0; t2 < 2; ++t2)
#pragma unroll
                for (int i = 0; i < 16; ++i) *(LAS float*)(lds + MC_QI + (32 * t2 + crow(i, hf)) * MC_STROW + (32 * wave + r) * 4) = acc[t2][i];
              __syncthreads();
#pragma unroll
              for (int k = 0; k < 8; ++k) { const int t = 8 * wave + k; const float rden = mc_sc(lds, 6)[t];
                  const f32x4 h4 = *(const LAS f32x4*)(lds + MC_QI + t * MC_STROW + 16 * laneD) * rden;
                  const float s1 = wave_sum_dpp((h4.x + h4.y) + (h4.z + h4.w)), s2 = wave_sum_dpp((h4.x * h4.x + h4.y * h4.y) + (h4.z * h4.z + h4.w * h4.w));
                  const float mean = s1 * (1.0f / MD); const float var = fmaxf(s2 * (1.0f / MD) - mean * mean, 0.f); const float rstd = frsq(var + LN_EPS);
                  const float y0 = ((h4.x - mean) * rstd * mhn.x + skp.x * bflo(xcp[k].x)) * silu_f(bflo(zr[k].x)), y1 = ((h4.y - mean) * rstd * mhn.y + skp.y * bfhi(xcp[k].x)) * silu_f(bfhi(zr[k].x));
                  const float y2 = ((h4.z - mean) * rstd * mhn.z + skp.z * bflo(xcp[k].y)) * silu_f(bflo(zr[k].y)), y3 = ((h4.w - mean) * rstd * mhn.w + skp.w * bfhi(xcp[k].y)) * silu_f(bfhi(zr[k].y));
                  u32x2 o; o.x = pk2(y0, y1); o.y = pk2(y2, y3);
                  *(u32x2*)(QK + (rowbase + t) * 2048 + 1024 + hd * MD + 4 * laneD) = o; } }
            __syncthreads();
        }
    }
#undef OPQ
}

DI void phase_final(const Args& a, int lane, int wave, int bid, int G, int dry) {
    const float* x = a.in[0]; const float* g_post = a.in[3]; float* out = a.out;
    const int gw = bid * NWAVES + wave, NGW = G * NWAVES;
    const f32x4* gr = (const f32x4*)g_post + lane; f32x4 gg[4];
#pragma unroll
    for (int j = 0; j < 4; ++j) gg[j] = gr[64 * j];
    for (int m = gw; m < MTOK; m += NGW) {
        f32x4* yr = (f32x4*)(out + (size_t)m * DM) + lane; const f32x4* xr = (const f32x4*)(x + (size_t)m * DM) + lane; f32x4 v[4], xv[4]; float s = 0.f;
#pragma unroll
        for (int j = 0; j < 4; ++j) { v[j] = yr[64 * j]; xv[j] = xr[64 * j]; s += (v[j].x * v[j].x + v[j].y * v[j].y) + (v[j].z * v[j].z + v[j].w * v[j].w); }
        const float rstd = frsq(wave_sum_dpp(s) * (1.0f / DM) + RMS_EPS);
#pragma unroll
        for (int j = 0; j < 4; ++j) { f32x4 o; o.x = xv[j].x + v[j].x * rstd * gg[j].x; o.y = xv[j].y + v[j].y * rstd * gg[j].y; o.z = xv[j].z + v[j].z * rstd * gg[j].z; o.w = xv[j].w + v[j].w * rstd * gg[j].w; if (!dry) yr[64 * j] = o; else asm volatile("" :: "v"(o)); }
    }
}

#define XB_TMO      128
#define XB_XCNT(j)  (256  + 64 * (j))
#define XB_XSUB(j)  (1280 + 64 * (j))
#define XB_XGEN(j)  (2304 + 64 * (j))
#define XB_TOP      3328
#define XB_TOPGEN   3392
#define XCD_BAR_WORDS 3456
#define XB_SPIN_CAP (1u << 18)

__device__ __forceinline__ unsigned xb_ld(unsigned* p)              { return __hip_atomic_load(p, __ATOMIC_RELAXED, __HIP_MEMORY_SCOPE_AGENT); }
__device__ __forceinline__ unsigned xb_add(unsigned* p, unsigned v) { return __hip_atomic_fetch_add(p, v, __ATOMIC_RELAXED, __HIP_MEMORY_SCOPE_AGENT); }
__device__ __forceinline__ unsigned xb_xcc_id() { return (unsigned)__builtin_amdgcn_s_getreg((3 << 11) | 20) & 0xFu; }
#define XB_SPIN(cond, bar) do { unsigned _sp = 0; while (cond) { __builtin_amdgcn_s_sleep(1); \
    if ((++_sp & 255u) == 0u) { if (xb_ld(&(bar)[XB_TMO])) break; if (_sp > XB_SPIN_CAP) { atomicAdd(&(bar)[XB_TMO], 1u); break; } } } } while (0)

struct XcdBarrier {
    unsigned* bar; unsigned x;
    volatile LAS unsigned* st;
};

__device__ __forceinline__ XcdBarrier xcd_barrier_post(unsigned* bar, volatile LAS unsigned* st) {
    XcdBarrier b; b.bar = bar; b.x = xb_xcc_id(); b.st = st;
    if (threadIdx.x == 0) (void)xb_add(&bar[XB_XCNT(b.x)], 1u);
    return b;
}
__device__ __forceinline__ void xcd_barrier_complete(unsigned* bar, unsigned x, unsigned& nloc, unsigned& nx) {
    const unsigned G = gridDim.x * gridDim.y * gridDim.z;
    unsigned sum, cnt, mine, sp = 0u;
    for (;;) {
        sum = 0u; cnt = 0u; mine = 0u;
#pragma unroll
        for (unsigned j = 0; j < 16; ++j) { const unsigned c = xb_ld(&bar[XB_XCNT(j)]); sum += c; cnt += (c > 0u) ? 1u : 0u; mine = (j == x) ? c : mine; }
        if (sum == G) break;
        __builtin_amdgcn_s_sleep(1);
        if ((++sp & 255u) == 0u) { if (xb_ld(&bar[XB_TMO])) break; if (sp > XB_SPIN_CAP) { atomicAdd(&bar[XB_TMO], 1u); break; } }
    }
    nloc = mine > 0u ? mine : 1u; nx = cnt > 0u ? cnt : 1u;
}

__device__ __forceinline__ void xcd_barrier(const XcdBarrier& b) {
    asm volatile("s_waitcnt vmcnt(0)" ::: "memory");
    __syncthreads();
    if (threadIdx.x == 0) {
        unsigned* bar = b.bar;
        __builtin_amdgcn_s_waitcnt(0);
        unsigned nloc = b.st[0], nx = b.st[1];
        if (nloc == 0u) { xcd_barrier_complete(bar, b.x, nloc, nx); b.st[0] = nloc; b.st[1] = nx; }
        const unsigned old = xb_add(&bar[XB_XSUB(b.x)], 1u);
        const unsigned gen = old / nloc;
        if (old + 1u == (gen + 1u) * nloc) {
            __builtin_amdgcn_fence(__ATOMIC_RELEASE, "agent");
            asm volatile("s_waitcnt vmcnt(0)" ::: "memory");
            const unsigned og = xb_add(&bar[XB_TOP], 1u);
            const unsigned tg = og / nx;
            if (og + 1u == (tg + 1u) * nx) xb_add(&bar[XB_TOPGEN], 1u);
            else XB_SPIN(xb_ld(&bar[XB_TOPGEN]) == tg, bar);
            __builtin_amdgcn_fence(__ATOMIC_ACQUIRE, "agent");
            xb_add(&bar[XB_XGEN(b.x)], 1u);
            asm volatile("s_waitcnt vmcnt(0)" ::: "memory");
        } else {
            XB_SPIN(xb_ld(&bar[XB_XGEN(b.x)]) == gen, bar);
            __builtin_amdgcn_fence(__ATOMIC_ACQUIRE, "agent");
            asm volatile("s_waitcnt vmcnt(0)" ::: "memory");
        }
    }
    __syncthreads();
}

constexpr int NPHASE = 12;
#ifndef DUP_PHASE
#define DUP_PHASE -1
#endif
#define NREP(k) (DUP_PHASE == (k) ? 2 : 1)
#ifndef MK_MULTI
#define MK_MULTI 0
#endif
__global__ void __launch_bounds__(NTHR, 2) hymba_fwd(Args args) {
    extern __shared__ __attribute__((aligned(16))) unsigned char lds_raw[];
    LAS unsigned char* lds = (LAS unsigned char*)lds_raw;
    cg::grid_group grid = cg::this_grid();
    const int tid = threadIdx.x, lane = tid & 63, wave = __builtin_amdgcn_readfirstlane(tid >> 6), bid = blockIdx.x, G = gridDim.x;
    const int lo = args.ph_lo, hi = args.ph_hi;
#ifdef ONLY_PHASE
#define IN(k) ((k) == ONLY_PHASE && lo <= (k) && (k) < hi)
#else
#define IN(k) (lo <= (k) && (k) < hi)
#endif
    unsigned char* ws = args.ws;
    volatile LAS unsigned* barst = (volatile LAS unsigned*)(lds + LDS_BARST);
    if (tid < 2) barst[tid] = 0u;
    __syncthreads();
    XcdBarrier xbar = xcd_barrier_post((unsigned*)(ws + WS_CTL) + CW_BAR, barst);
#define SEAM(k) do { if (IN(k) && IN((k) + 1)) { if ((k) == 0) grid.sync(); else xcd_barrier(xbar); } } while (0)
#undef DUPSYNC
    if (IN(0)) { for (int rep = 0; rep < NREP(0); ++rep) { if (rep) xcd_barrier(xbar); int t_ = tid; asm volatile("" : "+v"(t_)); phase_prologue(args, lds, t_, t_ & 63, wave, bid, G); } } SEAM(0);
    if (IN(1)) {
        pg8::Gemm g{(const pg8::bf16_t*)(ws + WS_XN), (const pg8::bf16_t*)(ws + WS_WINT), MTOK, NIN, DM}; pg8::StaticOrder S; S.init(MTOK, NIN, G, bid);
        pg8::EpiProj E{(pg8::bf16_t*)(ws + WS_QK), (pg8::bf16_t*)(ws + WS_V), (pg8::bf16_t*)(ws + WS_G), (pg8::bf16_t*)(ws + WS_XM), (pg8::bf16_t*)(ws + WS_ZM), QSCALE, (float*)(ws + WS_KM2), (float*)(ws + WS_KA2)};
        for (int rep = 0; rep < NREP(1); ++rep) { if (rep) xcd_barrier(xbar); pg8::gemm_phase<pg8::EpiProj, pg8::StaticOrder, true, true>(lds, g, S, E); }
    } SEAM(1);
    if (IN(2)) { for (int rep = 0; rep < NREP(2); ++rep) { if (rep) xcd_barrier(xbar); int t_ = tid; asm volatile("" : "+v"(t_)); phase_mgate(args, lds, t_, t_ & 63, wave, bid, G); } } SEAM(2);
    if (IN(3)) { for (int rep = 0; rep < NREP(3); ++rep) { if (rep) xcd_barrier(xbar); int t_ = tid; asm volatile("" : "+v"(t_)); phase_sel(args, lds, t_, t_ & 63, wave, bid, G, rep); } } SEAM(3);
    if (IN(4)) { for (int rep = 0; rep < NREP(4); ++rep) { if (rep) xcd_barrier(xbar); int t_ = tid; asm volatile("" : "+v"(t_)); phase_att_gather(args, lds, t_, t_ & 63, wave, bid, G, rep); } } SEAM(4);
    if (IN(5)) { for (int rep = 0; rep < NREP(5); ++rep) { if (rep) xcd_barrier(xbar); int t_ = tid; asm volatile("" : "+v"(t_)); phase_att_own(args, lds, t_, t_ & 63, wave, bid, G, rep); } } SEAM(5);
    if (IN(7)) { for (int rep = 0; rep < NREP(7); ++rep) { if (rep) xcd_barrier(xbar); int t_ = tid; asm volatile("" : "+v"(t_)); phase_mstate(args, lds, t_, t_ & 63, wave, bid, G); } } SEAM(7);
    if (IN(8)) { for (int rep = 0; rep < NREP(8); ++rep) { if (rep) xcd_barrier(xbar); phase_mcomb(args, tid, bid, G, rep); } } SEAM(8);
    if (IN(9)) { for (int rep = 0; rep < NREP(9); ++rep) { if (rep) xcd_barrier(xbar); int t_ = tid; asm volatile("" : "+v"(t_)); phase_mscan(args, lds, t_, t_ & 63, wave, bid, G); } } SEAM(9);
    if (IN(10)) {
        pg8::Gemm g{(const pg8::bf16_t*)(ws + WS_QK), (const pg8::bf16_t*)(ws + WS_WOUTT), MTOK, DM, MIXW}; pg8::StaticOrder S; S.init(MTOK, DM, G, bid);
        pg8::EpiF32 E{args.out, DM};
        for (int rep = 0; rep < NREP(10); ++rep) { if (rep) xcd_barrier(xbar); pg8::gemm_phase<pg8::EpiF32, pg8::StaticOrder, true, true>(lds, g, S, E); }
    } SEAM(10);
    if (IN(11)) { for (int rep = 0; rep < NREP(11); ++rep) { if (rep) xcd_barrier(xbar); phase_final(args, lane, wave, bid, G, rep); } }
#undef IN
#undef SEAM
}

extern "C" void kernel_launch(void* const* d_in, const int* in_sizes, int n_in, void* d_out, int out_size, void* d_ws, size_t ws_size, hipStream_t stream) {
    static int grid = 0;
    if (grid == 0) {
        if (n_in != 15 || out_size != MTOK * DM || ws_size < WS_END) { fprintf(stderr, "kernel_launch: unexpected shapes (n_in %d out %d ws %zu)\n", n_in, out_size, ws_size); grid = -1; return; }
        int dev = 0, cus = 0, per_cu = 0;
        if (hipGetDevice(&dev) != hipSuccess || hipDeviceGetAttribute(&cus, hipDeviceAttributeMultiprocessorCount, dev) != hipSuccess) { grid = -1; return; }
        if (hipFuncSetAttribute((const void*)hymba_fwd, hipFuncAttributeMaxDynamicSharedMemorySize, LDS_BYTES) != hipSuccess) { fprintf(stderr, "kernel_launch: hipFuncSetAttribute failed\n"); grid = -1; return; }
        if (hipOccupancyMaxActiveBlocksPerMultiprocessor(&per_cu, (const void*)hymba_fwd, NTHR, LDS_BYTES) != hipSuccess || per_cu < 1) { fprintf(stderr, "kernel_launch: occupancy query says %d\n", per_cu); per_cu = 1; }
        (void)hipGetLastError();
        grid = cus * 1;
        fprintf(stderr, "kernel_launch: grid %d (cus %d, query per_cu %d)\n", grid, cus, per_cu);
    }
    if (grid < 0) return;
    (void)hipMemsetAsync((char*)d_ws + WS_CTL, 0, CTL_ZERO_BYTES, stream);
    Args a{};
    for (int i = 0; i < 15; ++i) a.in[i] = (const float*)d_in[i];
    a.out = (float*)d_out; a.ws = (unsigned char*)d_ws;
#if MK_MULTI
    for (int p = 0; p < NPHASE; ++p) { a.ph_lo = p; a.ph_hi = p + 1; hipLaunchKernelGGL(hymba_fwd, dim3(grid), dim3(NTHR), LDS_BYTES, stream, a); }
#else
    a.ph_lo = 0; a.ph_hi = NPHASE;
    void* kargs[] = {&a};
    hipError_t e = hipLaunchCooperativeKernel((const void*)hymba_fwd, dim3(grid), dim3(NTHR), kargs, LDS_BYTES, stream);
    if (e != hipSuccess) fprintf(stderr, "kernel_launch: cooperative launch failed: %s (grid %d)\n", hipGetErrorString(e), grid);
#endif
}
```
